# Optimizing an MI355X kernel written in HIP

```python
import jax, jax.numpy as jnp
from jax import lax
import numpy as np

D_MODEL = 1024
BATCH = 8
SEQ = 2048
DEPTH = 2

N_EVEN = (DEPTH + 1) // 2
N_ODD = DEPTH // 2
PLE_DIM = 256
D_FF = -(-(8 * D_MODEL) // (3 * 256)) * 256
W_MIX = D_MODEL
W_A = W_MIX // 2
LRU_BLOCKS = 8
LRU_BLOCK_DIM = W_A // LRU_BLOCKS
CONV_W = 4
LRU_C = 8.0
W_B = W_MIX - W_A
GLA_HEADS = 4
GLA_DV = W_B // GLA_HEADS
GLA_DK = GLA_DV // 2
GLA_RANK = 16
GLA_GATE_NORM = 16.0
GLA_CHUNK = 16
W_C = W_MIX // 2
RET_HEADS = 4
RET_DK = W_C // RET_HEADS
RET_DV = W_C // RET_HEADS
RET_CHUNK = 128
ROPE_BASE = 10000.0
MAX_POS_OFFSET = 1024
W_D = W_MIX - W_C
RWKV_HEAD_DIM = 64
RWKV_HEADS = W_D // RWKV_HEAD_DIM
RWKV_W_RANK = 64
RWKV_A_RANK = 64
RWKV_G_RANK = 128
RWKV_LN_EPS = 64e-5
EVEN_WIDTHS = (W_A, W_A, GLA_HEADS * GLA_DK, GLA_HEADS * GLA_DK, W_B, W_B, GLA_RANK)
RET_WIDTHS = (W_C, W_C, W_C, W_C)
RWKV_WIDTHS = (W_D, W_D, W_D, RWKV_W_RANK, RWKV_A_RANK, RWKV_G_RANK)
EVEN_COLS = sum(EVEN_WIDTHS)
RET_COLS = sum(RET_WIDTHS)
RWKV_COLS = sum(RWKV_WIDTHS)
ODD_COLS = RET_COLS + RWKV_COLS
NORM_EPS = 1e-6

kernel_name = 'hybrid_lru_gla_retention_rwkv7_trunk'


def _split(x, widths):
    outs, start = [], 0
    for w in widths:
        outs.append(x[..., start:start + w])
        start += w
    return outs


def rmsnorm(x, g):
    x32 = x.astype(jnp.float32)
    y = x32 * lax.rsqrt(jnp.mean(jnp.square(x32), axis=-1, keepdims=True) + NORM_EPS)
    return (y * g.astype(jnp.float32)).astype(x.dtype)


def head_norm(x, g, center, eps):
    if center:
        x = x - jnp.mean(x, axis=-1, keepdims=True)
    x = x * lax.rsqrt(jnp.mean(jnp.square(x), axis=-1, keepdims=True) + eps)
    return x.reshape(x.shape[0], x.shape[1], -1) * g.astype(jnp.float32)


def rotary(x, positions):
    half = x.shape[-1] // 2
    inv_freq = ROPE_BASE ** (-jnp.arange(half, dtype=jnp.float32) / half)
    ang = positions.astype(jnp.float32)[..., None] * inv_freq
    cos, sin = jnp.cos(ang)[:, :, None, :], jnp.sin(ang)[:, :, None, :]
    x1, x2 = x[..., :half], x[..., half:]
    return jnp.concatenate([x1 * cos - x2 * sin, x2 * cos + x1 * sin], axis=-1)


def causal_depthwise_conv(x, w, b):
    out = lax.conv_general_dilated(x, w[:, None, :], window_strides=(1,), padding=[(CONV_W - 1, 0)],
                                   dimension_numbers=('NWC', 'WIO', 'NWC'), feature_group_count=x.shape[-1])
    return out + b


def _linear_combine(left, right):
    a_l, b_l = left
    a_r, b_r = right
    return a_l * a_r, a_r * b_l + b_r


def rg_lru(x, w_r, b_r, w_i, b_i, a_param):
    bsz, seq, _ = x.shape
    xb = x.reshape(bsz, seq, LRU_BLOCKS, LRU_BLOCK_DIM)
    gate_r = jnp.einsum('bsgi,gij->bsgj', xb, w_r).reshape(bsz, seq, W_A) + b_r
    gate_i = jnp.einsum('bsgi,gij->bsgj', xb, w_i).reshape(bsz, seq, W_A) + b_i
    r = jax.nn.sigmoid(gate_r.astype(jnp.float32))
    i = jax.nn.sigmoid(gate_i.astype(jnp.float32))
    log_a = LRU_C * r * jax.nn.log_sigmoid(a_param.astype(jnp.float32))
    a = jnp.exp(log_a)
    u = jnp.sqrt(-jnp.expm1(2.0 * log_a)) * (i * x.astype(jnp.float32))
    _, h = lax.associative_scan(_linear_combine, (a, u), axis=1)
    return h


def gla(q, k, v, g, gk_lr, w_gk, b_gk, norm_g):
    f32 = jnp.float32
    bsz, seq, _ = q.shape
    n, c, h = seq // GLA_CHUNK, GLA_CHUNK, GLA_HEADS
    log_f = jax.nn.log_sigmoid((gk_lr @ w_gk + b_gk).astype(f32)) / GLA_GATE_NORM
    q = q.astype(f32).reshape(bsz, n, c, h, GLA_DK) * GLA_DK ** -0.5
    k = k.astype(f32).reshape(bsz, n, c, h, GLA_DK)
    v = v.astype(f32).reshape(bsz, n, c, h, GLA_DV)
    cum = jnp.cumsum(log_f.reshape(bsz, n, c, h, GLA_DK), axis=2)
    mask = jnp.tril(jnp.ones((c, c), dtype=bool))[:, :, None, None]
    rel = jnp.minimum(cum[:, :, :, None] - cum[:, :, None, :], 0.0)
    decay = jnp.where(mask, jnp.exp(rel), 0.0)
    scores = jnp.einsum('bnihk,bnjhk,bnijhk->bnhij', q, k, decay)
    o_intra = jnp.einsum('bnhij,bnjhv->bnihv', scores, v)
    q_in = q * jnp.exp(cum)
    k_out = k * jnp.exp(cum[:, :, -1:] - cum)
    chunk_decay = jnp.exp(cum[:, :, -1])

    def step(state, inp):
        qc, kc, vc, dc = inp
        o = jnp.einsum('bchk,bhkv->bchv', qc, state)
        state = state * dc[..., None] + jnp.einsum('bchk,bchv->bhkv', kc, vc)
        return state, o

    xs = (jnp.moveaxis(q_in, 1, 0), jnp.moveaxis(k_out, 1, 0), jnp.moveaxis(v, 1, 0), jnp.moveaxis(chunk_decay, 1, 0))
    state0 = jnp.zeros((bsz, h, GLA_DK, GLA_DV), f32)
    _, o_inter = lax.scan(step, state0, xs)
    o = (o_intra + jnp.moveaxis(o_inter, 0, 1)).reshape(bsz, seq, h, GLA_DV)
    o = head_norm(o, norm_g, center=False, eps=1e-5)
    return o * jax.nn.silu(g.astype(f32))


def retention(q, k, v, g, positions, norm_g):
    f32 = jnp.float32
    bsz, seq, _ = q.shape
    n, c, h = seq // RET_CHUNK, RET_CHUNK, RET_HEADS
    q = rotary(q.astype(f32).reshape(bsz, seq, h, RET_DK), positions) * RET_DK ** -0.5
    k = rotary(k.astype(f32).reshape(bsz, seq, h, RET_DK), positions)
    q = q.reshape(bsz, n, c, h, RET_DK)
    k = k.reshape(bsz, n, c, h, RET_DK)
    v = v.astype(f32).reshape(bsz, n, c, h, RET_DV)
    log_gamma = jnp.log1p(-jnp.exp2(-5.0 - jnp.arange(h, dtype=f32)))
    idx = jnp.arange(c, dtype=f32)
    rel = idx[:, None] - idx[None, :]
    dmask = jnp.where(rel >= 0, jnp.exp(jnp.maximum(rel, 0.0) * log_gamma[:, None, None]), 0.0)
    scores = jnp.einsum('bnihd,bnjhd->bnhij', q, k) * dmask
    o_intra = jnp.einsum('bnhij,bnjhv->bnihv', scores, v)
    q_in = q * jnp.exp((idx + 1.0)[:, None] * log_gamma)[:, :, None]
    k_out = k * jnp.exp((c - 1.0 - idx)[:, None] * log_gamma)[:, :, None]
    chunk_decay = jnp.exp(c * log_gamma)

    def step(state, inp):
        qc, kc, vc = inp
        o = jnp.einsum('bchk,bhkv->bchv', qc, state)
        state = state * chunk_decay[:, None, None] + jnp.einsum('bchk,bchv->bhkv', kc, vc)
        return state, o

    xs = (jnp.moveaxis(q_in, 1, 0), jnp.moveaxis(k_out, 1, 0), jnp.moveaxis(v, 1, 0))
    state0 = jnp.zeros((bsz, h, RET_DK, RET_DV), f32)
    _, o_inter = lax.scan(step, state0, xs)
    o = (o_intra + jnp.moveaxis(o_inter, 0, 1)).reshape(bsz, seq, h, RET_DV)
    o = head_norm(o, norm_g, center=True, eps=1e-5)
    return o * jax.nn.silu(g.astype(f32))


def rwkv7(r, k, v, w_lr, a_lr, g_lr, w0, w_w2, a0, a_w2, g_w2, k_k, k_a, r_k, norm_g):
    f32 = jnp.float32
    bsz, seq, _ = r.shape
    h, d = RWKV_HEADS, RWKV_HEAD_DIM
    r, k, v = r.astype(f32), k.astype(f32), v.astype(f32)
    w = -jax.nn.softplus(-(w0 + jnp.tanh(w_lr) @ w_w2).astype(f32)) - 0.5
    decay = jnp.exp(-jnp.exp(w))
    a = jax.nn.sigmoid((a0 + a_lr @ a_w2).astype(f32))
    g = (jax.nn.sigmoid(g_lr) @ g_w2).astype(f32)
    kk = (k * k_k.astype(f32)).reshape(bsz, seq, h, d)
    kk = kk * lax.rsqrt(jnp.sum(jnp.square(kk), axis=-1, keepdims=True) + 1e-12)
    k = k * (1.0 + (a - 1.0) * k_a.astype(f32))
    rh, kh, vh = r.reshape(bsz, seq, h, d), k.reshape(bsz, seq, h, d), v.reshape(bsz, seq, h, d)
    dh, ah = decay.reshape(bsz, seq, h, d), a.reshape(bsz, seq, h, d)

    def step(state, inp):
        r_t, k_t, v_t, w_t, kk_t, b_t = inp
        sa = jnp.einsum('bhvk,bhk->bhv', state, -kk_t)
        state = state * w_t[:, :, None, :] + sa[..., :, None] * b_t[:, :, None, :] + v_t[..., :, None] * k_t[..., None, :]
        y = jnp.einsum('bhvk,bhk->bhv', state, r_t)
        return state, y

    xs = (jnp.moveaxis(rh, 1, 0), jnp.moveaxis(kh, 1, 0), jnp.moveaxis(vh, 1, 0),
          jnp.moveaxis(dh, 1, 0), jnp.moveaxis(kk, 1, 0), jnp.moveaxis(kk * ah, 1, 0))
    state0 = jnp.zeros((bsz, h, d, d), f32)
    _, y = lax.scan(step, state0, xs)
    y = head_norm(jnp.moveaxis(y, 0, 1), norm_g, center=True, eps=RWKV_LN_EPS)
    bonus = jnp.sum(rh * kh * r_k.astype(f32).reshape(h, d), axis=-1, keepdims=True) * vh
    return (y + bonus.reshape(bsz, seq, W_D)) * g


def even_mixer(xn, w_in, conv_w, conv_b, lru_wr, lru_br, lru_wi, lru_bi, lru_a, gla_wgk, gla_bgk, gla_norm, w_out):
    proj = xn @ w_in
    a_x, a_gate, b_q, b_k, b_v, b_g, b_gk = _split(proj, EVEN_WIDTHS)
    a_x = causal_depthwise_conv(a_x, conv_w, conv_b)
    y_a = rg_lru(a_x, lru_wr, lru_br, lru_wi, lru_bi, lru_a) * jax.nn.gelu(a_gate.astype(jnp.float32), approximate=True)
    y_b = gla(b_q, b_k, b_v, b_g, b_gk, gla_wgk, gla_bgk, gla_norm)
    y = jnp.concatenate([y_a, y_b], axis=-1).astype(xn.dtype)
    return y @ w_out


def odd_mixer(xn, positions, w_in, ret_norm, mu, w0, w_w2, a0, a_w2, g_w2, k_k, k_a, r_k, rwkv_norm, w_out):
    proj = xn @ w_in
    c_part, d_part = proj[..., :RET_COLS], proj[..., RET_COLS:]
    c_q, c_k, c_v, c_g = _split(c_part, RET_WIDTHS)
    y_c = retention(c_q, c_k, c_v, c_g, positions, ret_norm)
    d_prev = jnp.pad(d_part, ((0, 0), (1, 0), (0, 0)))[:, :-1]
    d_part = d_part + mu * (d_prev - d_part)
    d_r, d_k, d_v, d_w, d_a, d_g = _split(d_part, RWKV_WIDTHS)
    y_d = rwkv7(d_r, d_k, d_v, d_w, d_a, d_g, w0, w_w2, a0, a_w2, g_w2, k_k, k_a, r_k, rwkv_norm)
    y = jnp.concatenate([y_c, y_d], axis=-1).astype(xn.dtype)
    return y @ w_out


def swiglu(x, w_gate, w_up, w_down):
    return (jax.nn.silu(x @ w_gate) * (x @ w_up)) @ w_down


def setup_inputs(seed: int = 0) -> dict:
    key = jax.random.key(seed)
    ks = iter(jax.random.split(key, 64))
    f32 = jnp.float32

    def nrm(shape, scale):
        return jax.random.normal(next(ks), shape, f32) * scale

    def unif(shape, lo, hi):
        return jax.random.uniform(next(ks), shape, f32, lo, hi)

    def gain(shape):
        return 1.0 + nrm(shape, 0.02)

    x = nrm((BATCH, SEQ, D_MODEL), 1.0)
    p = nrm((DEPTH, BATCH, SEQ, PLE_DIM), 1.0)
    offset = jax.random.randint(next(ks), (BATCH, 1), 0, MAX_POS_OFFSET, dtype=jnp.int32)
    positions = offset + jnp.arange(SEQ, dtype=jnp.int32)[None, :]
    lru_target = unif((N_EVEN, W_A), 0.9, 0.999)
    lru_s = lru_target ** (1.0 / LRU_C)
    return {
        'x': x, 'p': p, 'positions': positions,
        'ev_w_in': nrm((N_EVEN, D_MODEL, EVEN_COLS), D_MODEL ** -0.5),
        'ev_conv_w': nrm((N_EVEN, CONV_W, W_A), CONV_W ** -0.5),
        'ev_conv_b': nrm((N_EVEN, W_A), 0.01),
        'ev_lru_wr': nrm((N_EVEN, LRU_BLOCKS, LRU_BLOCK_DIM, LRU_BLOCK_DIM), LRU_BLOCK_DIM ** -0.5),
        'ev_lru_br': nrm((N_EVEN, W_A), 0.01),
        'ev_lru_wi': nrm((N_EVEN, LRU_BLOCKS, LRU_BLOCK_DIM, LRU_BLOCK_DIM), LRU_BLOCK_DIM ** -0.5),
        'ev_lru_bi': nrm((N_EVEN, W_A), 0.01),
        'ev_lru_a': jnp.log(lru_s) - jnp.log1p(-lru_s),
        'ev_gla_wgk': nrm((N_EVEN, GLA_RANK, GLA_HEADS * GLA_DK), GLA_RANK ** -0.5),
        'ev_gla_bgk': nrm((N_EVEN, GLA_HEADS * GLA_DK), 0.1),
        'ev_gla_norm': gain((N_EVEN, W_B)),
        'ev_w_out': nrm((N_EVEN, W_MIX, D_MODEL), W_MIX ** -0.5),
        'od_w_in': nrm((N_ODD, D_MODEL, ODD_COLS), D_MODEL ** -0.5),
        'od_ret_norm': gain((N_ODD, W_C)),
        'od_rwkv_mu': unif((N_ODD, RWKV_COLS), 0.0, 1.0),
        'od_rwkv_w0': unif((N_ODD, W_D), -6.0, -1.0),
        'od_rwkv_ww2': nrm((N_ODD, RWKV_W_RANK, W_D), 0.1),
        'od_rwkv_a0': nrm((N_ODD, W_D), 0.1),
        'od_rwkv_aw2': nrm((N_ODD, RWKV_A_RANK, W_D), 0.1),
        'od_rwkv_gw2': nrm((N_ODD, RWKV_G_RANK, W_D), RWKV_G_RANK ** -0.5),
        'od_rwkv_kk': 0.85 + nrm((N_ODD, W_D), 0.02),
        'od_rwkv_ka': gain((N_ODD, W_D)),
        'od_rwkv_rk': nrm((N_ODD, W_D), 0.1),
        'od_rwkv_norm': gain((N_ODD, W_D)),
        'od_w_out': nrm((N_ODD, W_MIX, D_MODEL), W_MIX ** -0.5),
        'mix_norm': gain((DEPTH, D_MODEL)),
        'ffn_norm': gain((DEPTH, D_MODEL)),
        'ffn_w_gate': nrm((DEPTH, D_MODEL, D_FF), D_MODEL ** -0.5),
        'ffn_w_up': nrm((DEPTH, D_MODEL, D_FF), D_MODEL ** -0.5),
        'ffn_w_down': nrm((DEPTH, D_FF, D_MODEL), D_FF ** -0.5),
        'ple_norm': gain((DEPTH, D_MODEL)),
        'ple_w_gate': nrm((DEPTH, D_MODEL, D_MODEL), D_MODEL ** -0.5),
        'ple_b_gate': nrm((DEPTH, D_MODEL), 0.01),
        'ple_w_proj': nrm((DEPTH, PLE_DIM, D_MODEL), PLE_DIM ** -0.5),
        'final_norm': gain((D_MODEL,)),
    }


def reference(x, p, positions, ev_w_in, ev_conv_w, ev_conv_b, ev_lru_wr, ev_lru_br, ev_lru_wi, ev_lru_bi, ev_lru_a,
              ev_gla_wgk, ev_gla_bgk, ev_gla_norm, ev_w_out, od_w_in, od_ret_norm, od_rwkv_mu, od_rwkv_w0, od_rwkv_ww2,
              od_rwkv_a0, od_rwkv_aw2, od_rwkv_gw2, od_rwkv_kk, od_rwkv_ka, od_rwkv_rk, od_rwkv_norm, od_w_out,
              mix_norm, ffn_norm, ffn_w_gate, ffn_w_up, ffn_w_down, ple_norm, ple_w_gate, ple_b_gate, ple_w_proj,
              final_norm):
    h = x
    for i in range(DEPTH):
        j = i // 2
        xn = rmsnorm(h, mix_norm[i])
        if i % 2 == 0:
            mix = even_mixer(xn, ev_w_in[j], ev_conv_w[j], ev_conv_b[j], ev_lru_wr[j], ev_lru_br[j], ev_lru_wi[j],
                             ev_lru_bi[j], ev_lru_a[j], ev_gla_wgk[j], ev_gla_bgk[j], ev_gla_norm[j], ev_w_out[j])
        else:
            mix = odd_mixer(xn, positions, od_w_in[j], od_ret_norm[j], od_rwkv_mu[j], od_rwkv_w0[j], od_rwkv_ww2[j],
                            od_rwkv_a0[j], od_rwkv_aw2[j], od_rwkv_gw2[j], od_rwkv_kk[j], od_rwkv_ka[j], od_rwkv_rk[j],
                            od_rwkv_norm[j], od_w_out[j])
        h = h + mix.astype(h.dtype)
        h = h + swiglu(rmsnorm(h, ffn_norm[i]), ffn_w_gate[i], ffn_w_up[i], ffn_w_down[i]).astype(h.dtype)
        gate = jax.nn.sigmoid((rmsnorm(h, ple_norm[i]) @ ple_w_gate[i] + ple_b_gate[i]).astype(jnp.float32))
        h = h + (gate * (p[i] @ ple_w_proj[i]).astype(jnp.float32)).astype(h.dtype)
    return rmsnorm(h, final_norm)
```

```cpp
#include <hip/hip_runtime.h>
#include <hip/hip_cooperative_groups.h>
#include <cstdio>
#include <cstdint>
namespace cg = cooperative_groups;
namespace pg8 {
#define PG8_LAS __attribute__((address_space(3)))
typedef unsigned short bf16_t;
typedef short bf16x8 __attribute__((ext_vector_type(8)));
typedef float f32x4 __attribute__((ext_vector_type(4)));
typedef unsigned u32x4 __attribute__((ext_vector_type(4)));
constexpr int BM = 256, BK = 64, HALF = 128, HTB = HALF * BK * 2  , STAGE_BYTES = 8 * HTB, NXCD = 8, WGM = 8;

__host__ __device__ __forceinline__ int lds_byte(int r, int c) { const int st = (r >> 4) * 2 + (c >> 5), rr = r & 15, cc = c & 31, ob = rr * 64 + cc * 2; return st * 1024 + (ob ^ (((ob >> 9) & 1) << 5)); }
__host__ __device__ __forceinline__ void stage_rc(int b, int& R, int& C) { const int st = b / 1024, sb = b % 1024, swz = sb ^ (((sb >> 9) & 1) << 5); R = (st >> 1) * 16 + swz / 64; C = (st & 1) * 32 + (swz % 64) / 2; }
__host__ __device__ __forceinline__ int perm32(int rho) { const int n = rho >> 4, i = rho & 15; return 8 * (i >> 2) + 4 * n + (i & 3); }

struct Unit { int pm, pn; };
struct Gemm { const bf16_t* A; const bf16_t* Bt; int M, N, K, lda; };

struct StaticOrder {
    int nM, nN, nwg, G, c;
    __host__ __device__ void init(int M, int N, int G_, int c_) { nM = M / BM; nN = N / BM; nwg = nM * nN; G = G_; c = c_; }
    __host__ __device__ bool next(int i, Unit& u) const {
        const long L = (long)i * G + c; if (L >= nwg) return false;
        int wgid = (int)L; { const int q = nwg / NXCD, r = nwg % NXCD, xcd = wgid % NXCD, off = wgid / NXCD; wgid = (xcd < r ? xcd * (q + 1) : r * (q + 1) + (xcd - r) * q) + off; }
        const int nig = WGM * nN, gid = wgid / nig, fm = gid * WGM, gsz = (nM - fm) < WGM ? (nM - fm) : WGM;
        u.pm = fm + ((wgid % nig) % gsz); u.pn = (wgid % nig) / gsz; return true;
    }
    __device__ __forceinline__ void a_ready(const Unit&) const {}
    __device__ __forceinline__ void done(const Unit&) const {}
};

__device__ __forceinline__ unsigned cvt_pk_bf16(float lo, float hi) { unsigned r; asm volatile("v_cvt_pk_bf16_f32 %0, %1, %2" : "=v"(r) : "v"(lo), "v"(hi)); return r; }
typedef float f32x2 __attribute__((ext_vector_type(2)));
__device__ __forceinline__ f32x2 gelu_pk(f32x2 v) {
    const f32x2 av = __builtin_elementwise_abs(v), d = av * 0.2316418882f + 1.0f;
    f32x2 t; t.x = __builtin_amdgcn_rcpf(d.x); t.y = __builtin_amdgcn_rcpf(d.y);
    f32x2 q = t * 0.5307027145f + (-0.7265760135f); q = q * t + 0.7107068705f; q = q * t + (-0.142248368f); q = q * t + 0.127414796f; q = q * t;
    const f32x2 s = (v * v) * (-0.72134752044f);
    f32x2 e; e.x = __builtin_amdgcn_exp2f(s.x); e.y = __builtin_amdgcn_exp2f(s.y);
    const f32x2 m = v * (q * e), r = v - m;
    f32x2 o; o.x = v.x < 0.f ? m.x : r.x; o.y = v.y < 0.f ? m.y : r.y; return o;
}


}
struct Params { const float* in[38]; float* out; unsigned char* ws; };
typedef const __attribute__((address_space(4))) Params& PRef;
__device__ __forceinline__ const __attribute__((address_space(4))) Params* fresh_params() { unsigned long long ki = (unsigned long long)__builtin_amdgcn_kernarg_segment_ptr(); asm volatile("" : "+s"(ki)); return (const __attribute__((address_space(4))) Params*)ki; }
#define FP (*fresh_params())
constexpr size_t EPI_MiB = 1u << 20;
constexpr size_t E_ROWSS = 65536, E_HB = 35 * EPI_MiB, E_PROJ = 67 * EPI_MiB, E_Y = 187 * EPI_MiB, E_HF = 107 * EPI_MiB;
namespace pg8 {

__device__ __forceinline__ float rs_of(const float* rowss, int row) { return rowss ? __builtin_amdgcn_rsqf(rowss[row] * (1.0f / 1024.0f) + 1e-6f) : 1.0f; }
__device__ __forceinline__ float sigm(float x) { return __builtin_amdgcn_rcpf(1.0f + __expf(-x)); }
constexpr size_t E_RPART = 253 * EPI_MiB;
__device__ __forceinline__ float* rpart(unsigned char* ws, int inst) { return (float*)(ws + E_RPART + ((inst & 1) ? 0 : EPI_MiB)); }
__device__ __forceinline__ float rs16(const float* part, int row) { const f32x4* q = (const f32x4*)(part + (size_t)row * 16); const f32x4 a = q[0], b = q[1], c = q[2], d = q[3];
    const float s = (((a[0] + a[1]) + (a[2] + a[3])) + ((b[0] + b[1]) + (b[2] + b[3]))) + (((c[0] + c[1]) + (c[2] + c[3])) + ((d[0] + d[1]) + (d[2] + d[3])));
    return __builtin_amdgcn_rsqf(s * (1.0f / 1024.0f) + 1e-6f); }

struct EpiScaleBf16 {
    static constexpr bool PERM = true, AFTER_DRAIN = false;
    int mode, li;
    __device__ __forceinline__ void operator()(const f32x4 (&acc)[2][2][4][2], const Unit& u, int wr, int wc, int fr, int fq) const {
        unsigned char* ws = FP.ws; bf16_t* O = (bf16_t*)(ws + (mode == 0 ? E_PROJ : E_Y));   const int ldc = mode == 0 ? (li == 0 ? 2816 : 3840) : (mode == 2 ? 1536 : 1024);
        const float* rowss = (mode == 0 && li == 0) ? (const float*)(ws + E_ROWSS) : nullptr; const float* part = rpart(ws, 3); const bool use16 = (mode == 0 && li == 1);
        const int row0 = u.pm * BM + wr * 64 + fr, col0 = u.pn * BM + wc * 32 + 8 * fq;
#pragma unroll
        for (int ai = 0; ai < 2; ++ai)
#pragma unroll
            for (int m = 0; m < 4; ++m) { const int row = row0 + ai * HALF + m * 16; const float rs = use16 ? rs16(part, row) : rs_of(rowss, row); bf16_t* rowp = O + (size_t)row * ldc + col0;
#pragma unroll
                for (int bj = 0; bj < 2; ++bj) { const f32x4 v0 = acc[ai][bj][m][0] * rs, v1 = acc[ai][bj][m][1] * rs;
                    u32x4 w; w.x = cvt_pk_bf16(v0[0], v0[1]); w.y = cvt_pk_bf16(v0[2], v0[3]); w.z = cvt_pk_bf16(v1[0], v1[1]); w.w = cvt_pk_bf16(v1[2], v1[3]);
                    *(u32x4*)(rowp + bj * HALF) = w; } }
    }
};

__device__ __forceinline__ void unpk8(const u32x4 pw, f32x4& p0, f32x4& p1) {
    p0[0] = __uint_as_float(pw.x << 16); p0[1] = __uint_as_float(pw.x & 0xffff0000u); p0[2] = __uint_as_float(pw.y << 16); p0[3] = __uint_as_float(pw.y & 0xffff0000u);
    p1[0] = __uint_as_float(pw.z << 16); p1[1] = __uint_as_float(pw.z & 0xffff0000u); p1[2] = __uint_as_float(pw.w << 16); p1[3] = __uint_as_float(pw.w & 0xffff0000u);
}
struct EpiResid {
    static constexpr bool PERM = true, AFTER_DRAIN = false;
    int which, li;
    __device__ __forceinline__ void operator()(const f32x4 (&acc)[2][2][4][2], const Unit& u, int wr, int wc, int fr, int fq) const {
        PRef p = FP; unsigned char* ws = p.ws; bf16_t* res = (bf16_t*)p.out + (size_t)li * 16384 * 1024; const float* xin = p.in[0]; const bool from_x = (which == 0 && li == 0);
        float* part = rpart(ws, (which == 0 ? 1 : 2) + 3 * li); const int slot = 4 * u.pn + wc;
        const int row0 = u.pm * BM + wr * 64 + fr, col0 = u.pn * BM + wc * 32 + 8 * fq;
#pragma unroll
        for (int ai = 0; ai < 2; ++ai)
#pragma unroll
            for (int m = 0; m < 4; ++m) { const int row = row0 + ai * HALF + m * 16; float ss = 0.f;
#pragma unroll
                for (int bj = 0; bj < 2; ++bj) { const size_t off = (size_t)row * 1024 + col0 + bj * HALF; f32x4 v0, v1;
                    if (from_x) { v0 = *(const f32x4*)(xin + off); v1 = *(const f32x4*)(xin + off + 4); } else unpk8(*(const u32x4*)(res + off), v0, v1);
                    v0 = v0 + acc[ai][bj][m][0]; v1 = v1 + acc[ai][bj][m][1];
                    u32x4 w; w.x = cvt_pk_bf16(v0[0], v0[1]); w.y = cvt_pk_bf16(v0[2], v0[3]); w.z = cvt_pk_bf16(v1[0], v1[1]); w.w = cvt_pk_bf16(v1[2], v1[3]);
                    *(u32x4*)(res + off) = w;
                    ss += (v0[0] * v0[0] + v0[1] * v0[1]) + (v0[2] * v0[2] + v0[3] * v0[3]) + (v1[0] * v1[0] + v1[1] * v1[1]) + (v1[2] * v1[2] + v1[3] * v1[3]); }
                ss += __shfl_xor(ss, 16); ss += __shfl_xor(ss, 32);
                if (fq == 0) part[(size_t)row * 16 + slot] = ss; asm volatile("" ::: "memory"); }
    }
};

struct EpiSwiGLU {
    static constexpr bool PERM = true, AFTER_DRAIN = false;
    int li;
    __device__ __forceinline__ void operator()(const f32x4 (&acc)[2][2][4][2], const Unit& u, int wr, int wc, int fr, int fq) const {
        typedef unsigned u32x2v __attribute__((ext_vector_type(2)));
        unsigned char* ws = FP.ws; bf16_t* O = (bf16_t*)(ws + E_PROJ); const int ldc = 2816; const float* part = rpart(ws, 1 + 3 * li);
        const int row0 = u.pm * BM + wr * 64 + fr, col0 = u.pn * 128 + wc * 16 + 4 * fq;
#pragma unroll
        for (int ai = 0; ai < 2; ++ai)
#pragma unroll
            for (int m = 0; m < 4; ++m) { const int row = row0 + ai * HALF + m * 16; const float rs = rs16(part, row); bf16_t* rowp = O + (size_t)row * ldc + col0;
#pragma unroll
                for (int bj = 0; bj < 2; ++bj) { const f32x4 g = acc[ai][bj][m][0] * rs, up = acc[ai][bj][m][1] * rs; f32x4 o;
#pragma unroll
                    for (int i = 0; i < 4; ++i) o[i] = g[i] * sigm(g[i]) * up[i];
                    u32x2v w; w.x = cvt_pk_bf16(o[0], o[1]); w.y = cvt_pk_bf16(o[2], o[3]);
                    *(u32x2v*)(rowp + bj * 64) = w; } }
    }
};

struct EpiPLE {
    static constexpr bool PERM = true, AFTER_DRAIN = false;
    int li;
    __device__ __forceinline__ void operator()(const f32x4 (&acc)[2][2][4][2], const Unit& u, int wr, int wc, int fr, int fq) const {
        PRef p = FP; unsigned char* ws = p.ws; const bf16_t* rin = (const bf16_t*)p.out + (size_t)li * 16384 * 1024; bf16_t* rout = (bf16_t*)p.out + (size_t)16384 * 1024; bf16_t* hf = (bf16_t*)(ws + E_HF);
        const bf16_t* pp = (const bf16_t*)(ws + E_Y); const float* bias = p.in[35] + li * 1024;
        const float* rs_in = rpart(ws, 2 + 3 * li); float* part = rpart(ws, 3 + 3 * li); const int slot = 4 * u.pn + wc;
        const int row0 = u.pm * BM + wr * 64 + fr, col0 = u.pn * BM + wc * 32 + 8 * fq;
#pragma unroll
        for (int ai = 0; ai < 2; ++ai)
#pragma unroll
            for (int m = 0; m < 4; ++m) { const int row = row0 + ai * HALF + m * 16; const float rs = rs16(rs_in, row); float ss = 0.f;
#pragma unroll
                for (int bj = 0; bj < 2; ++bj) { const size_t off = (size_t)row * 1024 + col0 + bj * HALF;
                    const f32x4 b0 = *(const f32x4*)(bias + col0 + bj * HALF), b1 = *(const f32x4*)(bias + col0 + bj * HALF + 4);
                    f32x4 p0, p1, v0, v1; unpk8(*(const u32x4*)(pp + off), p0, p1); unpk8(*(const u32x4*)(rin + off), v0, v1);
                    const f32x4 g0 = acc[ai][bj][m][0] * rs + b0, g1 = acc[ai][bj][m][1] * rs + b1;
#pragma unroll
                    for (int i = 0; i < 4; ++i) { v0[i] += sigm(g0[i]) * p0[i]; v1[i] += sigm(g1[i]) * p1[i]; }
                    if (li == 0) { u32x4 w; w.x = cvt_pk_bf16(v0[0], v0[1]); w.y = cvt_pk_bf16(v0[2], v0[3]); w.z = cvt_pk_bf16(v1[0], v1[1]); w.w = cvt_pk_bf16(v1[2], v1[3]); *(u32x4*)(rout + off) = w; }
                    else { u32x4 w; w.x = cvt_pk_bf16(v0[0], v0[1]); w.y = cvt_pk_bf16(v0[2], v0[3]); w.z = cvt_pk_bf16(v1[0], v1[1]); w.w = cvt_pk_bf16(v1[2], v1[3]); *(u32x4*)(hf + off) = w; }
                    ss += (v0[0] * v0[0] + v0[1] * v0[1]) + (v0[2] * v0[2] + v0[3] * v0[3]) + (v1[0] * v1[0] + v1[1] * v1[1]) + (v1[2] * v1[2] + v1[3] * v1[3]); }
                ss += __shfl_xor(ss, 16); ss += __shfl_xor(ss, 32);
                if (fq == 0) part[(size_t)row * 16 + slot] = ss; asm volatile("" ::: "memory"); }
    }
};

struct EpiLowRank {
    static constexpr bool PERM = true, AFTER_DRAIN = false;
    int dummy;
    template <int KIND> __device__ __forceinline__ void run(const f32x4 (&acc)[2][2][4][2], const Unit& u, int wr, int wc, int fr, int fq) const {
        PRef p = FP; bf16_t* O = (bf16_t*)(p.ws + E_Y); const float* bsrc = KIND == 0 ? p.in[18] : p.in[20];
        const int row0 = u.pm * BM + wr * 64 + fr, col0 = u.pn * BM + wc * 32 + 8 * fq;
#pragma unroll
        for (int bj = 0; bj < 2; ++bj) { const int col = col0 + bj * HALF; f32x4 b0 = {0.f, 0.f, 0.f, 0.f}, b1 = {0.f, 0.f, 0.f, 0.f};
            if (KIND < 2) { b0 = *(const f32x4*)(bsrc + (col & 511)); b1 = *(const f32x4*)(bsrc + (col & 511) + 4); }
#pragma unroll
            for (int ai = 0; ai < 2; ++ai)
#pragma unroll
                for (int m = 0; m < 4; ++m) { const int row = row0 + ai * HALF + m * 16; f32x4 v0 = acc[ai][bj][m][0] + b0, v1 = acc[ai][bj][m][1] + b1;
#pragma unroll
                    for (int i = 0; i < 4; ++i) {
                        if (KIND == 0) { const float n0 = -v0[i], n1 = -v1[i]; const float s0 = fmaxf(n0, 0.f) + __logf(1.0f + __expf(-fabsf(n0))), s1 = fmaxf(n1, 0.f) + __logf(1.0f + __expf(-fabsf(n1)));
                            v0[i] = __expf(-s0 - 0.5f); v1[i] = __expf(-s1 - 0.5f); }
                        else if (KIND == 1) { v0[i] = sigm(v0[i]); v1[i] = sigm(v1[i]); } }
                    u32x4 w; w.x = cvt_pk_bf16(v0[0], v0[1]); w.y = cvt_pk_bf16(v0[2], v0[3]); w.z = cvt_pk_bf16(v1[0], v1[1]); w.w = cvt_pk_bf16(v1[2], v1[3]);
                    *(u32x4*)(O + (size_t)row * 1536 + col) = w; } }
    }
    __device__ __forceinline__ void operator()(const f32x4 (&acc)[2][2][4][2], const Unit& u, int wr, int wc, int fr, int fq) const {
        const int kind = u.pn >> 1;
        if (kind == 0) run<0>(acc, u, wr, wc, fr, fq); else if (kind == 1) run<1>(acc, u, wr, wc, fr, fq); else run<2>(acc, u, wr, wc, fr, fq);
    }
};
template <class Epi, class Sched, bool ALIGN_EPI = false, bool SP2 = false>
__device__ __forceinline__ void gemm_phase(PG8_LAS unsigned char* lds, const Gemm g, const Sched& S, const Epi& E) {
    int tid_l = threadIdx.x; asm volatile("" : "+v"(tid_l));
    const int tid = tid_l, wid = __builtin_amdgcn_readfirstlane(tid >> 6), lane = tid & 63, wr = wid >> 2, wc = wid & 3, fr = lane & 15, fq = lane >> 4;
    const int K = g.K, nt = K / BK, lda = g.lda;
    unsigned voffA[2], voffB[2];
#pragma unroll
    for (int i = 0; i < 2; ++i) { int R, C; stage_rc(tid * 16 + i * 8192, R, C); const int Rb = Epi::PERM ? ((R & ~31) + perm32(R & 31)) : R;
        voffA[i] = (unsigned)(R * lda + C) * 2u; voffB[i] = (unsigned)(Rb * K + C) * 2u; }
    const size_t kstep = (size_t)(BK * 2);
    const size_t hstepB = (size_t)HALF * K * 2, hstepA = (size_t)HALF * lda * 2;
    const size_t tstepB = 2 * hstepB, tstepA = 2 * hstepA;
    const unsigned ldsw = (unsigned)wid * 1024u;
    const int aoff = lds_byte(wr * 64 + fr, fq * 8), boff = lds_byte(wc * 32 + fr, fq * 8);
#define PG8_SA(b, h) (((b) * 2 + (h)) * HTB)
#define PG8_SB(b, h) ((4 + (b) * 2 + (h)) * HTB)
#define PG8_STAGE(bufoff, gbase, voff) do { _Pragma("unroll") for (int _i = 0; _i < 2; ++_i) \
        __builtin_amdgcn_global_load_lds((const unsigned*)((const char*)(gbase) + (voff)[_i]), (PG8_LAS unsigned*)(lds + (bufoff) + ldsw + _i * 8192), 16, 0, 0); } while (0)
#define PG8_LDA(dst, b, h) do { _Pragma("unroll") for (int m = 0; m < 4; ++m) _Pragma("unroll") for (int k = 0; k < 2; ++k) dst[m][k] = *(const PG8_LAS bf16x8*)(lds + PG8_SA(b, h) + aoff + m * 2048 + k * 1024); } while (0)
#define PG8_LDB(dst, b, h) do { _Pragma("unroll") for (int n = 0; n < 2; ++n) _Pragma("unroll") for (int k = 0; k < 2; ++k) dst[n][k] = *(const PG8_LAS bf16x8*)(lds + PG8_SB(b, h) + boff + n * 2048 + k * 1024); } while (0)
#define PG8_MMA(ai, bj, At, Bt) do { __builtin_amdgcn_s_setprio(1); _Pragma("unroll") for (int m = 0; m < 4; ++m) _Pragma("unroll") for (int n = 0; n < 2; ++n) _Pragma("unroll") for (int k = 0; k < 2; ++k) \
        acc[ai][bj][m][n] = __builtin_amdgcn_mfma_f32_16x16x32_bf16(Bt[n][k], At[m][k], acc[ai][bj][m][n], 0, 0, 0); __builtin_amdgcn_s_setprio(0); } while (0)
#define PG8_WAIT_V(n) asm volatile("s_waitcnt vmcnt(" #n ")" ::: "memory")
#define PG8_WAIT_L(n) asm volatile("s_waitcnt lgkmcnt(" #n ")" ::: "memory")
#define PG8_BAR __builtin_amdgcn_s_barrier()
#define PG8_SCHED __builtin_amdgcn_sched_barrier(0)
    Unit cur, nxt; int ui = 0;
    if (!S.next(0, cur)) return;
    f32x4 acc[2][2][4][2];
#pragma unroll
    for (int a = 0; a < 2; ++a)
#pragma unroll
        for (int b = 0; b < 2; ++b)
#pragma unroll
            for (int m = 0; m < 4; ++m)
#pragma unroll
                for (int n = 0; n < 2; ++n) acc[a][b][m][n] = (f32x4){0.f, 0.f, 0.f, 0.f};
    bf16x8 At[4][2], B0[2][2], B1[2][2];
    const char* cA = (const char*)g.A + (size_t)cur.pm * tstepA; const char* cB = (const char*)g.Bt + (size_t)cur.pn * tstepB;
    S.a_ready(cur);
    if constexpr (SP2) {
        PG8_STAGE(PG8_SB(0, 0), cB, voffB); PG8_STAGE(PG8_SB(0, 1), cB + hstepB, voffB); PG8_STAGE(PG8_SA(0, 0), cA, voffA); PG8_STAGE(PG8_SA(0, 1), cA + hstepA, voffA);
        if (wr == 1) PG8_BAR;
        PG8_WAIT_V(2); PG8_BAR;
        PG8_STAGE(PG8_SB(1, 0), cB + kstep, voffB); PG8_STAGE(PG8_SA(1, 0), cA + kstep, voffA); PG8_STAGE(PG8_SB(1, 1), cB + hstepB + kstep, voffB);
        PG8_WAIT_V(6); PG8_BAR;
    } else {
        PG8_STAGE(PG8_SB(0, 0), cB, voffB); PG8_STAGE(PG8_SA(0, 0), cA, voffA); PG8_STAGE(PG8_SB(0, 1), cB + hstepB, voffB); PG8_STAGE(PG8_SA(0, 1), cA + hstepA, voffA);
        if (wr == 1) PG8_BAR;
        PG8_WAIT_V(4); PG8_BAR;
        PG8_STAGE(PG8_SB(1, 0), cB + kstep, voffB); PG8_STAGE(PG8_SA(1, 0), cA + kstep, voffA); PG8_STAGE(PG8_SB(1, 1), cB + hstepB + kstep, voffB);
        PG8_WAIT_V(6); PG8_BAR;
    }
    for (;;) {
        const bool has_next = S.next(ui + 1, nxt);
        const char* nA = has_next ? (const char*)g.A + (size_t)nxt.pm * tstepA : cA; const char* nB = has_next ? (const char*)g.Bt + (size_t)nxt.pn * tstepB : cB;
        for (int t = 0; t < nt; t += 2) {
            const bool last = (t == nt - 2);
            const char* a1 = cA + (size_t)(t + 1) * kstep;
            const char* a2 = last ? nA : cA + (size_t)(t + 2) * kstep; const char* b2 = last ? nB : cB + (size_t)(t + 2) * kstep;
            const char* a3 = a2 + kstep; const char* b3 = b2 + kstep;
            if (last && has_next) S.a_ready(nxt);
            if constexpr (SP2) {
            PG8_LDB(B0, 0, 0); PG8_LDB(B1, 0, 1); PG8_SCHED; PG8_LDA(At, 0, 0); PG8_STAGE(PG8_SA(1, 1), a1 + hstepA, voffA);
            PG8_WAIT_V(8); PG8_WAIT_L(0); PG8_BAR; PG8_MMA(0, 0, At, B0); PG8_MMA(0, 1, At, B1); PG8_BAR; PG8_SCHED;
            PG8_LDA(At, 0, 1); PG8_STAGE(PG8_SB(0, 0), b2, voffB); PG8_STAGE(PG8_SB(0, 1), b2 + hstepB, voffB); PG8_STAGE(PG8_SA(0, 0), a2, voffA);
            PG8_WAIT_V(8); PG8_WAIT_L(0); PG8_BAR; PG8_MMA(1, 0, At, B0); PG8_MMA(1, 1, At, B1); PG8_BAR; PG8_SCHED;
            PG8_LDB(B0, 1, 0); PG8_LDB(B1, 1, 1); PG8_SCHED; PG8_LDA(At, 1, 0); PG8_STAGE(PG8_SA(0, 1), a2 + hstepA, voffA);
            PG8_WAIT_V(8); PG8_WAIT_L(0); PG8_BAR; PG8_MMA(0, 0, At, B0); PG8_MMA(0, 1, At, B1); PG8_BAR; PG8_SCHED;
            PG8_LDA(At, 1, 1); PG8_STAGE(PG8_SB(1, 0), b3, voffB); PG8_STAGE(PG8_SB(1, 1), b3 + hstepB, voffB); PG8_STAGE(PG8_SA(1, 0), a3, voffA);
            PG8_WAIT_V(8); PG8_WAIT_L(0); PG8_BAR; PG8_MMA(1, 0, At, B0); PG8_MMA(1, 1, At, B1); PG8_BAR; PG8_SCHED;
            } else {
            PG8_LDB(B0, 0, 0); PG8_SCHED; PG8_LDA(At, 0, 0); PG8_STAGE(PG8_SA(1, 1), a1 + hstepA, voffA);
            PG8_WAIT_L(8); PG8_BAR; PG8_WAIT_L(0); PG8_MMA(0, 0, At, B0); PG8_BAR; PG8_SCHED;
            PG8_LDB(B1, 0, 1); PG8_STAGE(PG8_SB(0, 0), b2, voffB);
            PG8_BAR; PG8_WAIT_L(0); PG8_MMA(0, 1, At, B1); PG8_BAR;
            PG8_LDA(At, 0, 1); PG8_STAGE(PG8_SA(0, 0), a2, voffA);
            PG8_BAR; PG8_WAIT_L(0); PG8_MMA(1, 0, At, B0); PG8_BAR; PG8_SCHED;
            PG8_STAGE(PG8_SB(0, 1), b2 + hstepB, voffB);
            PG8_WAIT_V(6); PG8_BAR; PG8_MMA(1, 1, At, B1); PG8_BAR;
            PG8_LDB(B0, 1, 0); PG8_SCHED; PG8_LDA(At, 1, 0); PG8_STAGE(PG8_SA(0, 1), a2 + hstepA, voffA);
            PG8_WAIT_L(8); PG8_BAR; PG8_WAIT_L(0); PG8_MMA(0, 0, At, B0); PG8_BAR; PG8_SCHED;
            PG8_LDB(B1, 1, 1); PG8_STAGE(PG8_SB(1, 0), b3, voffB);
            PG8_BAR; PG8_WAIT_L(0); PG8_MMA(0, 1, At, B1); PG8_BAR;
            PG8_LDA(At, 1, 1); PG8_STAGE(PG8_SA(1, 0), a3, voffA);
            PG8_BAR; PG8_WAIT_L(0); PG8_MMA(1, 0, At, B0); PG8_BAR; PG8_SCHED;
            PG8_STAGE(PG8_SB(1, 1), b3 + hstepB, voffB);
            PG8_WAIT_V(6); PG8_BAR; PG8_MMA(1, 1, At, B1); PG8_BAR;
            }
        }
        if constexpr (ALIGN_EPI) { if (wr == 0) PG8_BAR; }
        if constexpr (!Epi::AFTER_DRAIN) { int tl2 = threadIdx.x; asm volatile("" : "+v"(tl2)); E(acc, cur, wr, wc, tl2 & 15, (tl2 & 63) >> 4); S.done(cur); }
        if (!has_next) break;
#pragma unroll
        for (int a = 0; a < 2; ++a)
#pragma unroll
            for (int b = 0; b < 2; ++b)
#pragma unroll
                for (int m = 0; m < 4; ++m)
#pragma unroll
                    for (int n = 0; n < 2; ++n) acc[a][b][m][n] = (f32x4){0.f, 0.f, 0.f, 0.f};
        cur = nxt; cA = nA; cB = nB; ++ui;
        if constexpr (ALIGN_EPI) { if (wr == 1) PG8_BAR; }
    }
    PG8_WAIT_V(0);
    if constexpr (!ALIGN_EPI) { if (wr == 0) PG8_BAR; }
    PG8_BAR;
    if constexpr (Epi::AFTER_DRAIN) { E.fused(acc, cur, wr, wc, fr, fq, lds, wid, lane); S.done(cur); }
#undef PG8_SA
#undef PG8_SB
#undef PG8_STAGE
#undef PG8_LDA
#undef PG8_LDB
#undef PG8_MMA
#undef PG8_WAIT_V
#undef PG8_WAIT_L
#undef PG8_BAR
#undef PG8_SCHED
}
}

#define LAS __attribute__((address_space(3)))
typedef unsigned short bf16;
typedef unsigned v4u __attribute__((ext_vector_type(4)));
typedef unsigned v2u __attribute__((ext_vector_type(2)));
typedef float f32x4 __attribute__((ext_vector_type(4)));
typedef short bf16x8 __attribute__((ext_vector_type(8)));

constexpr int T = 16384, SEQ = 2048, NP0 = 2816, NP1 = 3840, FF = 2816;
constexpr int NTHREADS = 512, NWAVES = 8;
constexpr int LDS_BYTES = 147456;
constexpr size_t MiB = 1u << 20;
constexpr size_t WS_CTL = 0, CTL_ZERO_BYTES = 65536;
constexpr size_t WS_ROWSS = 65536;
constexpr size_t WS_CARRY = 512 * 1024;
constexpr size_t WS_W = 1 * MiB;
constexpr size_t W_IN = WS_W, W_OUT = W_IN + 7680 * 1024, W_GU = W_OUT + 2 * MiB, W_DN = W_GU + 11 * MiB, W_PG = W_DN + 5632 * 1024, W_PP = W_PG + 2 * MiB,
                 W_LR = W_PP + 512 * 1024, W_LRU = W_LR + 768 * 1024, W_END = W_LRU + 128 * 1024;
static_assert(W_END <= 35 * MiB, "weights region");
constexpr size_t WS_HB = 35 * MiB;
constexpr size_t WS_PROJ = 67 * MiB;
constexpr size_t WS_Y = 187 * MiB;
constexpr size_t WS_GST = 219 * MiB;
constexpr size_t WS_ALR = 235 * MiB;
constexpr size_t WS_PB = 243 * MiB;
constexpr size_t WS_RKR = 251 * MiB;
constexpr size_t WS_GDEC = WS_RKR + 512 * 1024;
constexpr size_t WS_LEND = 252 * MiB;
constexpr size_t WS_END = 256 * MiB;

static_assert(E_ROWSS == WS_ROWSS && E_HB == WS_HB && E_PROJ == WS_PROJ && E_Y == WS_Y, "epilogue offsets");

__device__ __forceinline__ int fresh_s(int x) { asm volatile("" : "+s"(x)); return x; }
__device__ __forceinline__ int fresh_tid() { int t = threadIdx.x; asm volatile("" : "+v"(t)); return t; }
__device__ __forceinline__ float bf2f(unsigned v) { return __uint_as_float(v << 16); }
typedef float f32x2_t __attribute__((ext_vector_type(2))); typedef __bf16 bf16x2_t __attribute__((ext_vector_type(2)));
__device__ __forceinline__ unsigned pk2(float lo, float hi) { const f32x2_t v = {lo, hi}; const bf16x2_t b = __builtin_convertvector(v, bf16x2_t); return __builtin_bit_cast(unsigned, b); }
__device__ __forceinline__ unsigned f2bf(float f) { return pk2(f, f) & 0xffffu; }
__device__ __forceinline__ void unpack8(const v4u w, float* f) {
    f[0] = __uint_as_float(w.x << 16); f[1] = __uint_as_float(w.x & 0xffff0000u); f[2] = __uint_as_float(w.y << 16); f[3] = __uint_as_float(w.y & 0xffff0000u);
    f[4] = __uint_as_float(w.z << 16); f[5] = __uint_as_float(w.z & 0xffff0000u); f[6] = __uint_as_float(w.w << 16); f[7] = __uint_as_float(w.w & 0xffff0000u);
}
__device__ __forceinline__ v4u pack8(const float* f) { v4u w; w.x = pk2(f[0], f[1]); w.y = pk2(f[2], f[3]); w.z = pk2(f[4], f[5]); w.w = pk2(f[6], f[7]); return w; }
__device__ __forceinline__ void ld8(const bf16* p, float* f) { unpack8(*(const v4u*)p, f); }
__device__ __forceinline__ void ldf8(const float* p, float* f) { const f32x4 a = *(const f32x4*)p, b = *(const f32x4*)(p + 4); f[0] = a[0]; f[1] = a[1]; f[2] = a[2]; f[3] = a[3]; f[4] = b[0]; f[5] = b[1]; f[6] = b[2]; f[7] = b[3]; }
__device__ __forceinline__ float sigmf(float x) { return __builtin_amdgcn_rcpf(1.0f + __expf(-x)); }
__device__ __forceinline__ float logsigf(float z) { return fminf(z, 0.f) - __logf(1.0f + __expf(-fabsf(z))); }
__device__ __forceinline__ float wave_sum(float v) {
#pragma unroll
    for (int o = 1; o < 64; o <<= 1) v += __shfl_xor(v, o);
    return v;
}
#define LDS_WAIT() asm volatile("s_waitcnt lgkmcnt(0)" ::: "memory")

#define XB_TMO      128
#define XB_XCNT(j)  (256  + 64 * (j))
#define XB_XSUB(j)  (1280 + 64 * (j))
#define XB_XGEN(j)  (2304 + 64 * (j))
#define XB_TOP      3328
#define XB_TOPGEN   3392
#define XCD_BAR_WORDS 3456
#define XB_SPIN_CAP (1u << 18)

__device__ __forceinline__ unsigned xb_ld(unsigned* p)              { return __hip_atomic_load(p, __ATOMIC_RELAXED, __HIP_MEMORY_SCOPE_AGENT); }
__device__ __forceinline__ unsigned xb_add(unsigned* p, unsigned v) { return __hip_atomic_fetch_add(p, v, __ATOMIC_RELAXED, __HIP_MEMORY_SCOPE_AGENT); }
__device__ __forceinline__ unsigned xb_xcc_id() { return (unsigned)__builtin_amdgcn_s_getreg((3 << 11) | 20) & 0xFu; }
#define XB_SPIN(cond, bar) do { unsigned _sp = 0; while (cond) { __builtin_amdgcn_s_sleep(1); \
    if ((++_sp & 255u) == 0u) { if (xb_ld(&(bar)[XB_TMO])) break; if (_sp > XB_SPIN_CAP) { atomicAdd(&(bar)[XB_TMO], 1u); break; } } } } while (0)

struct XcdBarrier {
    unsigned* bar; unsigned x;
    volatile LAS unsigned* st;
};

__device__ __forceinline__ XcdBarrier xcd_barrier_post(unsigned* bar, volatile LAS unsigned* st) {
    XcdBarrier b; b.bar = bar; b.x = xb_xcc_id(); b.st = st;
    if (threadIdx.x == 0) (void)xb_add(&bar[XB_XCNT(b.x)], 1u);
    return b;
}
__device__ __forceinline__ void xcd_barrier_complete(unsigned* bar, unsigned x, unsigned& nloc, unsigned& nx) {
    const unsigned G = gridDim.x * gridDim.y * gridDim.z;
    unsigned sum, cnt, mine, sp = 0u;
    for (;;) {
        sum = 0u; cnt = 0u; mine = 0u;
#pragma unroll
        for (unsigned j = 0; j < 16; ++j) { const unsigned c = xb_ld(&bar[XB_XCNT(j)]); sum += c; cnt += (c > 0u) ? 1u : 0u; mine = (j == x) ? c : mine; }
        if (sum == G) break;
        __builtin_amdgcn_s_sleep(1);
        if ((++sp & 255u) == 0u) { if (xb_ld(&bar[XB_TMO])) break; if (sp > XB_SPIN_CAP) { atomicAdd(&bar[XB_TMO], 1u); break; } }
    }
    nloc = mine > 0u ? mine : 1u; nx = cnt > 0u ? cnt : 1u;
}

__device__ __forceinline__ void xcd_barrier(const XcdBarrier& b) {
    asm volatile("s_waitcnt vmcnt(0)" ::: "memory");
    __syncthreads();
    if (threadIdx.x == 0) {
        unsigned* bar = b.bar;
        __builtin_amdgcn_s_waitcnt(0);
        unsigned nloc = b.st[0], nx = b.st[1];
        if (nloc == 0u) { xcd_barrier_complete(bar, b.x, nloc, nx); b.st[0] = nloc; b.st[1] = nx; }
        const unsigned old = xb_add(&bar[XB_XSUB(b.x)], 1u);
        const unsigned gen = old / nloc;
        if (old + 1u == (gen + 1u) * nloc) {
            __builtin_amdgcn_fence(__ATOMIC_RELEASE, "agent");
            asm volatile("s_waitcnt vmcnt(0)" ::: "memory");
            const unsigned og = xb_add(&bar[XB_TOP], 1u);
            const unsigned tg = og / nx;
            if (og + 1u == (tg + 1u) * nx) xb_add(&bar[XB_TOPGEN], 1u);
            else XB_SPIN(xb_ld(&bar[XB_TOPGEN]) == tg, bar);
            __builtin_amdgcn_fence(__ATOMIC_ACQUIRE, "agent");
            xb_add(&bar[XB_XGEN(b.x)], 1u);
            asm volatile("s_waitcnt vmcnt(0)" ::: "memory");
        } else {
            XB_SPIN(xb_ld(&bar[XB_XGEN(b.x)]) == gen, bar);
            __builtin_amdgcn_fence(__ATOMIC_ACQUIRE, "agent");
            asm volatile("s_waitcnt vmcnt(0)" ::: "memory");
        }
    }
    __syncthreads();
}

constexpr size_t WS_XBAR = 16384;
constexpr int LDS_XST = LDS_BYTES - 64;

__device__ __forceinline__ f32x4 mma_ll(const LAS bf16* X, int ldx, const LAS bf16* Y, int ldy, int K, f32x4 acc, int lane) {
    const LAS bf16* xp = X + (lane & 15) * ldx + 8 * (lane >> 4);
    const LAS bf16* yp = Y + (lane & 15) * ldy + 8 * (lane >> 4);
    for (int k = 0; k < K; k += 32) {
        const bf16x8 a = *(const LAS bf16x8*)(xp + k), b = *(const LAS bf16x8*)(yp + k);
        acc = __builtin_amdgcn_mfma_f32_16x16x32_bf16(a, b, acc, 0, 0, 0);
    }
    return acc;
}
__device__ __forceinline__ f32x4 mma_lg(const LAS bf16* X, int ldx, const bf16* Y, int ldy, int K, f32x4 acc, int lane) {
    const LAS bf16* xp = X + (lane & 15) * ldx + 8 * (lane >> 4);
    const bf16* yp = Y + (size_t)(lane & 15) * ldy + 8 * (lane >> 4);
    for (int k = 0; k < K; k += 32) {
        const bf16x8 a = *(const LAS bf16x8*)(xp + k), b = *(const bf16x8*)(yp + k);
        acc = __builtin_amdgcn_mfma_f32_16x16x32_bf16(a, b, acc, 0, 0, 0);
    }
    return acc;
}

__device__ __forceinline__ void tr_load(const float* W, int ldw, const float* gain, int ncols, int item, int lane, f32x4 (&v)[8]) {
    const int nblk = ncols / 32, kb = item / nblk, nb = item % nblk, k0 = 64 * kb, n0 = 32 * nb;
#pragma unroll
    for (int i = 0; i < 8; ++i) { const int kk = 8 * i + (lane >> 3), cc = (lane & 7) * 4; v[i] = *(const f32x4*)(W + (size_t)(k0 + kk) * ldw + n0 + cc); if (gain) v[i] = v[i] * gain[k0 + kk]; }
}
__device__ __forceinline__ void tr_store(int K, bf16* WT, int ncols, int mode, LAS float* scr, int item, int lane, const f32x4 (&v)[8]) {
    const int nblk = ncols / 32, kb = item / nblk, nb = item % nblk, k0 = 64 * kb, n0 = 32 * nb;
#pragma unroll
    for (int i = 0; i < 8; ++i) { const int kk = 8 * i + (lane >> 3), cc = (lane & 7) * 4; scr[kk * 33 + cc] = v[i].x; scr[kk * 33 + cc + 1] = v[i].y; scr[kk * 33 + cc + 2] = v[i].z; scr[kk * 33 + cc + 3] = v[i].w; }
    LDS_WAIT(); asm volatile("" ::: "memory");
    const int c = lane & 7;
#pragma unroll
    for (int j = 0; j < 4; ++j) { const int n = (lane >> 3) + 8 * j; const LAS float* s = scr + (8 * c) * 33 + n;
        v4u o; o.x = pk2(s[0 * 33], s[1 * 33]); o.y = pk2(s[2 * 33], s[3 * 33]); o.z = pk2(s[4 * 33], s[5 * 33]); o.w = pk2(s[6 * 33], s[7 * 33]);
        const int nn = n0 + n; const int r = mode == 0 ? nn : (8 * (nn >> 2) + (nn & 3) + (mode == 2 ? 4 : 0));
        *(v4u*)(WT + (size_t)r * K + k0 + 8 * c) = o; }
    LDS_WAIT(); asm volatile("" ::: "memory");
}
__device__ __forceinline__ void tr_item(const float* W, int ldw, int K, const float* gain, bf16* WT, int ncols, int mode, LAS float* scr, int item, int lane) {
    f32x4 v[8]; tr_load(W, ldw, gain, ncols, item, lane, v); tr_store(K, WT, ncols, mode, scr, item, lane, v);
}
__device__ __forceinline__ void tr_job(const float* W, int ldw, int K, const float* gain, bf16* WT, int ncols, int mode, LAS unsigned char* lds, int gw, int NGW, int wave, int lane) {
    LAS float* scr = (LAS float*)(lds + wave * 8704);
    const int nitems = (K / 64) * (ncols / 32);
    for (int it = gw; it < nitems; it += NGW) tr_item(W, ldw, K, gain, WT, ncols, mode, scr, it, lane);
}
__device__ __forceinline__ void cvt_layer_weights(PRef p, int li, LAS unsigned char* lds, int gw, int NGW, int wave, int lane) {
    unsigned char* ws = p.ws;
    tr_job(li == 0 ? p.in[14] : p.in[27], 1024, 1024, nullptr, (bf16*)(ws + W_OUT), 1024, 0, lds, gw, NGW, wave, lane);
    tr_job(p.in[30] + (size_t)li * 1024 * FF, FF, 1024, p.in[29] + li * 1024, (bf16*)(ws + W_GU), FF, 1, lds, gw, NGW, wave, lane);
    tr_job(p.in[31] + (size_t)li * 1024 * FF, FF, 1024, p.in[29] + li * 1024, (bf16*)(ws + W_GU), FF, 2, lds, gw, NGW, wave, lane);
    tr_job(p.in[32] + (size_t)li * FF * 1024, 1024, FF, nullptr, (bf16*)(ws + W_DN), 1024, 0, lds, gw, NGW, wave, lane);
    tr_job(p.in[34] + (size_t)li * 1024 * 1024, 1024, 1024, p.in[33] + li * 1024, (bf16*)(ws + W_PG), 1024, 0, lds, gw, NGW, wave, lane);
    tr_job(p.in[36] + (size_t)li * 256 * 1024, 1024, 256, nullptr, (bf16*)(ws + W_PP), 1024, 0, lds, gw, NGW, wave, lane);
}
__device__ __forceinline__ void cvt_p(PRef p, int li, int gw, int NGW, int lane) {
    const float* src = p.in[1] + (size_t)li * T * 256; bf16* pb = (bf16*)(p.ws + WS_PB);
    for (int m = gw; m < T; m += NGW) { const f32x4 v = *((const f32x4*)(src + (size_t)m * 256) + lane); v2u o; o.x = pk2(v.x, v.y); o.y = pk2(v.z, v.w); *((v2u*)(pb + (size_t)m * 256) + lane) = o; }
}

constexpr int CVT1_ITEMS = 512 + 3 * 1408 + 512 + 128 + 1024;
struct Cvt1Job { const float* W; const float* gain; bf16* WT; int ldw, K, ncols, mode, item; };
__device__ __forceinline__ Cvt1Job cvt1_job(PRef p, int idx) {
    unsigned char* ws = p.ws; Cvt1Job j;
    if (idx < 512) { j = Cvt1Job{p.in[27], nullptr, (bf16*)(ws + W_OUT), 1024, 1024, 1024, 0, idx}; return j; } idx -= 512;
    if (idx < 1408) { j = Cvt1Job{p.in[30] + (size_t)1024 * FF, p.in[29] + 1024, (bf16*)(ws + W_GU), FF, 1024, FF, 1, idx}; return j; } idx -= 1408;
    if (idx < 1408) { j = Cvt1Job{p.in[31] + (size_t)1024 * FF, p.in[29] + 1024, (bf16*)(ws + W_GU), FF, 1024, FF, 2, idx}; return j; } idx -= 1408;
    if (idx < 1408) { j = Cvt1Job{p.in[32] + (size_t)FF * 1024, nullptr, (bf16*)(ws + W_DN), 1024, FF, 1024, 0, idx}; return j; } idx -= 1408;
    if (idx < 512) { j = Cvt1Job{p.in[34] + (size_t)1024 * 1024, p.in[33] + 1024, (bf16*)(ws + W_PG), 1024, 1024, 1024, 0, idx}; return j; } idx -= 512;
    j = Cvt1Job{p.in[36] + (size_t)256 * 1024, nullptr, (bf16*)(ws + W_PP), 1024, 256, 1024, 0, idx}; return j;
}
constexpr int CVT1_W_ITEMS = CVT1_ITEMS - 1024;
__device__ __forceinline__ void cvt1_load(PRef p, int idx, int lane, f32x4 (&v)[8]) {
    if (idx < CVT1_W_ITEMS) { const Cvt1Job j = cvt1_job(p, idx); tr_load(j.W, j.ldw, j.gain, j.ncols, j.item, lane, v); }
    else { const float* src = p.in[1] + (size_t)T * 256 + (size_t)(idx - CVT1_W_ITEMS) * 16 * 256;
#pragma unroll
        for (int r = 0; r < 8; ++r) v[r] = *((const f32x4*)(src + (size_t)r * 256) + lane); }
}
__device__ __forceinline__ void cvt1_store(PRef p, int idx, LAS float* scr, int lane, const f32x4 (&v)[8]) {
    if (idx < CVT1_W_ITEMS) { const Cvt1Job j = cvt1_job(p, idx); tr_store(j.K, j.WT, j.ncols, j.mode, scr, j.item, lane, v); }
    else { const int m0 = (idx - CVT1_W_ITEMS) * 16; const float* src = p.in[1] + (size_t)T * 256; bf16* pb = (bf16*)(p.ws + WS_PB);
#pragma unroll
        for (int r = 0; r < 8; ++r) { v2u o; o.x = pk2(v[r].x, v[r].y); o.y = pk2(v[r].z, v[r].w); *((v2u*)(pb + (size_t)(m0 + r) * 256) + lane) = o; }
        for (int r = 8; r < 16; ++r) { const f32x4 w = *((const f32x4*)(src + (size_t)(m0 + r) * 256) + lane); v2u o; o.x = pk2(w.x, w.y); o.y = pk2(w.z, w.w); *((v2u*)(pb + (size_t)(m0 + r) * 256) + lane) = o; } }
}
__device__ __forceinline__ void cvt1_flat(PRef p, int idx, LAS float* scr, int lane) { f32x4 v[8]; cvt1_load(p, idx, lane, v); cvt1_store(p, idx, scr, lane, v); }
__device__ __forceinline__ void phase_prologue(PRef p, LAS unsigned char* lds, int gw, int NGW, int wave, int lane) {
    unsigned char* ws = p.ws; const int gtid = gw * 64 + lane, NGT = NGW * 64;
    tr_job(p.in[3], 2576, 1024, p.in[28], (bf16*)(ws + W_IN), 2560, 0, lds, gw, NGW, wave, lane);
    for (int it = gtid; it < 256 * 128; it += NGT) { const int n = it >> 7, kc = it & 127; float o[8];
#pragma unroll
        for (int i = 0; i < 8; ++i) { const int k = 8 * kc + i; const float* wr = p.in[3] + (size_t)k * 2576 + 2560; float s = 0.f;
#pragma unroll
            for (int r = 0; r < 16; ++r) s += wr[r] * p.in[11][r * 256 + n];
            o[i] = s * p.in[28][k]; }
        *(v4u*)((bf16*)(ws + W_IN) + (size_t)(2560 + n) * 1024 + 8 * kc) = pack8(o); }
    cvt_layer_weights(p, 0, lds, gw, NGW, wave, lane);
    for (int it = gtid; it < 1536 * 32; it += NGT) { const int n = it >> 5, kc = it & 31; float o[8];
#pragma unroll
        for (int i = 0; i < 8; ++i) { const int k = 8 * kc + i; float v = 0.f;
            if (n < 512) { if (k < 64) v = p.in[19][k * 512 + n]; }
            else if (n < 1024) { if (k >= 64 && k < 128) v = p.in[21][(k - 64) * 512 + (n - 512)]; }
            else { if (k >= 128) v = p.in[22][(k - 128) * 512 + (n - 1024)]; }
            o[i] = v; }
        *(v4u*)((bf16*)(ws + W_LR) + (size_t)n * 256 + 8 * kc) = pack8(o); }
    for (int it = gtid; it < 2 * 8 * 64 * 8; it += NGT) { const int ic = it & 7, j = (it >> 3) & 63, g = (it >> 9) & 7, which = it >> 12; const float* src = which ? p.in[8] : p.in[6]; float o[8];
#pragma unroll
        for (int i = 0; i < 8; ++i) o[i] = src[(g * 64 + 8 * ic + i) * 64 + j];
        *(v4u*)((bf16*)(ws + W_LRU) + (size_t)which * 32768 + (g * 64 + j) * 64 + 8 * ic) = pack8(o); }
    { const float* x = p.in[0]; bf16* hb = (bf16*)(ws + WS_HB); float* rss = (float*)(ws + WS_ROWSS);
      for (int m = gw; m < T; m += NGW) { const f32x4* xr = (const f32x4*)(x + (size_t)m * 1024) + lane; float s = 0.f; v2u* o8 = (v2u*)(hb + (size_t)m * 1024) + lane;
#pragma unroll
          for (int j = 0; j < 4; ++j) { const f32x4 v = xr[64 * j]; s += (v.x * v.x + v.y * v.y) + (v.z * v.z + v.w * v.w); v2u o; o.x = pk2(v.x, v.y); o.y = pk2(v.z, v.w); o8[64 * j] = o; }
          s = wave_sum(s); if (lane == 0) rss[m] = s; } }
    cvt_p(p, 0, gw, NGW, lane);
}

__device__ __forceinline__ void lru_local_item(PRef p, LAS unsigned char* lds, int item, int tid, int wave, int lane) {
    const int c = item & 31, b = item >> 5;
    const bf16* proj = (const bf16*)(p.ws + WS_PROJ);
    constexpr int LX = 520;
    constexpr int LR = 65;
    LAS bf16* Xs = (LAS bf16*)lds; LAS float* R = (LAS float*)(lds + 66560); LAS float* I = (LAS float*)(lds + 66560 + 16640);
    LAS float* SEGH = (LAS float*)(lds + 66560 + 33280); LAS float* SEGP = SEGH + 512;
    const int tl = tid >> 3, c8 = (tid & 7) * 8, t0 = b * SEQ + 64 * c;
    LAS float* LS = SEGP + 512; LAS float* BR = LS + 512; LAS float* BI = BR + 512; LAS float* CARH = BI + 512; LAS float* CARP = CARH + 512;
    LS[tid] = logsigf(p.in[10][tid]); BR[tid] = p.in[7][tid]; BI[tid] = p.in[9][tid];
#pragma unroll 2
    for (int g = 0; g < 8; ++g) { const int ch0 = 64 * g + c8; f32x4 a0 = *(const f32x4*)(p.in[5] + ch0), a1 = *(const f32x4*)(p.in[5] + ch0 + 4);
#pragma unroll
        for (int k = 0; k < 4; ++k) { const int tt = 64 * c + tl - 3 + k; if (tt >= 0) { float xv[8]; ld8(proj + (size_t)(b * SEQ + tt) * NP0 + ch0, xv);
                const f32x4 w0 = *(const f32x4*)(p.in[4] + k * 512 + ch0), w1 = *(const f32x4*)(p.in[4] + k * 512 + ch0 + 4);
                a0 = a0 + w0 * (f32x4){xv[0], xv[1], xv[2], xv[3]}; a1 = a1 + w1 * (f32x4){xv[4], xv[5], xv[6], xv[7]}; } }
        const float av[8] = {a0[0], a0[1], a0[2], a0[3], a1[0], a1[1], a1[2], a1[3]};
        *(LAS v4u*)(Xs + tl * LX + ch0) = pack8(av); }
    __syncthreads();
    const int rt = wave & 3, gate = wave >> 2, q = lane >> 4;
    const bf16* WTb = (const bf16*)(p.ws + W_LRU) + gate * 32768 + (size_t)(lane & 15) * 64 + 8 * q;
    bf16x8 wf[4][2];
#pragma unroll
    for (int ct = 0; ct < 4; ++ct) { wf[ct][0] = *(const bf16x8*)(WTb + 16 * ct * 64); wf[ct][1] = *(const bf16x8*)(WTb + 16 * ct * 64 + 32); }
    for (int g = 0; g < 8; ++g) { const int ch0 = 64 * g + c8;
        { LAS float* dst = gate ? I : R; const LAS float* bias = gate ? BI : BR;
          const LAS bf16* xp = Xs + (16 * rt + (lane & 15)) * LX + 64 * g + 8 * q; const bf16x8 a0 = *(const LAS bf16x8*)xp, a1 = *(const LAS bf16x8*)(xp + 32);
          f32x4 acc[4];
#pragma unroll
          for (int ct = 0; ct < 4; ++ct) { acc[ct] = (f32x4){0.f, 0.f, 0.f, 0.f}; acc[ct] = __builtin_amdgcn_mfma_f32_16x16x32_bf16(a0, wf[ct][0], acc[ct], 0, 0, 0); acc[ct] = __builtin_amdgcn_mfma_f32_16x16x32_bf16(a1, wf[ct][1], acc[ct], 0, 0, 0); }
          { const int gn = g < 7 ? g + 1 : 7;
#pragma unroll
            for (int ct = 0; ct < 4; ++ct) { wf[ct][0] = *(const bf16x8*)(WTb + gn * 4096 + 16 * ct * 64); wf[ct][1] = *(const bf16x8*)(WTb + gn * 4096 + 16 * ct * 64 + 32); } }
#pragma unroll
          for (int ct = 0; ct < 4; ++ct) { const int ch = 16 * ct + (lane & 15); const float bv = bias[64 * g + ch];
#pragma unroll
              for (int j = 0; j < 4; ++j) dst[(16 * rt + 4 * q + j) * LR + ch] = sigmf(acc[ct][j] + bv); } }
        __syncthreads();
        {
#pragma unroll
          for (int i = 0; i < 8; ++i) { const float r = R[tl * LR + c8 + i], ii = I[tl * LR + c8 + i], xc = bf2f(Xs[tl * LX + ch0 + i]);
              const float la = 8.0f * r * LS[ch0 + i]; const float a = __expf(la); const float u = __builtin_amdgcn_sqrtf(fmaxf(1.0f - a * a, 0.f)) * (ii * xc);
              R[tl * LR + c8 + i] = a; I[tl * LR + c8 + i] = u; } }
        __syncthreads();
        { const int ch = tid & 63, seg = tid >> 6; float h = 0.f, P = 1.f;
#pragma unroll
          for (int t = 8 * seg; t < 8 * seg + 8; ++t) { const float a = R[t * LR + ch], u = I[t * LR + ch]; h = a * h + u; P *= a; I[t * LR + ch] = h; R[t * LR + ch] = P; }
          SEGH[seg * 64 + ch] = h; SEGP[seg * 64 + ch] = P; }
        __syncthreads();
        { const int ch = tid & 63, seg = tid >> 6; float ch_ = 0.f, cp_ = 1.f;
#pragma unroll
          for (int s2 = 0; s2 < 7; ++s2) { const float sp = SEGP[s2 * 64 + ch], sh = SEGH[s2 * 64 + ch]; if (s2 < seg) { ch_ = sp * ch_ + sh; cp_ *= sp; } }
          CARH[seg * 64 + ch] = ch_; CARP[seg * 64 + ch] = cp_; }
        __syncthreads();
        { bf16* hl = (bf16*)(p.ws + WS_HB); bf16* Pc = hl + (size_t)T * 512; const int seg = tl >> 3; float ho[8], po[8];
#pragma unroll
          for (int i = 0; i < 8; ++i) { const int ch = c8 + i; const float pl = R[tl * LR + ch]; ho[i] = I[tl * LR + ch] + pl * CARH[seg * 64 + ch]; po[i] = pl * CARP[seg * 64 + ch]; }
          *(v4u*)(hl + (size_t)(t0 + tl) * 512 + ch0) = pack8(ho); *(v4u*)(Pc + (size_t)(t0 + tl) * 512 + ch0) = pack8(po);
          if (tl == 63) { float* pe = (float*)(p.ws + WS_LEND);
#pragma unroll
              for (int i = 0; i < 8; ++i) { pe[(b * 32 + c) * 512 + ch0 + i] = po[i]; pe[131072 + (b * 32 + c) * 512 + ch0 + i] = ho[i]; } } }
        __syncthreads();
    }
}
__device__ __forceinline__ void lru_prefix(PRef p, int gtid, int NGT) {
    const float* pe = (const float*)(p.ws + WS_LEND); float* ci = (float*)(p.ws + WS_CARRY);
    for (int it = gtid; it < 4096; it += NGT) { const int b = it >> 9, ch = it & 511; float carry = 0.f; float pv[32], hv[32];
#pragma unroll
        for (int c = 0; c < 32; ++c) { const int o = (b * 32 + c) * 512 + ch; pv[c] = pe[o]; hv[c] = pe[131072 + o]; }
#pragma unroll
        for (int c = 0; c < 32; ++c) { const int o = (b * 32 + c) * 512 + ch; ci[o] = carry; carry = pv[c] * carry + hv[c]; } }
}
__device__ __forceinline__ float tanh_fast(float u) { return 1.0f - 2.0f * __builtin_amdgcn_rcpf(1.0f + __expf(2.0f * u)); }
__device__ __forceinline__ float gelu_tanh(float x) { const float u = 0.7978845608028654f * (x + 0.044715f * x * x * x); return 0.5f * x * (1.0f + tanh_fast(u)); }
__device__ __forceinline__ void lru_out(PRef p, int gtid, int NGT) {
    const bf16* proj = (const bf16*)(p.ws + WS_PROJ); const bf16* hl = (const bf16*)(p.ws + WS_HB); const bf16* Pc = hl + (size_t)T * 512; const float* ci = (const float*)(p.ws + WS_CARRY);
    bf16* y = (bf16*)(p.ws + WS_Y);
    int it = gtid; if (it >= T * 64) return;
    v4u rh, rp, rg; f32x4 c0, c1;
    { const int row = it >> 6, c8 = (it & 63) * 8, b = row >> 11, c = (row & 2047) >> 6; rh = *(const v4u*)(hl + (size_t)row * 512 + c8); rp = *(const v4u*)(Pc + (size_t)row * 512 + c8); rg = *(const v4u*)(proj + (size_t)row * NP0 + 512 + c8);
      const float* cp = ci + (b * 32 + c) * 512 + c8; c0 = *(const f32x4*)cp; c1 = *(const f32x4*)(cp + 4); }
    for (;;) { const int nx = it + NGT; const bool more = nx < T * 64; v4u nh = rh, np = rp, ng = rg; f32x4 n0 = c0, n1 = c1;
        if (more) { const int row = nx >> 6, c8 = (nx & 63) * 8, b = row >> 11, c = (row & 2047) >> 6; nh = *(const v4u*)(hl + (size_t)row * 512 + c8); np = *(const v4u*)(Pc + (size_t)row * 512 + c8); ng = *(const v4u*)(proj + (size_t)row * NP0 + 512 + c8);
            const float* cp = ci + (b * 32 + c) * 512 + c8; n0 = *(const f32x4*)cp; n1 = *(const f32x4*)(cp + 4); }
        { const int row = it >> 6, c8 = (it & 63) * 8; float h[8], P[8], gt[8], o[8]; unpack8(rh, h); unpack8(rp, P); unpack8(rg, gt); const float cr[8] = {c0[0], c0[1], c0[2], c0[3], c1[0], c1[1], c1[2], c1[3]};
#pragma unroll
          for (int i = 0; i < 8; ++i) o[i] = (h[i] + P[i] * cr[i]) * gelu_tanh(gt[i]);
          *(v4u*)(y + (size_t)row * 1024 + c8) = pack8(o); }
        if (!more) break; it = nx; rh = nh; rp = np; rg = ng; c0 = n0; c1 = n1; }
}

template <bool RET> struct LA {
    static constexpr int DK = RET ? 128 : 64, C = RET ? 128 : 64, NCH = SEQ / C, TPT = NTHREADS / C, KPT = DK / TPT, VPT = 128 / TPT, LQ = DK + 8, LT = C + 8;
    static constexpr int O_QS = 0, O_KS = O_QS + C * LQ * 2, O_VT = O_KS + C * LQ * 2, O_SC = O_VT + 128 * LT * 2, O_F = O_SC + C * LT * 2, O_OF = RET ? 0 : O_F + 16640;
    static constexpr int O_KT = O_QS;
    static_assert(DK * LT * 2 <= 2 * C * LQ * 2, "Kt fits");
    static_assert(RET ? (O_SC + C * LT * 2 <= LDS_BYTES - 256 && 128 * 133 * 4 <= 2 * 128 * 136 * 2) : (O_OF + 64 * 133 * 4 <= 98304 && 98304 + 2048 <= LDS_BYTES - 256), "LA LDS");
};
__device__ __forceinline__ void gla_cum(PRef p, LAS unsigned char* lds, const bf16* proj, int t0, int h, int tid) {
    LAS float* F = (LAS float*)(lds + LA<false>::O_F); const int tl = tid >> 3, c8 = (tid & 7) * 8;
    float z[8], bg[8]; ld8(proj + (size_t)(t0 + tl) * NP0 + 2560 + 64 * h + c8, z); ldf8(p.in[12] + 64 * h + c8, bg);
#pragma unroll
    for (int i = 0; i < 8; ++i) F[tl * 65 + c8 + i] = logsigf(z[i] + bg[i]) * (1.0f / 16.0f);
    __syncthreads();
    LAS float* SEG = (LAS float*)(lds + 98304);
    { const int ch = tid & 63, seg = tid >> 6; float run = 0.f;
#pragma unroll
      for (int t = 8 * seg; t < 8 * seg + 8; ++t) { run += F[t * 65 + ch]; F[t * 65 + ch] = run; }
      SEG[seg * 64 + ch] = run; }
    __syncthreads();
    { const int ch = tid & 63, seg = tid >> 6; float off = 0.f;
#pragma unroll
      for (int s2 = 0; s2 < 7; ++s2) { const float v = SEG[s2 * 64 + ch]; if (s2 < seg) off += v; }
#pragma unroll
      for (int t = 8 * seg; t < 8 * seg + 8; ++t) F[t * 65 + ch] += off; }
    __syncthreads();
}
template <bool RET> __device__ __forceinline__ void la_load_vt(LAS unsigned char* lds, const bf16* vsrc  , int ld, int tid) {
    typedef LA<RET> L; LAS bf16* Vt = (LAS bf16*)(lds + L::O_VT); const int tl = tid / L::TPT, v0 = (tid % L::TPT) * L::VPT;
#pragma unroll
    for (int s = 0; s < L::VPT / 8; ++s) { float v[8]; ld8(vsrc + (size_t)tl * ld + v0 + 8 * s, v);
#pragma unroll
        for (int i = 0; i < 8; ++i) Vt[(v0 + 8 * s + i) * L::LT + tl] = (bf16)f2bf(v[i]); }
}
__device__ __forceinline__ void rot_cs(int pos_i, int part, float* cs, float* sn) {
    const float pos = (float)pos_i;
#pragma unroll
    for (int i = 0; i < 16; ++i) { const float invr = __builtin_amdgcn_exp2f(-(float)(16 * part + i) * (13.287712379549449f / 64.0f)) * 0.15915494309189535f;
        const float hi = __uint_as_float(__float_as_uint(invr) & 0xfffff000u), lo = invr - hi;
        const float rev = __builtin_amdgcn_fractf(pos * hi) + pos * lo;
        sn[i] = __builtin_amdgcn_sinf(rev); cs[i] = __builtin_amdgcn_cosf(rev); }
}
__device__ __forceinline__ void ret_rot16(const bf16* src, const float* cs, const float* sn, int part, float* o1, float* o2) {
    float x1[16], x2[16]; ld8(src + 16 * part, x1); ld8(src + 16 * part + 8, x1 + 8); ld8(src + 64 + 16 * part, x2); ld8(src + 64 + 16 * part + 8, x2 + 8);
#pragma unroll
    for (int i = 0; i < 16; ++i) { o1[i] = x1[i] * cs[i] - x2[i] * sn[i]; o2[i] = x2[i] * cs[i] + x1[i] * sn[i]; }
}

template <bool RET> __device__ __forceinline__ void la_local_item(PRef p, LAS unsigned char* lds, int item, int tid, int wave, int lane) {
    typedef LA<RET> L; const int c = item % L::NCH, h = (item / L::NCH) & 3, b = item / (L::NCH * 4), t0 = b * SEQ + L::C * c;
    const bf16* proj = (const bf16*)(p.ws + WS_PROJ); LAS bf16* Kt = (LAS bf16*)(lds + L::O_KT); LAS bf16* Vt = (LAS bf16*)(lds + L::O_VT);
    bf16* state = RET ? (bf16*)(p.ws + WS_HB) : (bf16*)(p.ws + WS_GST);
    if (!RET) {
        la_load_vt<false>(lds, proj + (size_t)t0 * NP0 + 1536 + 128 * h, NP0, tid);
        const int tl = tid >> 3, c8 = (tid & 7) * 8; const v4u kraw = *(const v4u*)(proj + (size_t)(t0 + tl) * NP0 + 1280 + 64 * h + c8);
        gla_cum(p, lds, proj, t0, h, tid);
        LAS float* F = (LAS float*)(lds + L::O_F); float kv[8]; unpack8(kraw, kv);
#pragma unroll
        for (int i = 0; i < 8; ++i) { const float ge = F[63 * 65 + c8 + i], gt = F[tl * 65 + c8 + i]; Kt[(c8 + i) * L::LT + tl] = (bf16)f2bf(kv[i] * __expf(ge - gt));
            if (tl == 63) ((float*)(p.ws + WS_GDEC))[item * 64 + c8 + i] = __expf(ge); }
    } else {
        la_load_vt<true>(lds, proj + (size_t)t0 * NP1 + 1024 + 128 * h, NP1, tid);
        const int tl = tid >> 2, part = tid & 3; float cs[16], sn[16]; rot_cs(((const int*)p.in[2])[t0 + tl], part, cs, sn); const float lg = log1pf(-exp2f(-5.0f - (float)h));
        float k1[16], k2[16]; ret_rot16(proj + (size_t)(t0 + tl) * NP1 + 512 + 128 * h, cs, sn, part, k1, k2); const float f = __expf((float)(127 - tl) * lg);
#pragma unroll
        for (int i = 0; i < 16; ++i) { Kt[(16 * part + i) * L::LT + tl] = (bf16)f2bf(k1[i] * f); Kt[(64 + 16 * part + i) * L::LT + tl] = (bf16)f2bf(k2[i] * f); }
    }
    __syncthreads();
    { const int q = lane >> 4; bf16* dst = state + (size_t)item * 128 * L::DK;
      for (int kt = 0; kt < L::DK / 16; ++kt) { f32x4 acc = {0.f, 0.f, 0.f, 0.f}; acc = mma_ll(Vt + 16 * wave * L::LT, L::LT, Kt + 16 * kt * L::LT, L::LT, L::C, acc, lane);
#pragma unroll
          for (int j = 0; j < 4; ++j) dst[(16 * wave + 4 * q + j) * L::DK + 16 * kt + (lane & 15)] = (bf16)f2bf(acc[j]); } }
    __syncthreads();
}
template <bool RET> __device__ __forceinline__ void la_prefix(PRef p, int gtid, int NGT) {
    typedef LA<RET> L; constexpr int NP = 128 * L::DK / 2; unsigned* state = RET ? (unsigned*)(p.ws + WS_HB) : (unsigned*)(p.ws + WS_GST); const float* dec = (const float*)(p.ws + WS_GDEC);
    for (int it = gtid; it < 32 * NP; it += NGT) { const int bh = it / NP, pe = it % NP, k = (2 * pe) % L::DK; float s0 = 0.f, s1 = 0.f;
        unsigned w[L::NCH]; float d0[L::NCH], d1[L::NCH];
        float dr = 0.f; if (RET) { const float lg = log1pf(-exp2f(-5.0f - (float)(bh & 3))); dr = __expf(128.0f * lg); }
#pragma unroll
        for (int c = 0; c < L::NCH; ++c) { w[c] = state[(size_t)(bh * L::NCH + c) * NP + pe];
            if (RET) { d0[c] = dr; d1[c] = dr; } else { d0[c] = dec[(bh * L::NCH + c) * 64 + k]; d1[c] = dec[(bh * L::NCH + c) * 64 + k + 1]; } }
#pragma unroll
        for (int c = 0; c < L::NCH; ++c) { state[(size_t)(bh * L::NCH + c) * NP + pe] = pk2(s0, s1);
            s0 = s0 * d0[c] + __uint_as_float(w[c] << 16); s1 = s1 * d1[c] + __uint_as_float(w[c] & 0xffff0000u); } }
}
template <bool RET> __device__ __forceinline__ void la_out_item(PRef p, LAS unsigned char* lds, int item, int tid, int wave, int lane) {
    typedef LA<RET> L; const int c = item % L::NCH, h = (item / L::NCH) & 3, b = item / (L::NCH * 4), t0 = b * SEQ + L::C * c;
    bf16* proj = (bf16*)(p.ws + WS_PROJ); LAS bf16* Qs = (LAS bf16*)(lds + L::O_QS); LAS bf16* Ks = (LAS bf16*)(lds + L::O_KS); LAS bf16* Vt = (LAS bf16*)(lds + L::O_VT); LAS bf16* Sc = (LAS bf16*)(lds + L::O_SC);
    LAS float* Of = (LAS float*)(lds + L::O_OF);
    const bf16* state = (RET ? (const bf16*)(p.ws + WS_HB) : (const bf16*)(p.ws + WS_GST)) + (size_t)item * 128 * L::DK;
    float inter_scale = 1.0f;
    const int ptl = tid / L::TPT, pv0 = (tid % L::TPT) * L::VPT;
    const bf16* gsrc0 = RET ? proj + (size_t)(t0 + ptl) * NP1 + 1536 + 128 * h + pv0 : proj + (size_t)(t0 + ptl) * NP0 + 2048 + 128 * h + pv0;
    const float* gn0 = (RET ? p.in[16] : p.in[13]) + 128 * h + pv0;
    v4u graw[L::VPT / 8]; f32x4 gnr[L::VPT / 4];
#pragma unroll
    for (int s8 = 0; s8 < L::VPT / 8; ++s8) graw[s8] = *(const v4u*)(gsrc0 + 8 * s8);
#pragma unroll
    for (int s4 = 0; s4 < L::VPT / 4; ++s4) gnr[s4] = *(const f32x4*)(gn0 + 4 * s4);
    if (!RET) {
        la_load_vt<false>(lds, proj + (size_t)t0 * NP0 + 1536 + 128 * h, NP0, tid);
        const int tl = tid >> 3, c8 = (tid & 7) * 8; const v4u qraw = *(const v4u*)(proj + (size_t)(t0 + tl) * NP0 + 1024 + 64 * h + c8), kraw = *(const v4u*)(proj + (size_t)(t0 + tl) * NP0 + 1280 + 64 * h + c8);
        gla_cum(p, lds, proj, t0, h, tid);
        LAS float* F = (LAS float*)(lds + L::O_F); float qv[8], kv[8], qo[8], ko[8]; unpack8(qraw, qv); unpack8(kraw, kv);
#pragma unroll
        for (int i = 0; i < 8; ++i) { const float gt = F[tl * 65 + c8 + i]; qo[i] = qv[i] * 0.125f * __expf(gt); ko[i] = kv[i] * __expf(-gt); }
        *(LAS v4u*)(Qs + tl * L::LQ + c8) = pack8(qo); *(LAS v4u*)(Ks + tl * L::LQ + c8) = pack8(ko);
    } else {
        la_load_vt<true>(lds, proj + (size_t)t0 * NP1 + 1024 + 128 * h, NP1, tid);
        const int tl = tid >> 2, part = tid & 3; float cs[16], sn[16]; rot_cs(((const int*)p.in[2])[t0 + tl], part, cs, sn); const float lg = log1pf(-exp2f(-5.0f - (float)h)); inter_scale = __expf(lg);
        float a1[16], a2[16];
        ret_rot16(proj + (size_t)(t0 + tl) * NP1 + 128 * h, cs, sn, part, a1, a2); const float fq_ = 0.08838834764831845f * __expf((float)tl * lg);
#pragma unroll
        for (int i = 0; i < 16; ++i) { a1[i] *= fq_; a2[i] *= fq_; }
        *(LAS v4u*)(Qs + tl * L::LQ + 16 * part) = pack8(a1); *(LAS v4u*)(Qs + tl * L::LQ + 16 * part + 8) = pack8(a1 + 8);
        *(LAS v4u*)(Qs + tl * L::LQ + 64 + 16 * part) = pack8(a2); *(LAS v4u*)(Qs + tl * L::LQ + 64 + 16 * part + 8) = pack8(a2 + 8);
        ret_rot16(proj + (size_t)(t0 + tl) * NP1 + 512 + 128 * h, cs, sn, part, a1, a2); const float fk_ = __expf(-(float)tl * lg);
#pragma unroll
        for (int i = 0; i < 16; ++i) { a1[i] *= fk_; a2[i] *= fk_; }
        *(LAS v4u*)(Ks + tl * L::LQ + 16 * part) = pack8(a1); *(LAS v4u*)(Ks + tl * L::LQ + 16 * part + 8) = pack8(a1 + 8);
        *(LAS v4u*)(Ks + tl * L::LQ + 64 + 16 * part) = pack8(a2); *(LAS v4u*)(Ks + tl * L::LQ + 64 + 16 * part + 8) = pack8(a2 + 8);
    }
    bf16x8 sf[4][2];
    if (!RET) {
#pragma unroll
        for (int vi = 0; vi < 4; ++vi)
#pragma unroll
            for (int ks = 0; ks < 2; ++ks) sf[vi][ks] = *(const bf16x8*)(state + (size_t)(16 * (4 * (wave >> 2) + vi) + (lane & 15)) * 64 + 8 * (lane >> 4) + 32 * ks);
    }
    __syncthreads();
    const int q = lane >> 4; constexpr int RT = L::C / 16;
    if (!RET) { const int rt = wave & 3;
#pragma unroll
        for (int cc = 0; cc < 2; ++cc) { const int ct = 2 * (wave >> 2) + cc; f32x4 acc = {0.f, 0.f, 0.f, 0.f};
            if (ct <= rt) acc = mma_ll(Qs + 16 * rt * L::LQ, L::LQ, Ks + 16 * ct * L::LQ, L::LQ, L::DK, acc, lane);
#pragma unroll
            for (int j = 0; j < 4; ++j) { const int it_ = 16 * rt + 4 * q + j, jt = 16 * ct + (lane & 15); Sc[it_ * L::LT + jt] = (bf16)f2bf(jt <= it_ ? acc[j] : 0.f); } }
    } else { const int rt = wave;
        for (int ct = 0; ct < RT; ++ct) { f32x4 acc = {0.f, 0.f, 0.f, 0.f};
            if (ct <= rt) acc = mma_ll(Qs + 16 * rt * L::LQ, L::LQ, Ks + 16 * ct * L::LQ, L::LQ, L::DK, acc, lane);
#pragma unroll
            for (int j = 0; j < 4; ++j) { const int it_ = 16 * rt + 4 * q + j, jt = 16 * ct + (lane & 15); Sc[it_ * L::LT + jt] = (bf16)f2bf(jt <= it_ ? acc[j] : 0.f); } }
    }
    __syncthreads();
    f32x4 oacc[RET ? 8 : 4];
    { const int rt = RET ? wave : (wave & 3), vt0 = RET ? 0 : 4 * (wave >> 2); constexpr int NV = RET ? 8 : 4;
#pragma unroll
      for (int vi = 0; vi < NV; ++vi) { const int vt = vt0 + vi; f32x4 a1 = {0.f, 0.f, 0.f, 0.f}, a2 = {0.f, 0.f, 0.f, 0.f};
          a1 = mma_ll(Sc + 16 * rt * L::LT, L::LT, Vt + 16 * vt * L::LT, L::LT, L::C, a1, lane);
          if (RET) a2 = mma_lg(Qs + 16 * rt * L::LQ, L::LQ, state + (size_t)16 * vt * L::DK, L::DK, L::DK, a2, lane);
          else { const LAS bf16* xp = Qs + (16 * rt + (lane & 15)) * L::LQ + 8 * (lane >> 4);
              a2 = __builtin_amdgcn_mfma_f32_16x16x32_bf16(*(const LAS bf16x8*)xp, sf[vi & 3][0], a2, 0, 0, 0); a2 = __builtin_amdgcn_mfma_f32_16x16x32_bf16(*(const LAS bf16x8*)(xp + 32), sf[vi & 3][1], a2, 0, 0, 0); }
          oacc[vi] = a1 + a2 * inter_scale; }
      if (RET) __syncthreads();
#pragma unroll
      for (int vi = 0; vi < NV; ++vi) { const int vt = vt0 + vi;
#pragma unroll
          for (int j = 0; j < 4; ++j) Of[(16 * rt + 4 * q + j) * 133 + 16 * vt + (lane & 15)] = oacc[vi][j]; } }
    __syncthreads();
    { const int tl = tid / L::TPT, v0 = (tid % L::TPT) * L::VPT; float s = 0.f, s2 = 0.f;
#pragma unroll
      for (int i = 0; i < L::VPT; ++i) { const float o = Of[tl * 133 + v0 + i]; s += o; s2 += o * o; }
#pragma unroll
      for (int m = 1; m < L::TPT; m <<= 1) { s += __shfl_xor(s, m); s2 += __shfl_xor(s2, m); }
      float mean = 0.f, var = s2 * (1.0f / 128.0f);
      if (RET) { mean = s * (1.0f / 128.0f); var = fmaxf(var - mean * mean, 0.f); }
      const float rstd = __builtin_amdgcn_rsqf(var + 1e-5f);
      const bf16* gsrc = RET ? proj + (size_t)(t0 + tl) * NP1 + 1536 + 128 * h + v0 : proj + (size_t)(t0 + tl) * NP0 + 2048 + 128 * h + v0;
      const float* gn = (RET ? p.in[16] : p.in[13]) + 128 * h + v0;
      bf16* dst = RET ? proj + (size_t)(t0 + tl) * NP1 + 128 * h + v0 : (bf16*)(p.ws + WS_Y) + (size_t)(t0 + tl) * 1024 + 512 + 128 * h + v0;
#pragma unroll
      for (int s8 = 0; s8 < L::VPT / 8; ++s8) { float gv[8], o[8]; unpack8(graw[s8], gv); const float gg[8] = {gnr[2 * s8][0], gnr[2 * s8][1], gnr[2 * s8][2], gnr[2 * s8][3], gnr[2 * s8 + 1][0], gnr[2 * s8 + 1][1], gnr[2 * s8 + 1][2], gnr[2 * s8 + 1][3]};
#pragma unroll
          for (int i = 0; i < 8; ++i) { const float x = (Of[tl * 133 + v0 + 8 * s8 + i] - mean) * rstd * gg[i]; o[i] = x * (gv[i] * sigmf(gv[i])); }
          *(v4u*)(dst + 8 * s8) = pack8(o); } }
    __syncthreads();
}

__device__ __forceinline__ void rwkv_prep(PRef p, int gtid, int NGT) {
    const bf16* proj = (const bf16*)(p.ws + WS_PROJ); bf16* alr = (bf16*)(p.ws + WS_ALR); const float* mu = p.in[17];
    for (int it = gtid; it < T * 32; it += NGT) { const int row = it >> 5, c8 = (it & 31) * 8, col = 1536 + c8; float cur[8], prv[8], o[8];
        ld8(proj + (size_t)row * NP1 + 2048 + col, cur);
        if ((row & 2047) != 0) ld8(proj + (size_t)(row - 1) * NP1 + 2048 + col, prv); else {
#pragma unroll
            for (int i = 0; i < 8; ++i) prv[i] = 0.f; }
        float mv[8]; ldf8(mu + col, mv);
#pragma unroll
        for (int i = 0; i < 8; ++i) { const float d = cur[i] + mv[i] * (prv[i] - cur[i]); o[i] = c8 < 64 ? tanh_fast(d) : (c8 < 128 ? d : sigmf(d)); }
        *(v4u*)(alr + (size_t)row * 256 + c8) = pack8(o); }
}
__device__ __forceinline__ float row_sum16(float x) {
    x += __int_as_float(__builtin_amdgcn_update_dpp(0, __float_as_int(x), 0x128, 0xf, 0xf, false));
    x += __int_as_float(__builtin_amdgcn_update_dpp(0, __float_as_int(x), 0x124, 0xf, 0xf, false));
    x += __int_as_float(__builtin_amdgcn_update_dpp(0, __float_as_int(x), 0x122, 0xf, 0xf, false));
    x += __int_as_float(__builtin_amdgcn_update_dpp(0, __float_as_int(x), 0x121, 0xf, 0xf, false));
    return x;
}
constexpr int SC_STR = 344, SC_STEPS = 32;
__device__ __forceinline__ void rwkv_stage(PRef p, LAS float* buf, int b, int h, int part, int ch, int pt,
                                           const float* mur, const float* muk, const float* muv, const float* kkp, const float* kap, const float* rkp, const float* w0p, const float* a0p) {
    const bf16* proj = (const bf16*)(p.ws + WS_PROJ); const bf16* wag = (const bf16*)(p.ws + WS_Y);
    const int tl = pt >> 3, kc = pt & 7, t = SC_STEPS * ch + tl, row = b * SEQ + t, c0 = 64 * h + 8 * kc;
    float r[8], k[8], v[8], pr[8], pk[8], pv[8], e[8], a[8];
    ld8(proj + (size_t)row * NP1 + 2048 + c0, r); ld8(proj + (size_t)row * NP1 + 2560 + c0, k); ld8(proj + (size_t)row * NP1 + 3072 + c0, v);
    if (t > 0) { ld8(proj + (size_t)(row - 1) * NP1 + 2048 + c0, pr); ld8(proj + (size_t)(row - 1) * NP1 + 2560 + c0, pk); ld8(proj + (size_t)(row - 1) * NP1 + 3072 + c0, pv); }
    else {
#pragma unroll
        for (int i = 0; i < 8; ++i) { pr[i] = 0.f; pk[i] = 0.f; pv[i] = 0.f; } }
    ld8(wag + (size_t)row * 1536 + c0, e); ld8(wag + (size_t)row * 1536 + 512 + c0, a);
#pragma unroll
    for (int i = 0; i < 8; ++i) { const float nx = -(e[i] + w0p[i]); const float sp = fmaxf(nx, 0.f) + __logf(1.0f + __expf(-fabsf(nx))); e[i] = __expf(-sp - 0.5f); a[i] = sigmf(a[i] + a0p[i]); }
    float kkr[8], ss = 0.f;
#pragma unroll
    for (int i = 0; i < 8; ++i) { r[i] += mur[i] * (pr[i] - r[i]); k[i] += muk[i] * (pk[i] - k[i]); v[i] += muv[i] * (pv[i] - v[i]); kkr[i] = k[i] * kkp[i]; ss += kkr[i] * kkr[i]; }
    ss += __shfl_xor(ss, 1); ss += __shfl_xor(ss, 2); ss += __shfl_xor(ss, 4);
    const float rn = __builtin_amdgcn_rsqf(ss + 1e-12f);
    LAS float* base = buf + tl * SC_STR; float br = 0.f, kr = 0.f, rkr = 0.f;
    f32x4 o0[2], o1[2], o2[2], o3[2], o4[2];
#pragma unroll
    for (int i = 0; i < 8; ++i) { const float kk = kkr[i] * rn, w = __expf(-e[i]), km = k[i] * (1.0f + (a[i] - 1.0f) * kap[i]), bb = kk * a[i];
        o0[i >> 2][i & 3] = -kk; o1[i >> 2][i & 3] = w * r[i]; o2[i >> 2][i & 3] = w; o3[i >> 2][i & 3] = bb; o4[i >> 2][i & 3] = km;
        br += bb * r[i]; kr += km * r[i]; rkr += r[i] * km * rkp[i]; }
#pragma unroll
    for (int s = 0; s < 2; ++s) { *(LAS f32x4*)(base + 16 * kc + 8 * s) = (f32x4){o0[s][0], o1[s][0], o0[s][1], o1[s][1]}; *(LAS f32x4*)(base + 16 * kc + 8 * s + 4) = (f32x4){o0[s][2], o1[s][2], o0[s][3], o1[s][3]}; *(LAS f32x4*)(base + 128 + 8 * kc + 4 * s) = o2[s];
        *(LAS f32x4*)(base + 192 + 8 * kc + 4 * s) = o3[s]; *(LAS f32x4*)(base + 256 + 8 * kc + 4 * s) = o4[s]; }
    if ((kc >> 1) == part) {
#pragma unroll
        for (int i = 0; i < 8; ++i) base[320 + (kc & 1) * 8 + i] = v[i]; }
#pragma unroll
    for (int m = 1; m < 8; m <<= 1) { br += __shfl_xor(br, m); kr += __shfl_xor(kr, m); rkr += __shfl_xor(rkr, m); }
    if (kc == 0) { base[336] = br; base[337] = kr; if (part == 0) ((float*)(p.ws + WS_RKR))[(size_t)(b * 8 + h) * SEQ + t] = rkr; }
}
__device__ __forceinline__ void rwkv_scan_item(PRef p, LAS unsigned char* lds, int item, int tid, int wave, int lane, bool do_cvt) {
    const int part = item & 3, h = (item >> 2) & 7, b = item >> 5;
    LAS float* buf = (LAS float*)lds; LAS float* ybuf = (LAS float*)(lds + 2 * SC_STEPS * SC_STR * 4);
    bf16* yraw = (bf16*)(p.ws + WS_HB) + (size_t)T * 512;
    constexpr int NCHK = SEQ / SC_STEPS;
    if (wave >= 4) {
        const int pt = tid - 256, kc = pt & 7, c0 = 64 * h + 8 * kc; float mur[8], muk[8], muv[8], kkp[8], kap[8], rkp[8], w0p[8], a0p[8];
#pragma unroll
        for (int i = 0; i < 8; ++i) { mur[i] = p.in[17][c0 + i]; muk[i] = p.in[17][512 + c0 + i]; muv[i] = p.in[17][1024 + c0 + i]; kkp[i] = p.in[23][c0 + i]; kap[i] = p.in[24][c0 + i]; rkp[i] = p.in[25][c0 + i]; w0p[i] = p.in[18][c0 + i]; a0p[i] = p.in[20][c0 + i]; }
        rwkv_stage(p, buf, b, h, part, 0, pt, mur, muk, muv, kkp, kap, rkp, w0p, a0p);
        LAS float* scr = (LAS float*)(lds + 2 * SC_STEPS * SC_STR * 4 + 8192 + (wave - 4) * 8704);
        f32x4 creg[8];
#pragma unroll
        for (int i = 0; i < 8; ++i) creg[i] = (f32x4){0.f, 0.f, 0.f, 0.f};
        for (int ch = 0; ch < NCHK; ++ch) { __syncthreads(); if (ch + 1 < NCHK) rwkv_stage(p, buf + ((ch + 1) & 1) * SC_STEPS * SC_STR, b, h, part, ch + 1, pt, mur, muk, muv, kkp, kap, rkp, w0p, a0p);
#ifndef NO_SCAN_CVT
            if (do_cvt) { const int idx = (int)blockIdx.x * 4 + (wave - 4) + (ch >> 3) * ((int)gridDim.x * 4);
                if ((ch & 7) == 0) { if (idx < CVT1_ITEMS) cvt1_load(p, idx, lane, creg); } else if ((ch & 7) == 1) { if (idx < CVT1_ITEMS) cvt1_store(p, idx, scr, lane, creg); } }
#endif
        }
    } else {
        const int vl = lane >> 4, kg = lane & 15; f32x4 S = {0.f, 0.f, 0.f, 0.f}; LAS float* yb = ybuf + wave * 512;
        bf16* yp = yraw + (size_t)(item * SEQ) * 16;
        for (int ch = 0; ch < NCHK; ++ch) { __syncthreads(); const LAS float* cb = buf + (ch & 1) * SC_STEPS * SC_STR;
            typedef float f32x2 __attribute__((ext_vector_type(2)));
            const LAS float* b0 = cb;
            f32x4 c_nw0 = *(const LAS f32x4*)(b0 + 8 * kg), c_nw1 = *(const LAS f32x4*)(b0 + 8 * kg + 4), c_w = *(const LAS f32x4*)(b0 + 128 + 4 * kg),
                  c_bb = *(const LAS f32x4*)(b0 + 192 + 4 * kg), c_kk = *(const LAS f32x4*)(b0 + 256 + 4 * kg);
            float c_vv = b0[320 + 4 * wave + vl], c_br = b0[336], c_kr = b0[337];
#pragma unroll
            for (int s = 0; s < SC_STEPS; ++s) { const LAS float* base = cb + (s + 1 < SC_STEPS ? s + 1 : s) * SC_STR;
                const f32x4 n_nw0 = *(const LAS f32x4*)(base + 8 * kg), n_nw1 = *(const LAS f32x4*)(base + 8 * kg + 4), n_w = *(const LAS f32x4*)(base + 128 + 4 * kg),
                            n_bb = *(const LAS f32x4*)(base + 192 + 4 * kg), n_kk = *(const LAS f32x4*)(base + 256 + 4 * kg);
                const float n_vv = base[320 + 4 * wave + vl], n_br = base[336], n_kr = base[337];
                const f32x4 tS = S * c_w + c_kk * c_vv;
                f32x2 dd = (f32x2){S[0], S[0]} * (f32x2){c_nw0[0], c_nw0[1]};
                dd = (f32x2){S[1], S[1]} * (f32x2){c_nw0[2], c_nw0[3]} + dd;
                dd = (f32x2){S[2], S[2]} * (f32x2){c_nw1[0], c_nw1[1]} + dd;
                dd = (f32x2){S[3], S[3]} * (f32x2){c_nw1[2], c_nw1[3]} + dd;
                const float d1 = row_sum16(dd.x);
                S = tS + c_bb * d1;
                float d2 = dd.y;
                d2 += __int_as_float(__builtin_amdgcn_update_dpp(0, __float_as_int(d2), 0x128, 0xf, 0xf, false));
                d2 += __int_as_float(__builtin_amdgcn_update_dpp(0, __float_as_int(d2), 0x124, 0xf, 0xf, false));
                yb[(s * 4 + vl) * 4 + (kg & 3)] = d2 + 0.25f * (d1 * c_br + c_vv * c_kr);
                c_nw0 = n_nw0; c_nw1 = n_nw1; c_w = n_w; c_bb = n_bb; c_kk = n_kk; c_vv = n_vv; c_br = n_br; c_kr = n_kr; }
            { const int s = lane >> 1, pr = lane & 1; const f32x4 q0 = *(const LAS f32x4*)(yb + (s * 4 + 2 * pr) * 4), q1 = *(const LAS f32x4*)(yb + (s * 4 + 2 * pr + 1) * 4); const float y0 = (q0[0] + q0[1]) + (q0[2] + q0[3]), y1 = (q1[0] + q1[1]) + (q1[2] + q1[3]);
              *(unsigned*)(yp + (size_t)(SC_STEPS * ch + s) * 16 + 4 * wave + 2 * pr) = pk2(y0, y1); } }
    }
    __syncthreads();
}
__device__ __forceinline__ void rwkv_post(PRef p, int gtid, int NGT) {
    bf16* proj = (bf16*)(p.ws + WS_PROJ); const bf16* wag = (const bf16*)(p.ws + WS_Y); const bf16* yraw = (const bf16*)(p.ws + WS_HB) + (size_t)T * 512; const float* rkr = (const float*)(p.ws + WS_RKR);
    for (int it = gtid; it < T * 64; it += NGT) { const int row = it >> 6, h = (it >> 3) & 7, c0 = 64 * h + 8 * (it & 7); float y[8], v[8], pv[8], g[8], o[8];
        { const int b_ = row >> 11, t_ = row & 2047, j_ = it & 7; ld8(yraw + ((size_t)(((b_ * 8 + h) * 4 + (j_ >> 1)) * SEQ + t_)) * 16 + (j_ & 1) * 8, y); } float s = 0.f;
#pragma unroll
        for (int i = 0; i < 8; ++i) s += y[i];
        s += __shfl_xor(s, 1); s += __shfl_xor(s, 2); s += __shfl_xor(s, 4); const float mean = s * (1.0f / 64.0f); float s2 = 0.f;
#pragma unroll
        for (int i = 0; i < 8; ++i) { y[i] -= mean; s2 += y[i] * y[i]; }
        s2 += __shfl_xor(s2, 1); s2 += __shfl_xor(s2, 2); s2 += __shfl_xor(s2, 4); const float rstd = __builtin_amdgcn_rsqf(s2 * (1.0f / 64.0f) + 64e-5f);
        ld8(proj + (size_t)row * NP1 + 3072 + c0, v);
        if ((row & 2047) != 0) ld8(proj + (size_t)(row - 1) * NP1 + 3072 + c0, pv); else {
#pragma unroll
            for (int i = 0; i < 8; ++i) pv[i] = 0.f; }
        ld8(wag + (size_t)row * 1536 + 1024 + c0, g); const float rk = rkr[(size_t)((row >> 11) * 8 + h) * SEQ + (row & 2047)];
        float mv[8], ng[8]; ldf8(p.in[17] + 1024 + c0, mv); ldf8(p.in[26] + c0, ng);
#pragma unroll
        for (int i = 0; i < 8; ++i) { const float vs = v[i] + mv[i] * (pv[i] - v[i]); o[i] = (y[i] * rstd * ng[i] + rk * vs) * g[i]; }
#ifdef SANITIZE
#pragma unroll
        for (int i = 0; i < 8; ++i) if (!(fabsf(o[i]) < 1e30f)) o[i] = 0.f;
#endif
        *(v4u*)(proj + (size_t)row * NP1 + 512 + c0) = pack8(o); }
}
__device__ __forceinline__ void final_norm(PRef p, int gw, int NGW, int lane) {
    const float* part = pg8::rpart(p.ws, 6); const float* g = p.in[37]; const bf16* hf = (const bf16*)(p.ws + 107 * MiB);
    f32x4 gv[4];
#pragma unroll
    for (int j = 0; j < 4; ++j) gv[j] = *((const f32x4*)g + lane + 64 * j);
    int m = gw; if (m >= T) return;
    v2u cur[4]; float rs = pg8::rs16(part, m);
#pragma unroll
    for (int j = 0; j < 4; ++j) cur[j] = *((const v2u*)(hf + (size_t)m * 1024) + lane + 64 * j);
    for (;;) { const int nx = m + NGW; const bool more = nx < T; v2u nxt[4]; float nrs = rs;
#pragma unroll
        for (int j = 0; j < 4; ++j) nxt[j] = cur[j];
        if (more) { nrs = pg8::rs16(part, nx);
#pragma unroll
            for (int j = 0; j < 4; ++j) nxt[j] = *((const v2u*)(hf + (size_t)nx * 1024) + lane + 64 * j); }
        f32x4* xr = (f32x4*)(p.out + (size_t)m * 1024) + lane;
#pragma unroll
        for (int j = 0; j < 4; ++j) { const v2u hw = cur[j]; f32x4 v = {__uint_as_float(hw.x << 16), __uint_as_float(hw.x & 0xffff0000u), __uint_as_float(hw.y << 16), __uint_as_float(hw.y & 0xffff0000u)}; v = v * rs * gv[j]; xr[64 * j] = v; }
        if (!more) break; m = nx; rs = nrs;
#pragma unroll
        for (int j = 0; j < 4; ++j) cur[j] = nxt[j]; }
}

#define TID (fresh_tid())
#define LANE (TID & 63)
#define WAVE (__builtin_amdgcn_readfirstlane(TID >> 6))
#define GRD (fresh_s((int)gridDim.x))
#define BID (fresh_s((int)blockIdx.x))
#define GW (BID * NWAVES + WAVE)
#define NGW_ (GRD * NWAVES)
#define GTID (BID * NTHREADS + TID)
#define NGT_ (GRD * NTHREADS)
#define GSYNC_CG() cg::this_grid().sync()
#define GSYNC() do { XcdBarrier xb_; xb_.bar = (unsigned*)(FP.ws + WS_XBAR); xb_.x = xb_xcc_id(); xb_.st = (volatile LAS unsigned*)(lds + LDS_XST); xcd_barrier(xb_); } while (0)
#define WSP(off) (FP.ws + (off))
#define ROWSS(i) ((float*)WSP(WS_ROWSS) + (size_t)(i) * T)

template <int li> __device__ __forceinline__ void layer_body(LAS unsigned char* lds) {
        { const int N = li == 0 ? NP0 : NP1; pg8::Gemm g{li == 0 ? (const bf16*)WSP(WS_HB) : (const bf16*)FP.out + (size_t)T * 1024, (const bf16*)WSP(W_IN), T, N, 1024, 1024}; pg8::StaticOrder S; S.init(T, N, GRD, BID);
          pg8::EpiScaleBf16 E{0, li};
          pg8::gemm_phase<pg8::EpiScaleBf16, pg8::StaticOrder, true, true>(lds, g, S, E);
#ifdef PROBE_INPROJ2
          pg8::gemm_phase<pg8::EpiScaleBf16, pg8::StaticOrder, true, true>(lds, g, S, E);
#endif
        }
        GSYNC();
#ifndef NO_MIX
        if (li == 0) {
#ifdef NO_MIX0
            { PRef p = FP; tr_job(p.in[15], NP1, 1024, p.in[28] + 1024, (bf16*)(p.ws + W_IN), NP1, 0, lds, GW, NGW_, WAVE, LANE); }
            GSYNC();
#else
            for (int it = BID; it < 256; it += GRD) lru_local_item(FP, lds, it, TID, WAVE, LANE);
#ifdef PROBE_LRU2
            for (int it = BID; it < 256; it += GRD) lru_local_item(FP, lds, it, TID, WAVE, LANE);
#endif
#ifdef PROBE_GLA2
            for (int it = BID; it < 1024; it += GRD) la_local_item<false>(FP, lds, it, TID, WAVE, LANE);
#endif
            for (int it = BID; it < 1024; it += GRD) la_local_item<false>(FP, lds, it, TID, WAVE, LANE);
            { PRef p = FP; tr_job(p.in[15], NP1, 1024, p.in[28] + 1024, (bf16*)(p.ws + W_IN), NP1, 0, lds, GW, NGW_, WAVE, LANE); }
            GSYNC();
            lru_prefix(FP, GTID, NGT_); la_prefix<false>(FP, GTID, NGT_);
            GSYNC();
            for (int it = BID; it < 1024; it += GRD) la_out_item<false>(FP, lds, it, TID, WAVE, LANE);
#ifdef PROBE_GLAOUT2
            for (int it = BID; it < 1024; it += GRD) la_out_item<false>(FP, lds, it, TID, WAVE, LANE);
#endif
#ifdef PROBE_LRUOUT2
            lru_out(FP, GTID, NGT_);
#endif
            lru_out(FP, GTID, NGT_);
            GSYNC();
#endif
        } else {
#ifdef NO_MIX1
            cvt_layer_weights(FP, 1, lds, GW, NGW_, WAVE, LANE);
            cvt_p(FP, 1, GW, NGW_, LANE);
            GSYNC();
#else
#ifndef NO_RET
            for (int it = BID; it < 512; it += GRD) la_local_item<true>(FP, lds, it, TID, WAVE, LANE);
#endif
#ifdef PROBE_RETLOC2
            for (int it = BID; it < 512; it += GRD) la_local_item<true>(FP, lds, it, TID, WAVE, LANE);
#endif
#ifdef PROBE_CVT2
            cvt_layer_weights(FP, 1, lds, GW, NGW_, WAVE, LANE);
#endif
#ifndef NO_RWKV
            rwkv_prep(FP, GTID, NGT_);
#endif
#ifdef NO_SCAN_CVT
            cvt_layer_weights(FP, 1, lds, GW, NGW_, WAVE, LANE);
            cvt_p(FP, 1, GW, NGW_, LANE);
#endif
            GSYNC();
#ifndef NO_RET
            la_prefix<true>(FP, GTID, NGT_);
#endif
#ifndef NO_RWKV
            { PRef p = FP; pg8::Gemm g{(const bf16*)(p.ws + WS_ALR), (const bf16*)(p.ws + W_LR), T, 1536, 256, 256}; pg8::StaticOrder S; S.init(T, 1536, GRD, BID);
              pg8::EpiScaleBf16 E{2, 1};
              pg8::gemm_phase<pg8::EpiScaleBf16, pg8::StaticOrder, true, true>(lds, g, S, E); }
#endif
            GSYNC();
#ifndef NO_RET
            for (int it = BID; it < 512; it += GRD) la_out_item<true>(FP, lds, it, TID, WAVE, LANE);
#endif
#if !defined(NO_RWKV) && !defined(NO_SCAN)
            for (int it = BID; it < 256; it += GRD) rwkv_scan_item(FP, lds, it, TID, WAVE, LANE, it < GRD);
#endif
#ifndef NO_SCAN_CVT
            { const int first = 8 * GRD * 4; for (int idx = first + GW; idx < CVT1_ITEMS; idx += NGW_) cvt1_flat(FP, idx, (LAS float*)(lds + WAVE * 8704), LANE); }
#endif
#ifdef PROBE_SCAN2
            for (int it = BID; it < 256; it += GRD) rwkv_scan_item(FP, lds, it, TID, WAVE, LANE, it < GRD);
#endif
            GSYNC();
#ifndef NO_RWKV
            rwkv_post(FP, GTID, NGT_);
#endif
            GSYNC();
#endif
        }
#endif
        { PRef p = FP;
#if defined(NO_MIX) || defined(NO_MIX0)
          pg8::Gemm g{(const bf16*)(p.ws + WS_PROJ), (const bf16*)(p.ws + W_OUT), T, 1024, 1024, li == 0 ? NP0 : NP1};
#elif defined(NO_MIX1)
          pg8::Gemm g{li == 0 ? (const bf16*)(p.ws + WS_Y) : (const bf16*)(p.ws + WS_PROJ) + 2048, (const bf16*)(p.ws + W_OUT), T, 1024, 1024, li == 0 ? 1024 : NP1};
#else
          pg8::Gemm g{li == 0 ? (const bf16*)(p.ws + WS_Y) : (const bf16*)(p.ws + WS_PROJ), (const bf16*)(p.ws + W_OUT), T, 1024, 1024, li == 0 ? 1024 : NP1};
#endif

          pg8::StaticOrder S; S.init(T, 1024, GRD, BID);
          pg8::EpiResid E{0, li};
          pg8::gemm_phase<pg8::EpiResid, pg8::StaticOrder, true, true>(lds, g, S, E); }
        GSYNC();
        { pg8::Gemm g{(const bf16*)FP.out + (size_t)li * T * 1024, (const bf16*)WSP(W_GU), T, 2 * FF, 1024, 1024}; pg8::StaticOrder S; S.init(T, 2 * FF, GRD, BID);
          pg8::EpiSwiGLU E{li};
          pg8::gemm_phase<pg8::EpiSwiGLU, pg8::StaticOrder, true, true>(lds, g, S, E);
#ifdef PROBE_GU2
          pg8::gemm_phase<pg8::EpiSwiGLU, pg8::StaticOrder, true, true>(lds, g, S, E);
#endif
          { const int G_ = GRD, b_ = BID, half = G_ / 2; pg8::Gemm g2{(const bf16*)WSP(WS_PB), (const bf16*)WSP(W_PP), T, 1024, 256, 256}; pg8::StaticOrder S2;
            if (G_ == 256) S2.init(T, 1024, half, b_ >= half ? b_ - half : (1 << 28)); else S2.init(T, 1024, G_, b_);
            pg8::EpiScaleBf16 E2{1, li};
            pg8::gemm_phase<pg8::EpiScaleBf16, pg8::StaticOrder, true, true>(lds, g2, S2, E2); }
        }
        GSYNC();
        { PRef p = FP; pg8::Gemm g{(const bf16*)(p.ws + WS_PROJ), (const bf16*)(p.ws + W_DN), T, 1024, FF, FF}; pg8::StaticOrder S; S.init(T, 1024, GRD, BID);
          pg8::EpiResid E{1, li};
          pg8::gemm_phase<pg8::EpiResid, pg8::StaticOrder, true, true>(lds, g, S, E); }
        GSYNC();
        { PRef p = FP; pg8::Gemm g{(const bf16*)p.out + (size_t)li * T * 1024, (const bf16*)(p.ws + W_PG), T, 1024, 1024, 1024}; pg8::StaticOrder S; S.init(T, 1024, GRD, BID);
          pg8::EpiPLE E{li};
          pg8::gemm_phase<pg8::EpiPLE, pg8::StaticOrder, true, true>(lds, g, S, E);
#ifdef PROBE_PLE2
          pg8::gemm_phase<pg8::EpiPLE, pg8::StaticOrder, true, true>(lds, g, S, E);
#endif
        }
        GSYNC();
    }

__global__ void __launch_bounds__(NTHREADS, 2) trunk_fwd(Params p_unused) {
    extern __shared__ __attribute__((aligned(16))) unsigned char lds_raw[];
    LAS unsigned char* lds = (LAS unsigned char*)lds_raw;
    if (threadIdx.x < 16) ((volatile LAS unsigned*)(lds + LDS_XST))[threadIdx.x] = 0u;
    __syncthreads();
    (void)xcd_barrier_post((unsigned*)(FP.ws + WS_XBAR), (volatile LAS unsigned*)(lds + LDS_XST));
#ifndef NO_PRO
    phase_prologue(FP, lds, GW, NGW_, WAVE, LANE);
#endif
    GSYNC_CG();
#ifdef PROBE_SYNC10
    for (int i_ = 0; i_ < 10; ++i_) GSYNC();
#endif
#ifdef PROBE_PRO2
    phase_prologue(FP, lds, GW, NGW_, WAVE, LANE);
    GSYNC();
#endif
    layer_body<0>(lds);
    layer_body<1>(lds);
    final_norm(FP, GW, NGW_, LANE);
}

extern "C" void kernel_launch(void* const* d_in, const int* in_sizes, int n_in, void* d_out, int out_size, void* d_ws, size_t ws_size, hipStream_t stream) {
    static int grid = 0;
    if (grid == 0) {
        if (n_in != 38 || ws_size < WS_END) { fprintf(stderr, "kernel_launch: unexpected n_in %d / ws %zu\n", n_in, ws_size); grid = -1; return; }
        int dev = 0, cus = 0, per_cu = 0;
        hipGetDevice(&dev); hipDeviceGetAttribute(&cus, hipDeviceAttributeMultiprocessorCount, dev);
        hipFuncSetAttribute((const void*)trunk_fwd, hipFuncAttributeMaxDynamicSharedMemorySize, LDS_BYTES);
        hipOccupancyMaxActiveBlocksPerMultiprocessor(&per_cu, (const void*)trunk_fwd, NTHREADS, LDS_BYTES);
        (void)hipGetLastError();
        if (per_cu < 1) { fprintf(stderr, "kernel_launch: occupancy query reports %d blocks per CU\n", per_cu); per_cu = 1; }
        grid = cus;
    }
    if (grid < 0) return;
    hipMemsetAsync((char*)d_ws + WS_CTL, 0, CTL_ZERO_BYTES, stream);
    Params prm{};
    for (int i = 0; i < 38; ++i) prm.in[i] = (const float*)d_in[i];
    prm.out = (float*)d_out; prm.ws = (unsigned char*)d_ws;
    void* args[] = {&prm};
    hipError_t e = hipLaunchCooperativeKernel((const void*)trunk_fwd, dim3(grid), dim3(NTHREADS), args, LDS_BYTES, stream);
    if (e != hipSuccess) fprintf(stderr, "cooperative launch failed: %s (grid %d)\n", hipGetErrorString(e), grid);
}
```

```cpp
#include <hip/hip_runtime.h>
#include <hip/hip_cooperative_groups.h>
#include <cstdio>
#include <cstdint>
namespace cg = cooperative_groups;
namespace pg8 {
#define PG8_LAS __attribute__((address_space(3)))
typedef unsigned short bf16_t;
typedef short bf16x8 __attribute__((ext_vector_type(8)));
typedef float f32x4 __attribute__((ext_vector_type(4)));
typedef unsigned u32x4 __attribute__((ext_vector_type(4)));
constexpr int BM = 256, BK = 64, HALF = 128, HTB = HALF * BK * 2  , STAGE_BYTES = 8 * HTB, NXCD = 8, WGM = 8;

__host__ __device__ __forceinline__ int lds_byte(int r, int c) { const int st = (r >> 4) * 2 + (c >> 5), rr = r & 15, cc = c & 31, ob = rr * 64 + cc * 2; return st * 1024 + (ob ^ (((ob >> 9) & 1) << 5)); }
__host__ __device__ __forceinline__ void stage_rc(int b, int& R, int& C) { const int st = b / 1024, sb = b % 1024, swz = sb ^ (((sb >> 9) & 1) << 5); R = (st >> 1) * 16 + swz / 64; C = (st & 1) * 32 + (swz % 64) / 2; }
__host__ __device__ __forceinline__ int perm32(int rho) { const int n = rho >> 4, i = rho & 15; return 8 * (i >> 2) + 4 * n + (i & 3); }

struct Unit { int pm, pn; };
struct Gemm { const bf16_t* A; const bf16_t* Bt; int M, N, K, lda; };

struct StaticOrder {
    int nM, nN, nwg, G, c;
    __host__ __device__ void init(int M, int N, int G_, int c_) { nM = M / BM; nN = N / BM; nwg = nM * nN; G = G_; c = c_; }
    __host__ __device__ bool next(int i, Unit& u) const {
        const long L = (long)i * G + c; if (L >= nwg) return false;
        int wgid = (int)L; { const int q = nwg / NXCD, r = nwg % NXCD, xcd = wgid % NXCD, off = wgid / NXCD; wgid = (xcd < r ? xcd * (q + 1) : r * (q + 1) + (xcd - r) * q) + off; }
        const int nig = WGM * nN, gid = wgid / nig, fm = gid * WGM, gsz = (nM - fm) < WGM ? (nM - fm) : WGM;
        u.pm = fm + ((wgid % nig) % gsz); u.pn = (wgid % nig) / gsz; return true;
    }
    __device__ __forceinline__ void a_ready(const Unit&) const {}
    __device__ __forceinline__ void done(const Unit&) const {}
};

typedef float f32x2p_t __attribute__((ext_vector_type(2))); typedef __bf16 bf16x2p_t __attribute__((ext_vector_type(2)));
__device__ __forceinline__ unsigned cvt_pk_bf16(float lo, float hi) { const f32x2p_t v = {lo, hi}; const bf16x2p_t b = __builtin_convertvector(v, bf16x2p_t); return __builtin_bit_cast(unsigned, b); }
typedef float f32x2 __attribute__((ext_vector_type(2)));
__device__ __forceinline__ f32x2 gelu_pk(f32x2 v) {
    const f32x2 av = __builtin_elementwise_abs(v), d = av * 0.2316418882f + 1.0f;
    f32x2 t; t.x = __builtin_amdgcn_rcpf(d.x); t.y = __builtin_amdgcn_rcpf(d.y);
    f32x2 q = t * 0.5307027145f + (-0.7265760135f); q = q * t + 0.7107068705f; q = q * t + (-0.142248368f); q = q * t + 0.127414796f; q = q * t;
    const f32x2 s = (v * v) * (-0.72134752044f);
    f32x2 e; e.x = __builtin_amdgcn_exp2f(s.x); e.y = __builtin_amdgcn_exp2f(s.y);
    const f32x2 m = v * (q * e), r = v - m;
    f32x2 o; o.x = v.x < 0.f ? m.x : r.x; o.y = v.y < 0.f ? m.y : r.y; return o;
}


}
struct Params { const float* in[38]; float* out; unsigned char* ws; };
typedef const __attribute__((address_space(4))) Params& PRef;
__device__ __forceinline__ const __attribute__((address_space(4))) Params* fresh_params() { unsigned long long ki = (unsigned long long)__builtin_amdgcn_kernarg_segment_ptr(); asm volatile("" : "+s"(ki)); return (const __attribute__((address_space(4))) Params*)ki; }
#define FP (*fresh_params())
constexpr size_t EPI_MiB = 1u << 20;
constexpr size_t E_ROWSS = 65536, E_HB = 35 * EPI_MiB, E_PROJ = 67 * EPI_MiB, E_Y = 187 * EPI_MiB, E_HF = 107 * EPI_MiB;
namespace pg8 {

__device__ __forceinline__ float rs_of(const float* rowss, int row) { return rowss ? __builtin_amdgcn_rsqf(rowss[row] * (1.0f / 1024.0f) + 1e-6f) : 1.0f; }
__device__ __forceinline__ float sigm(float x) { return __builtin_amdgcn_rcpf(1.0f + __expf(-x)); }
constexpr size_t E_RPART = 253 * EPI_MiB;
__device__ __forceinline__ float* rpart(unsigned char* ws, int inst) { return (float*)(ws + E_RPART + ((inst & 1) ? 0 : EPI_MiB)); }
__device__ __forceinline__ float rs16(const float* part, int row) { const f32x4* q = (const f32x4*)(part + (size_t)row * 16); const f32x4 a = q[0], b = q[1], c = q[2], d = q[3];
    const float s = (((a[0] + a[1]) + (a[2] + a[3])) + ((b[0] + b[1]) + (b[2] + b[3]))) + (((c[0] + c[1]) + (c[2] + c[3])) + ((d[0] + d[1]) + (d[2] + d[3])));
    return __builtin_amdgcn_rsqf(s * (1.0f / 1024.0f) + 1e-6f); }

struct EpiScaleBf16 {
    static constexpr bool PERM = true, AFTER_DRAIN = false;
    int mode, li;
    __device__ __forceinline__ void operator()(const f32x4 (&acc)[2][2][4][2], const Unit& u, int wr, int wc, int fr, int fq) const {
        unsigned char* ws = FP.ws; bf16_t* O = (bf16_t*)(ws + (mode == 0 ? E_PROJ : E_Y));   const int ldc = mode == 0 ? (li == 0 ? 2816 : 3840) : (mode == 2 ? 1536 : 1024);
        const float* rowss = (mode == 0 && li == 0) ? (const float*)(ws + E_ROWSS) : nullptr; const float* part = rpart(ws, 3); const bool use16 = (mode == 0 && li == 1);
        const int row0 = u.pm * BM + wr * 64 + fr, col0 = u.pn * BM + wc * 32 + 8 * fq;
#pragma unroll
        for (int ai = 0; ai < 2; ++ai)
#pragma unroll
            for (int m = 0; m < 4; ++m) { const int row = row0 + ai * HALF + m * 16; const float rs = use16 ? rs16(part, row) : rs_of(rowss, row); bf16_t* rowp = O + (size_t)row * ldc + col0;
#pragma unroll
                for (int bj = 0; bj < 2; ++bj) { const f32x4 v0 = acc[ai][bj][m][0] * rs, v1 = acc[ai][bj][m][1] * rs;
                    u32x4 w; w.x = cvt_pk_bf16(v0[0], v0[1]); w.y = cvt_pk_bf16(v0[2], v0[3]); w.z = cvt_pk_bf16(v1[0], v1[1]); w.w = cvt_pk_bf16(v1[2], v1[3]);
                    *(u32x4*)(rowp + bj * HALF) = w; } }
    }
};

__device__ __forceinline__ void unpk8(const u32x4 pw, f32x4& p0, f32x4& p1) {
    p0[0] = __uint_as_float(pw.x << 16); p0[1] = __uint_as_float(pw.x & 0xffff0000u); p0[2] = __uint_as_float(pw.y << 16); p0[3] = __uint_as_float(pw.y & 0xffff0000u);
    p1[0] = __uint_as_float(pw.z << 16); p1[1] = __uint_as_float(pw.z & 0xffff0000u); p1[2] = __uint_as_float(pw.w << 16); p1[3] = __uint_as_float(pw.w & 0xffff0000u);
}
struct EpiResid {
    static constexpr bool PERM = true, AFTER_DRAIN = false;
    int which, li;
    __device__ __forceinline__ void operator()(const f32x4 (&acc)[2][2][4][2], const Unit& u, int wr, int wc, int fr, int fq) const {
        PRef p = FP; unsigned char* ws = p.ws; bf16_t* res = (bf16_t*)p.out + (size_t)li * 16384 * 1024; const float* xin = p.in[0]; const bool from_x = (which == 0 && li == 0);
        float* part = rpart(ws, (which == 0 ? 1 : 2) + 3 * li); const int slot = 4 * u.pn + wc;
        const int row0 = u.pm * BM + wr * 64 + fr, col0 = u.pn * BM + wc * 32 + 8 * fq;
#pragma unroll
        for (int ai = 0; ai < 2; ++ai)
#pragma unroll
            for (int m = 0; m < 4; ++m) { const int row = row0 + ai * HALF + m * 16; float ss = 0.f;
#pragma unroll
                for (int bj = 0; bj < 2; ++bj) { const size_t off = (size_t)row * 1024 + col0 + bj * HALF; f32x4 v0, v1;
                    if (from_x) { v0 = *(const f32x4*)(xin + off); v1 = *(const f32x4*)(xin + off + 4); } else unpk8(*(const u32x4*)(res + off), v0, v1);
                    v0 = v0 + acc[ai][bj][m][0]; v1 = v1 + acc[ai][bj][m][1];
                    u32x4 w; w.x = cvt_pk_bf16(v0[0], v0[1]); w.y = cvt_pk_bf16(v0[2], v0[3]); w.z = cvt_pk_bf16(v1[0], v1[1]); w.w = cvt_pk_bf16(v1[2], v1[3]);
                    *(u32x4*)(res + off) = w;
                    ss += (v0[0] * v0[0] + v0[1] * v0[1]) + (v0[2] * v0[2] + v0[3] * v0[3]) + (v1[0] * v1[0] + v1[1] * v1[1]) + (v1[2] * v1[2] + v1[3] * v1[3]); }
                ss += __shfl_xor(ss, 16); ss += __shfl_xor(ss, 32);
                if (fq == 0) part[(size_t)row * 16 + slot] = ss; asm volatile("" ::: "memory"); }
    }
};

struct EpiSwiGLU {
    static constexpr bool PERM = true, AFTER_DRAIN = false;
    int li;
    __device__ __forceinline__ void operator()(const f32x4 (&acc)[2][2][4][2], const Unit& u, int wr, int wc, int fr, int fq) const {
        typedef unsigned u32x2v __attribute__((ext_vector_type(2)));
        unsigned char* ws = FP.ws; bf16_t* O = (bf16_t*)(ws + E_PROJ); const int ldc = 2816; const float* part = rpart(ws, 1 + 3 * li);
        const int row0 = u.pm * BM + wr * 64 + fr, col0 = u.pn * 128 + wc * 16 + 4 * fq;
#pragma unroll
        for (int ai = 0; ai < 2; ++ai)
#pragma unroll
            for (int m = 0; m < 4; ++m) { const int row = row0 + ai * HALF + m * 16; const float rs = rs16(part, row); bf16_t* rowp = O + (size_t)row * ldc + col0;
#pragma unroll
                for (int bj = 0; bj < 2; ++bj) { const f32x4 g = acc[ai][bj][m][0] * rs, up = acc[ai][bj][m][1] * rs; f32x4 o;
#pragma unroll
                    for (int i = 0; i < 4; ++i) o[i] = g[i] * sigm(g[i]) * up[i];
                    u32x2v w; w.x = cvt_pk_bf16(o[0], o[1]); w.y = cvt_pk_bf16(o[2], o[3]);
                    *(u32x2v*)(rowp + bj * 64) = w; } }
    }
};

struct EpiPLE {
    static constexpr bool PERM = true, AFTER_DRAIN = false;
    int li;
    __device__ __forceinline__ void operator()(const f32x4 (&acc)[2][2][4][2], const Unit& u, int wr, int wc, int fr, int fq) const {
        PRef p = FP; unsigned char* ws = p.ws; const bf16_t* rin = (const bf16_t*)p.out + (size_t)li * 16384 * 1024; bf16_t* rout = (bf16_t*)p.out + (size_t)16384 * 1024; bf16_t* hf = (bf16_t*)(ws + E_HF);
        const bf16_t* pp = (const bf16_t*)(ws + E_Y); const float* bias = p.in[35] + li * 1024;
        const float* rs_in = rpart(ws, 2 + 3 * li); float* part = rpart(ws, 3 + 3 * li); const int slot = 4 * u.pn + wc;
        const int row0 = u.pm * BM + wr * 64 + fr, col0 = u.pn * BM + wc * 32 + 8 * fq;
#pragma unroll
        for (int ai = 0; ai < 2; ++ai)
#pragma unroll
            for (int m = 0; m < 4; ++m) { const int row = row0 + ai * HALF + m * 16; const float rs = rs16(rs_in, row); float ss = 0.f;
#pragma unroll
                for (int bj = 0; bj < 2; ++bj) { const size_t off = (size_t)row * 1024 + col0 + bj * HALF;
                    const f32x4 b0 = *(const f32x4*)(bias + col0 + bj * HALF), b1 = *(const f32x4*)(bias + col0 + bj * HALF + 4);
                    f32x4 p0, p1, v0, v1; unpk8(*(const u32x4*)(pp + off), p0, p1); unpk8(*(const u32x4*)(rin + off), v0, v1);
                    const f32x4 g0 = acc[ai][bj][m][0] * rs + b0, g1 = acc[ai][bj][m][1] * rs + b1;
#pragma unroll
                    for (int i = 0; i < 4; ++i) { v0[i] += sigm(g0[i]) * p0[i]; v1[i] += sigm(g1[i]) * p1[i]; }
                    if (li == 0) { u32x4 w; w.x = cvt_pk_bf16(v0[0], v0[1]); w.y = cvt_pk_bf16(v0[2], v0[3]); w.z = cvt_pk_bf16(v1[0], v1[1]); w.w = cvt_pk_bf16(v1[2], v1[3]); *(u32x4*)(rout + off) = w; }
                    else { u32x4 w; w.x = cvt_pk_bf16(v0[0], v0[1]); w.y = cvt_pk_bf16(v0[2], v0[3]); w.z = cvt_pk_bf16(v1[0], v1[1]); w.w = cvt_pk_bf16(v1[2], v1[3]); *(u32x4*)(hf + off) = w; }
                    ss += (v0[0] * v0[0] + v0[1] * v0[1]) + (v0[2] * v0[2] + v0[3] * v0[3]) + (v1[0] * v1[0] + v1[1] * v1[1]) + (v1[2] * v1[2] + v1[3] * v1[3]); }
                ss += __shfl_xor(ss, 16); ss += __shfl_xor(ss, 32);
                if (fq == 0) part[(size_t)row * 16 + slot] = ss; asm volatile("" ::: "memory"); }
    }
};

typedef float f32x2c_t __attribute__((ext_vector_type(2))); typedef __bf16 bf16x2c_t __attribute__((ext_vector_type(2)));
__device__ __forceinline__ unsigned cvt_pk_b(float lo, float hi) { const f32x2c_t v = {lo, hi}; const bf16x2c_t b = __builtin_convertvector(v, bf16x2c_t); return __builtin_bit_cast(unsigned, b); }
struct EpiLowRank {
    static constexpr bool PERM = true, AFTER_DRAIN = false;
    int dummy;
    template <int KIND> __device__ __forceinline__ void run(const f32x4 (&acc)[2][2][4][2], const Unit& u, int wr, int wc, int fr, int fq) const {
        PRef p = FP; bf16_t* O = (bf16_t*)(p.ws + E_Y); const float* bsrc = KIND == 0 ? p.in[18] : p.in[20];
        const int row0 = u.pm * BM + wr * 64 + fr, col0 = u.pn * BM + wc * 32 + 8 * fq;
#pragma unroll
        for (int bj = 0; bj < 2; ++bj) { const int col = col0 + bj * HALF; f32x4 b0 = {0.f, 0.f, 0.f, 0.f}, b1 = {0.f, 0.f, 0.f, 0.f};
            if (KIND < 2) { b0 = *(const f32x4*)(bsrc + (col & 511)); b1 = *(const f32x4*)(bsrc + (col & 511) + 4); }
#pragma unroll
            for (int ai = 0; ai < 2; ++ai)
#pragma unroll
                for (int m = 0; m < 4; ++m) { const int row = row0 + ai * HALF + m * 16; f32x4 v0 = acc[ai][bj][m][0] + b0, v1 = acc[ai][bj][m][1] + b1;
#pragma unroll
                    for (int i = 0; i < 4; ++i) {
                        if (KIND == 0) { const float n0 = -v0[i], n1 = -v1[i]; const float s0 = fmaxf(n0, 0.f) + __logf(1.0f + __expf(-fabsf(n0))), s1 = fmaxf(n1, 0.f) + __logf(1.0f + __expf(-fabsf(n1)));
                            v0[i] = __expf(-s0 - 0.5f); v1[i] = __expf(-s1 - 0.5f); }
                        else if (KIND == 1) { v0[i] = sigm(v0[i]); v1[i] = sigm(v1[i]); } }
                    u32x4 w; w.x = cvt_pk_b(v0[0], v0[1]); w.y = cvt_pk_b(v0[2], v0[3]); w.z = cvt_pk_b(v1[0], v1[1]); w.w = cvt_pk_b(v1[2], v1[3]);
                    *(u32x4*)(O + (size_t)row * 1536 + col) = w; } }
    }
    __device__ __forceinline__ void operator()(const f32x4 (&acc)[2][2][4][2], const Unit& u, int wr, int wc, int fr, int fq) const {
        const int kind = u.pn >> 1;
        if (kind == 0) run<0>(acc, u, wr, wc, fr, fq); else if (kind == 1) run<1>(acc, u, wr, wc, fr, fq); else run<2>(acc, u, wr, wc, fr, fq);
    }
};
template <class Epi, class Sched, bool ALIGN_EPI = false, bool SP2 = false>
__device__ __forceinline__ void gemm_phase(PG8_LAS unsigned char* lds, const Gemm g, const Sched& S, const Epi& E) {
    int tid_l = threadIdx.x; asm volatile("" : "+v"(tid_l));
    const int tid = tid_l, wid = __builtin_amdgcn_readfirstlane(tid >> 6), lane = tid & 63, wr = wid >> 2, wc = wid & 3, fr = lane & 15, fq = lane >> 4;
    const int K = g.K, nt = K / BK, lda = g.lda;
    unsigned voffA[2], voffB[2];
#pragma unroll
    for (int i = 0; i < 2; ++i) { int R, C; stage_rc(tid * 16 + i * 8192, R, C); const int Rb = Epi::PERM ? ((R & ~31) + perm32(R & 31)) : R;
        voffA[i] = (unsigned)(R * lda + C) * 2u; voffB[i] = (unsigned)(Rb * K + C) * 2u; }
    const size_t kstep = (size_t)(BK * 2);
    const size_t hstepB = (size_t)HALF * K * 2, hstepA = (size_t)HALF * lda * 2;
    const size_t tstepB = 2 * hstepB, tstepA = 2 * hstepA;
    const unsigned ldsw = (unsigned)wid * 1024u;
    const int aoff = lds_byte(wr * 64 + fr, fq * 8), boff = lds_byte(wc * 32 + fr, fq * 8);
#define PG8_SA(b, h) (((b) * 2 + (h)) * HTB)
#define PG8_SB(b, h) ((4 + (b) * 2 + (h)) * HTB)
#define PG8_STAGE(bufoff, gbase, voff) do { _Pragma("unroll") for (int _i = 0; _i < 2; ++_i) \
        __builtin_amdgcn_global_load_lds((const unsigned*)((const char*)(gbase) + (voff)[_i]), (PG8_LAS unsigned*)(lds + (bufoff) + ldsw + _i * 8192), 16, 0, 0); } while (0)
#define PG8_LDA(dst, b, h) do { _Pragma("unroll") for (int m = 0; m < 4; ++m) _Pragma("unroll") for (int k = 0; k < 2; ++k) dst[m][k] = *(const PG8_LAS bf16x8*)(lds + PG8_SA(b, h) + aoff + m * 2048 + k * 1024); } while (0)
#define PG8_LDB(dst, b, h) do { _Pragma("unroll") for (int n = 0; n < 2; ++n) _Pragma("unroll") for (int k = 0; k < 2; ++k) dst[n][k] = *(const PG8_LAS bf16x8*)(lds + PG8_SB(b, h) + boff + n * 2048 + k * 1024); } while (0)
#define PG8_MMA(ai, bj, At, Bt) do { __builtin_amdgcn_s_setprio(1); _Pragma("unroll") for (int m = 0; m < 4; ++m) _Pragma("unroll") for (int n = 0; n < 2; ++n) _Pragma("unroll") for (int k = 0; k < 2; ++k) \
        acc[ai][bj][m][n] = __builtin_amdgcn_mfma_f32_16x16x32_bf16(Bt[n][k], At[m][k], acc[ai][bj][m][n], 0, 0, 0); __builtin_amdgcn_s_setprio(0); } while (0)
#define PG8_WAIT_V(n) asm volatile("s_waitcnt vmcnt(" #n ")" ::: "memory")
#define PG8_WAIT_L(n) asm volatile("s_waitcnt lgkmcnt(" #n ")" ::: "memory")
#define PG8_BAR __builtin_amdgcn_s_barrier()
#define PG8_SCHED __builtin_amdgcn_sched_barrier(0)
    Unit cur, nxt; int ui = 0;
    if (!S.next(0, cur)) return;
    f32x4 acc[2][2][4][2];
#pragma unroll
    for (int a = 0; a < 2; ++a)
#pragma unroll
        for (int b = 0; b < 2; ++b)
#pragma unroll
            for (int m = 0; m < 4; ++m)
#pragma unroll
                for (int n = 0; n < 2; ++n) acc[a][b][m][n] = (f32x4){0.f, 0.f, 0.f, 0.f};
    bf16x8 At[4][2], B0[2][2], B1[2][2];
    const char* cA = (const char*)g.A + (size_t)cur.pm * tstepA; const char* cB = (const char*)g.Bt + (size_t)cur.pn * tstepB;
    S.a_ready(cur);
    if constexpr (SP2) {
        PG8_STAGE(PG8_SB(0, 0), cB, voffB); PG8_STAGE(PG8_SB(0, 1), cB + hstepB, voffB); PG8_STAGE(PG8_SA(0, 0), cA, voffA); PG8_STAGE(PG8_SA(0, 1), cA + hstepA, voffA);
        if (wr == 1) PG8_BAR;
        PG8_WAIT_V(2); PG8_BAR;
        PG8_STAGE(PG8_SB(1, 0), cB + kstep, voffB); PG8_STAGE(PG8_SA(1, 0), cA + kstep, voffA); PG8_STAGE(PG8_SB(1, 1), cB + hstepB + kstep, voffB);
        PG8_WAIT_V(6); PG8_BAR;
    } else {
        PG8_STAGE(PG8_SB(0, 0), cB, voffB); PG8_STAGE(PG8_SA(0, 0), cA, voffA); PG8_STAGE(PG8_SB(0, 1), cB + hstepB, voffB); PG8_STAGE(PG8_SA(0, 1), cA + hstepA, voffA);
        if (wr == 1) PG8_BAR;
        PG8_WAIT_V(4); PG8_BAR;
        PG8_STAGE(PG8_SB(1, 0), cB + kstep, voffB); PG8_STAGE(PG8_SA(1, 0), cA + kstep, voffA); PG8_STAGE(PG8_SB(1, 1), cB + hstepB + kstep, voffB);
        PG8_WAIT_V(6); PG8_BAR;
    }
    for (;;) {
        const bool has_next = S.next(ui + 1, nxt);
        const char* nA = has_next ? (const char*)g.A + (size_t)nxt.pm * tstepA : cA; const char* nB = has_next ? (const char*)g.Bt + (size_t)nxt.pn * tstepB : cB;
        for (int t = 0; t < nt; t += 2) {
            const bool last = (t == nt - 2);
            const char* a1 = cA + (size_t)(t + 1) * kstep;
            const char* a2 = last ? nA : cA + (size_t)(t + 2) * kstep; const char* b2 = last ? nB : cB + (size_t)(t + 2) * kstep;
            const char* a3 = a2 + kstep; const char* b3 = b2 + kstep;
            if (last && has_next) S.a_ready(nxt);
            if constexpr (SP2) {
            PG8_LDB(B0, 0, 0); PG8_LDB(B1, 0, 1); PG8_SCHED; PG8_LDA(At, 0, 0); PG8_STAGE(PG8_SA(1, 1), a1 + hstepA, voffA);
            PG8_WAIT_V(8); PG8_WAIT_L(0); PG8_BAR; PG8_MMA(0, 0, At, B0); PG8_MMA(0, 1, At, B1); PG8_BAR; PG8_SCHED;
            PG8_LDA(At, 0, 1); PG8_STAGE(PG8_SB(0, 0), b2, voffB); PG8_STAGE(PG8_SB(0, 1), b2 + hstepB, voffB); PG8_STAGE(PG8_SA(0, 0), a2, voffA);
            PG8_WAIT_V(8); PG8_WAIT_L(0); PG8_BAR; PG8_MMA(1, 0, At, B0); PG8_MMA(1, 1, At, B1); PG8_BAR; PG8_SCHED;
            PG8_LDB(B0, 1, 0); PG8_LDB(B1, 1, 1); PG8_SCHED; PG8_LDA(At, 1, 0); PG8_STAGE(PG8_SA(0, 1), a2 + hstepA, voffA);
            PG8_WAIT_V(8); PG8_WAIT_L(0); PG8_BAR; PG8_MMA(0, 0, At, B0); PG8_MMA(0, 1, At, B1); PG8_BAR; PG8_SCHED;
            PG8_LDA(At, 1, 1); PG8_STAGE(PG8_SB(1, 0), b3, voffB); PG8_STAGE(PG8_SB(1, 1), b3 + hstepB, voffB); PG8_STAGE(PG8_SA(1, 0), a3, voffA);
            PG8_WAIT_V(8); PG8_WAIT_L(0); PG8_BAR; PG8_MMA(1, 0, At, B0); PG8_MMA(1, 1, At, B1); PG8_BAR; PG8_SCHED;
            } else {
            PG8_LDB(B0, 0, 0); PG8_SCHED; PG8_LDA(At, 0, 0); PG8_STAGE(PG8_SA(1, 1), a1 + hstepA, voffA);
            PG8_WAIT_L(8); PG8_BAR; PG8_WAIT_L(0); PG8_MMA(0, 0, At, B0); PG8_BAR; PG8_SCHED;
            PG8_LDB(B1, 0, 1); PG8_STAGE(PG8_SB(0, 0), b2, voffB);
            PG8_BAR; PG8_WAIT_L(0); PG8_MMA(0, 1, At, B1); PG8_BAR;
            PG8_LDA(At, 0, 1); PG8_STAGE(PG8_SA(0, 0), a2, voffA);
            PG8_BAR; PG8_WAIT_L(0); PG8_MMA(1, 0, At, B0); PG8_BAR; PG8_SCHED;
            PG8_STAGE(PG8_SB(0, 1), b2 + hstepB, voffB);
            PG8_WAIT_V(6); PG8_BAR; PG8_MMA(1, 1, At, B1); PG8_BAR;
            PG8_LDB(B0, 1, 0); PG8_SCHED; PG8_LDA(At, 1, 0); PG8_STAGE(PG8_SA(0, 1), a2 + hstepA, voffA);
            PG8_WAIT_L(8); PG8_BAR; PG8_WAIT_L(0); PG8_MMA(0, 0, At, B0); PG8_BAR; PG8_SCHED;
            PG8_LDB(B1, 1, 1); PG8_STAGE(PG8_SB(1, 0), b3, voffB);
            PG8_BAR; PG8_WAIT_L(0); PG8_MMA(0, 1, At, B1); PG8_BAR;
            PG8_LDA(At, 1, 1); PG8_STAGE(PG8_SA(1, 0), a3, voffA);
            PG8_BAR; PG8_WAIT_L(0); PG8_MMA(1, 0, At, B0); PG8_BAR; PG8_SCHED;
            PG8_STAGE(PG8_SB(1, 1), b3 + hstepB, voffB);
            PG8_WAIT_V(6); PG8_BAR; PG8_MMA(1, 1, At, B1); PG8_BAR;
            }
        }
        if constexpr (ALIGN_EPI) { if (wr == 0) PG8_BAR; }
        if constexpr (!Epi::AFTER_DRAIN) { int tl2 = threadIdx.x; asm volatile("" : "+v"(tl2)); E(acc, cur, wr, wc, tl2 & 15, (tl2 & 63) >> 4); S.done(cur); }
        if (!has_next) break;
#pragma unroll
        for (int a = 0; a < 2; ++a)
#pragma unroll
            for (int b = 0; b < 2; ++b)
#pragma unroll
                for (int m = 0; m < 4; ++m)
#pragma unroll
                    for (int n = 0; n < 2; ++n) acc[a][b][m][n] = (f32x4){0.f, 0.f, 0.f, 0.f};
        cur = nxt; cA = nA; cB = nB; ++ui;
        if constexpr (ALIGN_EPI) { if (wr == 1) PG8_BAR; }
    }
    PG8_WAIT_V(0);
    if constexpr (!ALIGN_EPI) { if (wr == 0) PG8_BAR; }
    PG8_BAR;
    if constexpr (Epi::AFTER_DRAIN) { E.fused(acc, cur, wr, wc, fr, fq, lds, wid, lane); S.done(cur); }
#undef PG8_SA
#undef PG8_SB
#undef PG8_STAGE
#undef PG8_LDA
#undef PG8_LDB
#undef PG8_MMA
#undef PG8_WAIT_V
#undef PG8_WAIT_L
#undef PG8_BAR
#undef PG8_SCHED
}
}

#define LAS __attribute__((address_space(3)))
typedef unsigned short bf16;
typedef unsigned v4u __attribute__((ext_vector_type(4)));
typedef unsigned v2u __attribute__((ext_vector_type(2)));
typedef float f32x4 __attribute__((ext_vector_type(4)));
typedef short bf16x8 __attribute__((ext_vector_type(8)));

constexpr int T = 16384, SEQ = 2048, NP0 = 2816, NP1 = 3840, FF = 2816;
constexpr int NTHREADS = 512, NWAVES = 8;
constexpr int LDS_BYTES = 147456;
constexpr size_t MiB = 1u << 20;
constexpr size_t WS_CTL = 0, CTL_ZERO_BYTES = 65536;
constexpr size_t WS_ROWSS = 65536;
constexpr size_t WS_CARRY = 512 * 1024;
constexpr size_t WS_W = 1 * MiB;
constexpr size_t W_IN = WS_W, W_OUT = W_IN + 7680 * 1024, W_GU = W_OUT + 2 * MiB, W_DN = W_GU + 11 * MiB, W_PG = W_DN + 5632 * 1024, W_PP = W_PG + 2 * MiB,
                 W_LR = W_PP + 512 * 1024, W_LRU = W_LR + 768 * 1024, W_END = W_LRU + 128 * 1024;
static_assert(W_END <= 35 * MiB, "weights region");
constexpr size_t WS_HB = 35 * MiB;
constexpr size_t WS_PROJ = 67 * MiB;
constexpr size_t WS_Y = 187 * MiB;
constexpr size_t WS_GST = 219 * MiB;
constexpr size_t WS_ALR = 235 * MiB;
constexpr size_t WS_PB = 243 * MiB;
constexpr size_t WS_RKR = 251 * MiB;
constexpr size_t WS_GDEC = WS_RKR + 512 * 1024;
constexpr size_t WS_LEND = 252 * MiB;
constexpr size_t WS_END = 256 * MiB;

static_assert(E_ROWSS == WS_ROWSS && E_HB == WS_HB && E_PROJ == WS_PROJ && E_Y == WS_Y, "epilogue offsets");

__device__ __forceinline__ int fresh_s(int x) { asm volatile("" : "+s"(x)); return x; }
__device__ __forceinline__ int fresh_tid() { int t = threadIdx.x; asm volatile("" : "+v"(t)); return t; }
__device__ __forceinline__ float bf2f(unsigned v) { return __uint_as_float(v << 16); }
typedef float f32x2_t __attribute__((ext_vector_type(2))); typedef __bf16 bf16x2_t __attribute__((ext_vector_type(2)));
__device__ __forceinline__ unsigned pk2(float lo, float hi) { const f32x2_t v = {lo, hi}; const bf16x2_t b = __builtin_convertvector(v, bf16x2_t); return __builtin_bit_cast(unsigned, b); }
__device__ __forceinline__ unsigned f2bf(float f) { return pk2(f, f) & 0xffffu; }
__device__ __forceinline__ void unpack8(const v4u w, float* f) {
    f[0] = __uint_as_float(w.x << 16); f[1] = __uint_as_float(w.x & 0xffff0000u); f[2] = __uint_as_float(w.y << 16); f[3] = __uint_as_float(w.y & 0xffff0000u);
    f[4] = __uint_as_float(w.z << 16); f[5] = __uint_as_float(w.z & 0xffff0000u); f[6] = __uint_as_float(w.w << 16); f[7] = __uint_as_float(w.w & 0xffff0000u);
}
__device__ __forceinline__ v4u pack8(const float* f) { v4u w; w.x = pk2(f[0], f[1]); w.y = pk2(f[2], f[3]); w.z = pk2(f[4], f[5]); w.w = pk2(f[6], f[7]); return w; }
__device__ __forceinline__ void ld8(const bf16* p, float* f) { unpack8(*(const v4u*)p, f); }
__device__ __forceinline__ void ldf8(const float* p, float* f) { const f32x4 a = *(const f32x4*)p, b = *(const f32x4*)(p + 4); f[0] = a[0]; f[1] = a[1]; f[2] = a[2]; f[3] = a[3]; f[4] = b[0]; f[5] = b[1]; f[6] = b[2]; f[7] = b[3]; }
__device__ __forceinline__ float sigmf(float x) { return __builtin_amdgcn_rcpf(1.0f + __expf(-x)); }
__device__ __forceinline__ float logsigf(float z) { return fminf(z, 0.f) - __logf(1.0f + __expf(-fabsf(z))); }
__device__ __forceinline__ float wave_sum(float v) {
#pragma unroll
    for (int o = 1; o < 64; o <<= 1) v += __shfl_xor(v, o);
    return v;
}
#define LDS_WAIT() asm volatile("s_waitcnt lgkmcnt(0)" ::: "memory")

#define XB_TMO      128
#define XB_XCNT(j)  (256  + 64 * (j))
#define XB_XSUB(j)  (1280 + 64 * (j))
#define XB_XGEN(j)  (2304 + 64 * (j))
#define XB_TOP      3328
#define XB_TOPGEN   3392
#define XCD_BAR_WORDS 3456
#define XB_SPIN_CAP (1u << 18)

__device__ __forceinline__ unsigned xb_ld(unsigned* p)              { return __hip_atomic_load(p, __ATOMIC_RELAXED, __HIP_MEMORY_SCOPE_AGENT); }
__device__ __forceinline__ unsigned xb_add(unsigned* p, unsigned v) { return __hip_atomic_fetch_add(p, v, __ATOMIC_RELAXED, __HIP_MEMORY_SCOPE_AGENT); }
__device__ __forceinline__ unsigned xb_xcc_id() { return (unsigned)__builtin_amdgcn_s_getreg((3 << 11) | 20) & 0xFu; }
#define XB_SPIN(cond, bar) do { unsigned _sp = 0; while (cond) { __builtin_amdgcn_s_sleep(1); \
    if ((++_sp & 255u) == 0u) { if (xb_ld(&(bar)[XB_TMO])) break; if (_sp > XB_SPIN_CAP) { atomicAdd(&(bar)[XB_TMO], 1u); break; } } } } while (0)

struct XcdBarrier {
    unsigned* bar; unsigned x;
    volatile LAS unsigned* st;
};

__device__ __forceinline__ XcdBarrier xcd_barrier_post(unsigned* bar, volatile LAS unsigned* st) {
    XcdBarrier b; b.bar = bar; b.x = xb_xcc_id(); b.st = st;
    if (threadIdx.x == 0) (void)xb_add(&bar[XB_XCNT(b.x)], 1u);
    return b;
}
__device__ __forceinline__ void xcd_barrier_complete(unsigned* bar, unsigned x, unsigned& nloc, unsigned& nx) {
    const unsigned G = gridDim.x * gridDim.y * gridDim.z;
    unsigned sum, cnt, mine, sp = 0u;
    for (;;) {
        sum = 0u; cnt = 0u; mine = 0u;
#pragma unroll
        for (unsigned j = 0; j < 16; ++j) { const unsigned c = xb_ld(&bar[XB_XCNT(j)]); sum += c; cnt += (c > 0u) ? 1u : 0u; mine = (j == x) ? c : mine; }
        if (sum == G) break;
        __builtin_amdgcn_s_sleep(1);
        if ((++sp & 255u) == 0u) { if (xb_ld(&bar[XB_TMO])) break; if (sp > XB_SPIN_CAP) { atomicAdd(&bar[XB_TMO], 1u); break; } }
    }
    nloc = mine > 0u ? mine : 1u; nx = cnt > 0u ? cnt : 1u;
}

__device__ __forceinline__ void xcd_barrier(const XcdBarrier& b) {
    asm volatile("s_waitcnt vmcnt(0)" ::: "memory");
    __syncthreads();
    if (threadIdx.x == 0) {
        unsigned* bar = b.bar;
        __builtin_amdgcn_s_waitcnt(0);
        unsigned nloc = b.st[0], nx = b.st[1];
        if (nloc == 0u) { xcd_barrier_complete(bar, b.x, nloc, nx); b.st[0] = nloc; b.st[1] = nx; }
        const unsigned old = xb_add(&bar[XB_XSUB(b.x)], 1u);
        const unsigned gen = old / nloc;
        if (old + 1u == (gen + 1u) * nloc) {
            __builtin_amdgcn_fence(__ATOMIC_RELEASE, "agent");
            asm volatile("s_waitcnt vmcnt(0)" ::: "memory");
            const unsigned og = xb_add(&bar[XB_TOP], 1u);
            const unsigned tg = og / nx;
            if (og + 1u == (tg + 1u) * nx) xb_add(&bar[XB_TOPGEN], 1u);
            else XB_SPIN(xb_ld(&bar[XB_TOPGEN]) == tg, bar);
            __builtin_amdgcn_fence(__ATOMIC_ACQUIRE, "agent");
            xb_add(&bar[XB_XGEN(b.x)], 1u);
            asm volatile("s_waitcnt vmcnt(0)" ::: "memory");
        } else {
            XB_SPIN(xb_ld(&bar[XB_XGEN(b.x)]) == gen, bar);
            __builtin_amdgcn_fence(__ATOMIC_ACQUIRE, "agent");
            asm volatile("s_waitcnt vmcnt(0)" ::: "memory");
        }
    }
    __syncthreads();
}

constexpr size_t WS_XBAR = 16384;
constexpr int LDS_XST = LDS_BYTES - 64;

__device__ __forceinline__ f32x4 mma_ll(const LAS bf16* X, int ldx, const LAS bf16* Y, int ldy, int K, f32x4 acc, int lane) {
    const LAS bf16* xp = X + (lane & 15) * ldx + 8 * (lane >> 4);
    const LAS bf16* yp = Y + (lane & 15) * ldy + 8 * (lane >> 4);
    for (int k = 0; k < K; k += 32) {
        const bf16x8 a = *(const LAS bf16x8*)(xp + k), b = *(const LAS bf16x8*)(yp + k);
        acc = __builtin_amdgcn_mfma_f32_16x16x32_bf16(a, b, acc, 0, 0, 0);
    }
    return acc;
}
__device__ __forceinline__ f32x4 mma_lg(const LAS bf16* X, int ldx, const bf16* Y, int ldy, int K, f32x4 acc, int lane) {
    const LAS bf16* xp = X + (lane & 15) * ldx + 8 * (lane >> 4);
    const bf16* yp = Y + (size_t)(lane & 15) * ldy + 8 * (lane >> 4);
    for (int k = 0; k < K; k += 32) {
        const bf16x8 a = *(const LAS bf16x8*)(xp + k), b = *(const bf16x8*)(yp + k);
        acc = __builtin_amdgcn_mfma_f32_16x16x32_bf16(a, b, acc, 0, 0, 0);
    }
    return acc;
}

__device__ __forceinline__ void tr_load(const float* W, int ldw, const float* gain, int ncols, int item, int lane, f32x4 (&v)[8]) {
    const int nblk = ncols / 32, kb = item / nblk, nb = item % nblk, k0 = 64 * kb, n0 = 32 * nb;
#pragma unroll
    for (int i = 0; i < 8; ++i) { const int kk = 8 * i + (lane >> 3), cc = (lane & 7) * 4; v[i] = *(const f32x4*)(W + (size_t)(k0 + kk) * ldw + n0 + cc); if (gain) v[i] = v[i] * gain[k0 + kk]; }
}
__device__ __forceinline__ void tr_store(int K, bf16* WT, int ncols, int mode, LAS float* scr, int item, int lane, const f32x4 (&v)[8]) {
    const int nblk = ncols / 32, kb = item / nblk, nb = item % nblk, k0 = 64 * kb, n0 = 32 * nb;
#pragma unroll
    for (int i = 0; i < 8; ++i) { const int kk = 8 * i + (lane >> 3), cc = (lane & 7) * 4; scr[kk * 33 + cc] = v[i].x; scr[kk * 33 + cc + 1] = v[i].y; scr[kk * 33 + cc + 2] = v[i].z; scr[kk * 33 + cc + 3] = v[i].w; }
    LDS_WAIT(); asm volatile("" ::: "memory");
    const int c = lane & 7;
#pragma unroll
    for (int j = 0; j < 4; ++j) { const int n = (lane >> 3) + 8 * j; const LAS float* s = scr + (8 * c) * 33 + n;
        v4u o; o.x = pk2(s[0 * 33], s[1 * 33]); o.y = pk2(s[2 * 33], s[3 * 33]); o.z = pk2(s[4 * 33], s[5 * 33]); o.w = pk2(s[6 * 33], s[7 * 33]);
        const int nn = n0 + n; const int r = mode == 0 ? nn : (8 * (nn >> 2) + (nn & 3) + (mode == 2 ? 4 : 0));
        *(v4u*)(WT + (size_t)r * K + k0 + 8 * c) = o; }
    LDS_WAIT(); asm volatile("" ::: "memory");
}
__device__ __forceinline__ void tr_item(const float* W, int ldw, int K, const float* gain, bf16* WT, int ncols, int mode, LAS float* scr, int item, int lane) {
    f32x4 v[8]; tr_load(W, ldw, gain, ncols, item, lane, v); tr_store(K, WT, ncols, mode, scr, item, lane, v);
}
__device__ __forceinline__ void tr_job(const float* W, int ldw, int K, const float* gain, bf16* WT, int ncols, int mode, LAS unsigned char* lds, int gw, int NGW, int wave, int lane) {
    LAS float* scr = (LAS float*)(lds + wave * 8704);
    const int nitems = (K / 64) * (ncols / 32);
    for (int it = gw; it < nitems; it += NGW) tr_item(W, ldw, K, gain, WT, ncols, mode, scr, it, lane);
}
__device__ __forceinline__ void cvt_layer_weights(PRef p, int li, LAS unsigned char* lds, int gw, int NGW, int wave, int lane) {
    unsigned char* ws = p.ws;
    tr_job(li == 0 ? p.in[14] : p.in[27], 1024, 1024, nullptr, (bf16*)(ws + W_OUT), 1024, 0, lds, gw, NGW, wave, lane);
    tr_job(p.in[30] + (size_t)li * 1024 * FF, FF, 1024, p.in[29] + li * 1024, (bf16*)(ws + W_GU), FF, 1, lds, gw, NGW, wave, lane);
    tr_job(p.in[31] + (size_t)li * 1024 * FF, FF, 1024, p.in[29] + li * 1024, (bf16*)(ws + W_GU), FF, 2, lds, gw, NGW, wave, lane);
    tr_job(p.in[32] + (size_t)li * FF * 1024, 1024, FF, nullptr, (bf16*)(ws + W_DN), 1024, 0, lds, gw, NGW, wave, lane);
    tr_job(p.in[34] + (size_t)li * 1024 * 1024, 1024, 1024, p.in[33] + li * 1024, (bf16*)(ws + W_PG), 1024, 0, lds, gw, NGW, wave, lane);
    tr_job(p.in[36] + (size_t)li * 256 * 1024, 1024, 256, nullptr, (bf16*)(ws + W_PP), 1024, 0, lds, gw, NGW, wave, lane);
}
__device__ __forceinline__ void cvt_p(PRef p, int li, int gw, int NGW, int lane) {
    const float* src = p.in[1] + (size_t)li * T * 256; bf16* pb = (bf16*)(p.ws + WS_PB);
    for (int m = gw; m < T; m += NGW) { const f32x4 v = *((const f32x4*)(src + (size_t)m * 256) + lane); v2u o; o.x = pk2(v.x, v.y); o.y = pk2(v.z, v.w); *((v2u*)(pb + (size_t)m * 256) + lane) = o; }
}

constexpr int CVT1_ITEMS = 512 + 3 * 1408 + 512 + 128 + 1024;
struct Cvt1Job { const float* W; const float* gain; bf16* WT; int ldw, K, ncols, mode, item; };
__device__ __forceinline__ Cvt1Job cvt1_job(PRef p, int idx) {
    unsigned char* ws = p.ws; Cvt1Job j;
    if (idx < 512) { j = Cvt1Job{p.in[27], nullptr, (bf16*)(ws + W_OUT), 1024, 1024, 1024, 0, idx}; return j; } idx -= 512;
    if (idx < 1408) { j = Cvt1Job{p.in[30] + (size_t)1024 * FF, p.in[29] + 1024, (bf16*)(ws + W_GU), FF, 1024, FF, 1, idx}; return j; } idx -= 1408;
    if (idx < 1408) { j = Cvt1Job{p.in[31] + (size_t)1024 * FF, p.in[29] + 1024, (bf16*)(ws + W_GU), FF, 1024, FF, 2, idx}; return j; } idx -= 1408;
    if (idx < 1408) { j = Cvt1Job{p.in[32] + (size_t)FF * 1024, nullptr, (bf16*)(ws + W_DN), 1024, FF, 1024, 0, idx}; return j; } idx -= 1408;
    if (idx < 512) { j = Cvt1Job{p.in[34] + (size_t)1024 * 1024, p.in[33] + 1024, (bf16*)(ws + W_PG), 1024, 1024, 1024, 0, idx}; return j; } idx -= 512;
    j = Cvt1Job{p.in[36] + (size_t)256 * 1024, nullptr, (bf16*)(ws + W_PP), 1024, 256, 1024, 0, idx}; return j;
}
constexpr int CVT1_W_ITEMS = CVT1_ITEMS - 1024;
__device__ __forceinline__ void cvt1_load(PRef p, int idx, int lane, f32x4 (&v)[8]) {
    if (idx < CVT1_W_ITEMS) { const Cvt1Job j = cvt1_job(p, idx); tr_load(j.W, j.ldw, j.gain, j.ncols, j.item, lane, v); }
    else { const float* src = p.in[1] + (size_t)T * 256 + (size_t)(idx - CVT1_W_ITEMS) * 16 * 256;
#pragma unroll
        for (int r = 0; r < 8; ++r) v[r] = *((const f32x4*)(src + (size_t)r * 256) + lane); }
}
__device__ __forceinline__ void cvt1_store(PRef p, int idx, LAS float* scr, int lane, const f32x4 (&v)[8]) {
    if (idx < CVT1_W_ITEMS) { const Cvt1Job j = cvt1_job(p, idx); tr_store(j.K, j.WT, j.ncols, j.mode, scr, j.item, lane, v); }
    else { const int m0 = (idx - CVT1_W_ITEMS) * 16; const float* src = p.in[1] + (size_t)T * 256; bf16* pb = (bf16*)(p.ws + WS_PB);
#pragma unroll
        for (int r = 0; r < 8; ++r) { v2u o; o.x = pk2(v[r].x, v[r].y); o.y = pk2(v[r].z, v[r].w); *((v2u*)(pb + (size_t)(m0 + r) * 256) + lane) = o; }
        for (int r = 8; r < 16; ++r) { const f32x4 w = *((const f32x4*)(src + (size_t)(m0 + r) * 256) + lane); v2u o; o.x = pk2(w.x, w.y); o.y = pk2(w.z, w.w); *((v2u*)(pb + (size_t)(m0 + r) * 256) + lane) = o; } }
}
__device__ __forceinline__ void cvt1_flat(PRef p, int idx, LAS float* scr, int lane) { f32x4 v[8]; cvt1_load(p, idx, lane, v); cvt1_store(p, idx, scr, lane, v); }
__device__ __forceinline__ void phase_prologue(PRef p, LAS unsigned char* lds, int gw, int NGW, int wave, int lane) {
    unsigned char* ws = p.ws; const int gtid = gw * 64 + lane, NGT = NGW * 64;
    tr_job(p.in[3], 2576, 1024, p.in[28], (bf16*)(ws + W_IN), 2560, 0, lds, gw, NGW, wave, lane);
    for (int it = gtid; it < 256 * 128; it += NGT) { const int n = it >> 7, kc = it & 127; float o[8];
#pragma unroll
        for (int i = 0; i < 8; ++i) { const int k = 8 * kc + i; const float* wr = p.in[3] + (size_t)k * 2576 + 2560; float s = 0.f;
#pragma unroll
            for (int r = 0; r < 16; ++r) s += wr[r] * p.in[11][r * 256 + n];
            o[i] = s * p.in[28][k]; }
        *(v4u*)((bf16*)(ws + W_IN) + (size_t)(2560 + n) * 1024 + 8 * kc) = pack8(o); }
    cvt_layer_weights(p, 0, lds, gw, NGW, wave, lane);
    for (int it = gtid; it < 1536 * 32; it += NGT) { const int n = it >> 5, kc = it & 31; float o[8];
#pragma unroll
        for (int i = 0; i < 8; ++i) { const int k = 8 * kc + i; float v = 0.f;
            if (n < 512) { if (k < 64) v = p.in[19][k * 512 + n]; }
            else if (n < 1024) { if (k >= 64 && k < 128) v = p.in[21][(k - 64) * 512 + (n - 512)]; }
            else { if (k >= 128) v = p.in[22][(k - 128) * 512 + (n - 1024)]; }
            o[i] = v; }
        *(v4u*)((bf16*)(ws + W_LR) + (size_t)n * 256 + 8 * kc) = pack8(o); }
    for (int it = gtid; it < 2 * 8 * 64 * 8; it += NGT) { const int ic = it & 7, j = (it >> 3) & 63, g = (it >> 9) & 7, which = it >> 12; const float* src = which ? p.in[8] : p.in[6]; float o[8];
#pragma unroll
        for (int i = 0; i < 8; ++i) o[i] = src[(g * 64 + 8 * ic + i) * 64 + j];
        *(v4u*)((bf16*)(ws + W_LRU) + (size_t)which * 32768 + (g * 64 + j) * 64 + 8 * ic) = pack8(o); }
    { const float* x = p.in[0]; bf16* hb = (bf16*)(ws + WS_HB); float* rss = (float*)(ws + WS_ROWSS);
      for (int m = gw; m < T; m += NGW) { const f32x4* xr = (const f32x4*)(x + (size_t)m * 1024) + lane; float s = 0.f; v2u* o8 = (v2u*)(hb + (size_t)m * 1024) + lane;
#pragma unroll
          for (int j = 0; j < 4; ++j) { const f32x4 v = xr[64 * j]; s += (v.x * v.x + v.y * v.y) + (v.z * v.z + v.w * v.w); v2u o; o.x = pk2(v.x, v.y); o.y = pk2(v.z, v.w); o8[64 * j] = o; }
          s = wave_sum(s); if (lane == 0) rss[m] = s; } }
    cvt_p(p, 0, gw, NGW, lane);
}

__device__ __forceinline__ void lru_local_item(PRef p, LAS unsigned char* lds, int item, int tid, int wave, int lane) {
    const int c = item & 31, b = item >> 5;
    const bf16* proj = (const bf16*)(p.ws + WS_PROJ);
    constexpr int LX = 520;
    constexpr int LR = 65;
    LAS bf16* Xs = (LAS bf16*)lds; LAS float* R = (LAS float*)(lds + 66560); LAS float* I = (LAS float*)(lds + 66560 + 16640);
    LAS float* SEGH = (LAS float*)(lds + 66560 + 33280); LAS float* SEGP = SEGH + 512;
    const int tl = tid >> 3, c8 = (tid & 7) * 8, t0 = b * SEQ + 64 * c;
    LAS float* LS = SEGP + 512; LAS float* BR = LS + 512; LAS float* BI = BR + 512; LAS float* CARH = BI + 512; LAS float* CARP = CARH + 512;
    LS[tid] = logsigf(p.in[10][tid]); BR[tid] = p.in[7][tid]; BI[tid] = p.in[9][tid];
#pragma unroll 2
    for (int g = 0; g < 8; ++g) { const int ch0 = 64 * g + c8; f32x4 a0 = *(const f32x4*)(p.in[5] + ch0), a1 = *(const f32x4*)(p.in[5] + ch0 + 4);
#pragma unroll
        for (int k = 0; k < 4; ++k) { const int tt = 64 * c + tl - 3 + k; if (tt >= 0) { float xv[8]; ld8(proj + (size_t)(b * SEQ + tt) * NP0 + ch0, xv);
                const f32x4 w0 = *(const f32x4*)(p.in[4] + k * 512 + ch0), w1 = *(const f32x4*)(p.in[4] + k * 512 + ch0 + 4);
                a0 = a0 + w0 * (f32x4){xv[0], xv[1], xv[2], xv[3]}; a1 = a1 + w1 * (f32x4){xv[4], xv[5], xv[6], xv[7]}; } }
        const float av[8] = {a0[0], a0[1], a0[2], a0[3], a1[0], a1[1], a1[2], a1[3]};
        *(LAS v4u*)(Xs + tl * LX + ch0) = pack8(av); }
    __syncthreads();
    const int rt = wave & 3, gate = wave >> 2, q = lane >> 4;
    const bf16* WTb = (const bf16*)(p.ws + W_LRU) + gate * 32768 + (size_t)(lane & 15) * 64 + 8 * q;
    bf16x8 wf[4][2];
#pragma unroll
    for (int ct = 0; ct < 4; ++ct) { wf[ct][0] = *(const bf16x8*)(WTb + 16 * ct * 64); wf[ct][1] = *(const bf16x8*)(WTb + 16 * ct * 64 + 32); }
    for (int g = 0; g < 8; ++g) { const int ch0 = 64 * g + c8;
        { LAS float* dst = gate ? I : R; const LAS float* bias = gate ? BI : BR;
          const LAS bf16* xp = Xs + (16 * rt + (lane & 15)) * LX + 64 * g + 8 * q; const bf16x8 a0 = *(const LAS bf16x8*)xp, a1 = *(const LAS bf16x8*)(xp + 32);
          f32x4 acc[4];
#pragma unroll
          for (int ct = 0; ct < 4; ++ct) { acc[ct] = (f32x4){0.f, 0.f, 0.f, 0.f}; acc[ct] = __builtin_amdgcn_mfma_f32_16x16x32_bf16(a0, wf[ct][0], acc[ct], 0, 0, 0); acc[ct] = __builtin_amdgcn_mfma_f32_16x16x32_bf16(a1, wf[ct][1], acc[ct], 0, 0, 0); }
          { const int gn = g < 7 ? g + 1 : 7;
#pragma unroll
            for (int ct = 0; ct < 4; ++ct) { wf[ct][0] = *(const bf16x8*)(WTb + gn * 4096 + 16 * ct * 64); wf[ct][1] = *(const bf16x8*)(WTb + gn * 4096 + 16 * ct * 64 + 32); } }
#pragma unroll
          for (int ct = 0; ct < 4; ++ct) { const int ch = 16 * ct + (lane & 15); const float bv = bias[64 * g + ch];
#pragma unroll
              for (int j = 0; j < 4; ++j) dst[(16 * rt + 4 * q + j) * LR + ch] = sigmf(acc[ct][j] + bv); } }
        __syncthreads();
        {
#pragma unroll
          for (int i = 0; i < 8; ++i) { const float r = R[tl * LR + c8 + i], ii = I[tl * LR + c8 + i], xc = bf2f(Xs[tl * LX + ch0 + i]);
              const float la = 8.0f * r * LS[ch0 + i]; const float a = __expf(la); const float u = __builtin_amdgcn_sqrtf(fmaxf(1.0f - a * a, 0.f)) * (ii * xc);
              R[tl * LR + c8 + i] = a; I[tl * LR + c8 + i] = u; } }
        __syncthreads();
        { const int ch = tid & 63, seg = tid >> 6; float h = 0.f, P = 1.f;
#pragma unroll
          for (int t = 8 * seg; t < 8 * seg + 8; ++t) { const float a = R[t * LR + ch], u = I[t * LR + ch]; h = a * h + u; P *= a; I[t * LR + ch] = h; R[t * LR + ch] = P; }
          SEGH[seg * 64 + ch] = h; SEGP[seg * 64 + ch] = P; }
        __syncthreads();
        { const int ch = tid & 63, seg = tid >> 6; float ch_ = 0.f, cp_ = 1.f;
#pragma unroll
          for (int s2 = 0; s2 < 7; ++s2) { const float sp = SEGP[s2 * 64 + ch], sh = SEGH[s2 * 64 + ch]; if (s2 < seg) { ch_ = sp * ch_ + sh; cp_ *= sp; } }
          CARH[seg * 64 + ch] = ch_; CARP[seg * 64 + ch] = cp_; }
        __syncthreads();
        { bf16* hl = (bf16*)(p.ws + WS_HB); bf16* Pc = hl + (size_t)T * 512; const int seg = tl >> 3; float ho[8], po[8];
#pragma unroll
          for (int i = 0; i < 8; ++i) { const int ch = c8 + i; const float pl = R[tl * LR + ch]; ho[i] = I[tl * LR + ch] + pl * CARH[seg * 64 + ch]; po[i] = pl * CARP[seg * 64 + ch]; }
          *(v4u*)(hl + (size_t)(t0 + tl) * 512 + ch0) = pack8(ho); *(v4u*)(Pc + (size_t)(t0 + tl) * 512 + ch0) = pack8(po);
          if (tl == 63) { float* pe = (float*)(p.ws + WS_LEND);
#pragma unroll
              for (int i = 0; i < 8; ++i) { pe[(b * 32 + c) * 512 + ch0 + i] = po[i]; pe[131072 + (b * 32 + c) * 512 + ch0 + i] = ho[i]; } } }
        __syncthreads();
    }
}
__device__ __forceinline__ void lru_prefix(PRef p, int gtid, int NGT) {
    const float* pe = (const float*)(p.ws + WS_LEND); float* ci = (float*)(p.ws + WS_CARRY);
    for (int it = gtid; it < 4096; it += NGT) { const int b = it >> 9, ch = it & 511; float carry = 0.f; float pv[32], hv[32];
#pragma unroll
        for (int c = 0; c < 32; ++c) { const int o = (b * 32 + c) * 512 + ch; pv[c] = pe[o]; hv[c] = pe[131072 + o]; }
#pragma unroll
        for (int c = 0; c < 32; ++c) { const int o = (b * 32 + c) * 512 + ch; ci[o] = carry; carry = pv[c] * carry + hv[c]; } }
}
__device__ __forceinline__ float tanh_fast(float u) { return 1.0f - 2.0f * __builtin_amdgcn_rcpf(1.0f + __expf(2.0f * u)); }
__device__ __forceinline__ float gelu_tanh(float x) { const float u = 0.7978845608028654f * (x + 0.044715f * x * x * x); return 0.5f * x * (1.0f + tanh_fast(u)); }
__device__ __forceinline__ void lru_out(PRef p, int gtid, int NGT) {
    const bf16* proj = (const bf16*)(p.ws + WS_PROJ); const bf16* hl = (const bf16*)(p.ws + WS_HB); const bf16* Pc = hl + (size_t)T * 512; const float* ci = (const float*)(p.ws + WS_CARRY);
    bf16* y = (bf16*)(p.ws + WS_Y);
    int it = gtid; if (it >= T * 64) return;
    v4u rh, rp, rg; f32x4 c0, c1;
    { const int row = it >> 6, c8 = (it & 63) * 8, b = row >> 11, c = (row & 2047) >> 6; rh = *(const v4u*)(hl + (size_t)row * 512 + c8); rp = *(const v4u*)(Pc + (size_t)row * 512 + c8); rg = *(const v4u*)(proj + (size_t)row * NP0 + 512 + c8);
      const float* cp = ci + (b * 32 + c) * 512 + c8; c0 = *(const f32x4*)cp; c1 = *(const f32x4*)(cp + 4); }
    for (;;) { const int nx = it + NGT; const bool more = nx < T * 64; v4u nh = rh, np = rp, ng = rg; f32x4 n0 = c0, n1 = c1;
        if (more) { const int row = nx >> 6, c8 = (nx & 63) * 8, b = row >> 11, c = (row & 2047) >> 6; nh = *(const v4u*)(hl + (size_t)row * 512 + c8); np = *(const v4u*)(Pc + (size_t)row * 512 + c8); ng = *(const v4u*)(proj + (size_t)row * NP0 + 512 + c8);
            const float* cp = ci + (b * 32 + c) * 512 + c8; n0 = *(const f32x4*)cp; n1 = *(const f32x4*)(cp + 4); }
        { const int row = it >> 6, c8 = (it & 63) * 8; float h[8], P[8], gt[8], o[8]; unpack8(rh, h); unpack8(rp, P); unpack8(rg, gt); const float cr[8] = {c0[0], c0[1], c0[2], c0[3], c1[0], c1[1], c1[2], c1[3]};
#pragma unroll
          for (int i = 0; i < 8; ++i) o[i] = (h[i] + P[i] * cr[i]) * gelu_tanh(gt[i]);
          *(v4u*)(y + (size_t)row * 1024 + c8) = pack8(o); }
        if (!more) break; it = nx; rh = nh; rp = np; rg = ng; c0 = n0; c1 = n1; }
}

template <bool RET> struct LA {
    static constexpr int DK = RET ? 128 : 64, C = RET ? 128 : 64, NCH = SEQ / C, TPT = NTHREADS / C, KPT = DK / TPT, VPT = 128 / TPT, LQ = DK + 8, LT = C + 8;
    static constexpr int O_QS = 0, O_KS = O_QS + C * LQ * 2, O_VT = O_KS + C * LQ * 2, O_SC = O_VT + 128 * LT * 2, O_F = O_SC + C * LT * 2, O_OF = RET ? 0 : O_F + 16640;
    static constexpr int O_KT = O_QS;
    static_assert(DK * LT * 2 <= 2 * C * LQ * 2, "Kt fits");
    static_assert(RET ? (O_SC + C * LT * 2 <= LDS_BYTES - 256 && 128 * 133 * 4 <= 2 * 128 * 136 * 2) : (O_OF + 64 * 133 * 4 <= 98304 && 98304 + 2048 <= LDS_BYTES - 256), "LA LDS");
};
__device__ __forceinline__ void gla_cum(PRef p, LAS unsigned char* lds, const bf16* proj, int t0, int h, int tid) {
    LAS float* F = (LAS float*)(lds + LA<false>::O_F); const int tl = tid >> 3, c8 = (tid & 7) * 8;
    float z[8], bg[8]; ld8(proj + (size_t)(t0 + tl) * NP0 + 2560 + 64 * h + c8, z); ldf8(p.in[12] + 64 * h + c8, bg);
#pragma unroll
    for (int i = 0; i < 8; ++i) F[tl * 65 + c8 + i] = logsigf(z[i] + bg[i]) * (1.0f / 16.0f);
    __syncthreads();
    LAS float* SEG = (LAS float*)(lds + 98304);
    { const int ch = tid & 63, seg = tid >> 6; float run = 0.f;
#pragma unroll
      for (int t = 8 * seg; t < 8 * seg + 8; ++t) { run += F[t * 65 + ch]; F[t * 65 + ch] = run; }
      SEG[seg * 64 + ch] = run; }
    __syncthreads();
    { const int ch = tid & 63, seg = tid >> 6; float off = 0.f;
#pragma unroll
      for (int s2 = 0; s2 < 7; ++s2) { const float v = SEG[s2 * 64 + ch]; if (s2 < seg) off += v; }
#pragma unroll
      for (int t = 8 * seg; t < 8 * seg + 8; ++t) F[t * 65 + ch] += off; }
    __syncthreads();
}
template <bool RET> __device__ __forceinline__ void la_load_vt(LAS unsigned char* lds, const bf16* vsrc  , int ld, int tid) {
    typedef LA<RET> L; LAS bf16* Vt = (LAS bf16*)(lds + L::O_VT); const int tl = tid / L::TPT, v0 = (tid % L::TPT) * L::VPT;
#pragma unroll
    for (int s = 0; s < L::VPT / 8; ++s) { float v[8]; ld8(vsrc + (size_t)tl * ld + v0 + 8 * s, v);
#pragma unroll
        for (int i = 0; i < 8; ++i) Vt[(v0 + 8 * s + i) * L::LT + tl] = (bf16)f2bf(v[i]); }
}
__device__ __forceinline__ void rot_cs(int pos_i, int part, float* cs, float* sn) {
    const float pos = (float)pos_i;
#pragma unroll
    for (int i = 0; i < 16; ++i) { const float invr = __builtin_amdgcn_exp2f(-(float)(16 * part + i) * (13.287712379549449f / 64.0f)) * 0.15915494309189535f;
        const float hi = __uint_as_float(__float_as_uint(invr) & 0xfffff000u), lo = invr - hi;
        const float rev = __builtin_amdgcn_fractf(pos * hi) + pos * lo;
        sn[i] = __builtin_amdgcn_sinf(rev); cs[i] = __builtin_amdgcn_cosf(rev); }
}
__device__ __forceinline__ void ret_rot16(const bf16* src, const float* cs, const float* sn, int part, float* o1, float* o2) {
    float x1[16], x2[16]; ld8(src + 16 * part, x1); ld8(src + 16 * part + 8, x1 + 8); ld8(src + 64 + 16 * part, x2); ld8(src + 64 + 16 * part + 8, x2 + 8);
#pragma unroll
    for (int i = 0; i < 16; ++i) { o1[i] = x1[i] * cs[i] - x2[i] * sn[i]; o2[i] = x2[i] * cs[i] + x1[i] * sn[i]; }
}

template <bool RET> __device__ __forceinline__ void la_local_item(PRef p, LAS unsigned char* lds, int item, int tid, int wave, int lane) {
    typedef LA<RET> L; const int c = item % L::NCH, h = (item / L::NCH) & 3, b = item / (L::NCH * 4), t0 = b * SEQ + L::C * c;
    const bf16* proj = (const bf16*)(p.ws + WS_PROJ); LAS bf16* Kt = (LAS bf16*)(lds + L::O_KT); LAS bf16* Vt = (LAS bf16*)(lds + L::O_VT);
    bf16* state = RET ? (bf16*)(p.ws + WS_HB) : (bf16*)(p.ws + WS_GST);
    if (!RET) {
        la_load_vt<false>(lds, proj + (size_t)t0 * NP0 + 1536 + 128 * h, NP0, tid);
        const int tl = tid >> 3, c8 = (tid & 7) * 8; const v4u kraw = *(const v4u*)(proj + (size_t)(t0 + tl) * NP0 + 1280 + 64 * h + c8);
        gla_cum(p, lds, proj, t0, h, tid);
        LAS float* F = (LAS float*)(lds + L::O_F); float kv[8]; unpack8(kraw, kv);
#pragma unroll
        for (int i = 0; i < 8; ++i) { const float ge = F[63 * 65 + c8 + i], gt = F[tl * 65 + c8 + i]; Kt[(c8 + i) * L::LT + tl] = (bf16)f2bf(kv[i] * __expf(ge - gt));
            if (tl == 63) ((float*)(p.ws + WS_GDEC))[item * 64 + c8 + i] = __expf(ge); }
    } else {
        la_load_vt<true>(lds, proj + (size_t)t0 * NP1 + 1024 + 128 * h, NP1, tid);
        const int tl = tid >> 2, part = tid & 3; float cs[16], sn[16]; rot_cs(((const int*)p.in[2])[t0 + tl], part, cs, sn); const float lg = log1pf(-exp2f(-5.0f - (float)h));
        float k1[16], k2[16]; ret_rot16(proj + (size_t)(t0 + tl) * NP1 + 512 + 128 * h, cs, sn, part, k1, k2); const float f = __expf((float)(127 - tl) * lg);
#pragma unroll
        for (int i = 0; i < 16; ++i) { Kt[(16 * part + i) * L::LT + tl] = (bf16)f2bf(k1[i] * f); Kt[(64 + 16 * part + i) * L::LT + tl] = (bf16)f2bf(k2[i] * f); }
    }
    __syncthreads();
    { const int q = lane >> 4; bf16* dst = state + (size_t)item * 128 * L::DK;
      for (int kt = 0; kt < L::DK / 16; ++kt) { f32x4 acc = {0.f, 0.f, 0.f, 0.f}; acc = mma_ll(Vt + 16 * wave * L::LT, L::LT, Kt + 16 * kt * L::LT, L::LT, L::C, acc, lane);
#pragma unroll
          for (int j = 0; j < 4; ++j) dst[(16 * wave + 4 * q + j) * L::DK + 16 * kt + (lane & 15)] = (bf16)f2bf(acc[j]); } }
    __syncthreads();
}
template <bool RET> __device__ __forceinline__ void la_prefix(PRef p, int gtid, int NGT) {
    typedef LA<RET> L; constexpr int NP = 128 * L::DK / 2; unsigned* state = RET ? (unsigned*)(p.ws + WS_HB) : (unsigned*)(p.ws + WS_GST); const float* dec = (const float*)(p.ws + WS_GDEC);
    for (int it = gtid; it < 32 * NP; it += NGT) { const int bh = it / NP, pe = it % NP, k = (2 * pe) % L::DK; float s0 = 0.f, s1 = 0.f;
        unsigned w[L::NCH]; float d0[L::NCH], d1[L::NCH];
        float dr = 0.f; if (RET) { const float lg = log1pf(-exp2f(-5.0f - (float)(bh & 3))); dr = __expf(128.0f * lg); }
#pragma unroll
        for (int c = 0; c < L::NCH; ++c) { w[c] = state[(size_t)(bh * L::NCH + c) * NP + pe];
            if (RET) { d0[c] = dr; d1[c] = dr; } else { d0[c] = dec[(bh * L::NCH + c) * 64 + k]; d1[c] = dec[(bh * L::NCH + c) * 64 + k + 1]; } }
#pragma unroll
        for (int c = 0; c < L::NCH; ++c) { state[(size_t)(bh * L::NCH + c) * NP + pe] = pk2(s0, s1);
            s0 = s0 * d0[c] + __uint_as_float(w[c] << 16); s1 = s1 * d1[c] + __uint_as_float(w[c] & 0xffff0000u); } }
}
template <bool RET> __device__ __forceinline__ void la_out_item(PRef p, LAS unsigned char* lds, int item, int tid, int wave, int lane) {
    typedef LA<RET> L; const int c = item % L::NCH, h = (item / L::NCH) & 3, b = item / (L::NCH * 4), t0 = b * SEQ + L::C * c;
    bf16* proj = (bf16*)(p.ws + WS_PROJ); LAS bf16* Qs = (LAS bf16*)(lds + L::O_QS); LAS bf16* Ks = (LAS bf16*)(lds + L::O_KS); LAS bf16* Vt = (LAS bf16*)(lds + L::O_VT); LAS bf16* Sc = (LAS bf16*)(lds + L::O_SC);
    LAS float* Of = (LAS float*)(lds + L::O_OF);
    const bf16* state = (RET ? (const bf16*)(p.ws + WS_HB) : (const bf16*)(p.ws + WS_GST)) + (size_t)item * 128 * L::DK;
    float inter_scale = 1.0f;
    const int ptl = tid / L::TPT, pv0 = (tid % L::TPT) * L::VPT;
    const bf16* gsrc0 = RET ? proj + (size_t)(t0 + ptl) * NP1 + 1536 + 128 * h + pv0 : proj + (size_t)(t0 + ptl) * NP0 + 2048 + 128 * h + pv0;
    const float* gn0 = (RET ? p.in[16] : p.in[13]) + 128 * h + pv0;
    v4u graw[L::VPT / 8]; f32x4 gnr[L::VPT / 4];
#pragma unroll
    for (int s8 = 0; s8 < L::VPT / 8; ++s8) graw[s8] = *(const v4u*)(gsrc0 + 8 * s8);
#pragma unroll
    for (int s4 = 0; s4 < L::VPT / 4; ++s4) gnr[s4] = *(const f32x4*)(gn0 + 4 * s4);
    if (!RET) {
        la_load_vt<false>(lds, proj + (size_t)t0 * NP0 + 1536 + 128 * h, NP0, tid);
        const int tl = tid >> 3, c8 = (tid & 7) * 8; const v4u qraw = *(const v4u*)(proj + (size_t)(t0 + tl) * NP0 + 1024 + 64 * h + c8), kraw = *(const v4u*)(proj + (size_t)(t0 + tl) * NP0 + 1280 + 64 * h + c8);
        gla_cum(p, lds, proj, t0, h, tid);
        LAS float* F = (LAS float*)(lds + L::O_F); float qv[8], kv[8], qo[8], ko[8]; unpack8(qraw, qv); unpack8(kraw, kv);
#pragma unroll
        for (int i = 0; i < 8; ++i) { const float gt = F[tl * 65 + c8 + i]; qo[i] = qv[i] * 0.125f * __expf(gt); ko[i] = kv[i] * __expf(-gt); }
        *(LAS v4u*)(Qs + tl * L::LQ + c8) = pack8(qo); *(LAS v4u*)(Ks + tl * L::LQ + c8) = pack8(ko);
    } else {
        la_load_vt<true>(lds, proj + (size_t)t0 * NP1 + 1024 + 128 * h, NP1, tid);
        const int tl = tid >> 2, part = tid & 3; float cs[16], sn[16]; rot_cs(((const int*)p.in[2])[t0 + tl], part, cs, sn); const float lg = log1pf(-exp2f(-5.0f - (float)h)); inter_scale = __expf(lg);
        float a1[16], a2[16];
        ret_rot16(proj + (size_t)(t0 + tl) * NP1 + 128 * h, cs, sn, part, a1, a2); const float fq_ = 0.08838834764831845f * __expf((float)tl * lg);
#pragma unroll
        for (int i = 0; i < 16; ++i) { a1[i] *= fq_; a2[i] *= fq_; }
        *(LAS v4u*)(Qs + tl * L::LQ + 16 * part) = pack8(a1); *(LAS v4u*)(Qs + tl * L::LQ + 16 * part + 8) = pack8(a1 + 8);
        *(LAS v4u*)(Qs + tl * L::LQ + 64 + 16 * part) = pack8(a2); *(LAS v4u*)(Qs + tl * L::LQ + 64 + 16 * part + 8) = pack8(a2 + 8);
        ret_rot16(proj + (size_t)(t0 + tl) * NP1 + 512 + 128 * h, cs, sn, part, a1, a2); const float fk_ = __expf(-(float)tl * lg);
#pragma unroll
        for (int i = 0; i < 16; ++i) { a1[i] *= fk_; a2[i] *= fk_; }
        *(LAS v4u*)(Ks + tl * L::LQ + 16 * part) = pack8(a1); *(LAS v4u*)(Ks + tl * L::LQ + 16 * part + 8) = pack8(a1 + 8);
        *(LAS v4u*)(Ks + tl * L::LQ + 64 + 16 * part) = pack8(a2); *(LAS v4u*)(Ks + tl * L::LQ + 64 + 16 * part + 8) = pack8(a2 + 8);
    }
    bf16x8 sf[4][2];
    if (!RET) {
#pragma unroll
        for (int vi = 0; vi < 4; ++vi)
#pragma unroll
            for (int ks = 0; ks < 2; ++ks) sf[vi][ks] = *(const bf16x8*)(state + (size_t)(16 * (4 * (wave >> 2) + vi) + (lane & 15)) * 64 + 8 * (lane >> 4) + 32 * ks);
    }
    __syncthreads();
    const int q = lane >> 4; constexpr int RT = L::C / 16;
    if (!RET) { const int rt = wave & 3;
#pragma unroll
        for (int cc = 0; cc < 2; ++cc) { const int ct = 2 * (wave >> 2) + cc; f32x4 acc = {0.f, 0.f, 0.f, 0.f};
            if (ct <= rt) acc = mma_ll(Qs + 16 * rt * L::LQ, L::LQ, Ks + 16 * ct * L::LQ, L::LQ, L::DK, acc, lane);
#pragma unroll
            for (int j = 0; j < 4; ++j) { const int it_ = 16 * rt + 4 * q + j, jt = 16 * ct + (lane & 15); Sc[it_ * L::LT + jt] = (bf16)f2bf(jt <= it_ ? acc[j] : 0.f); } }
    } else { const int rt = wave;
        for (int ct = 0; ct < RT; ++ct) { f32x4 acc = {0.f, 0.f, 0.f, 0.f};
            if (ct <= rt) acc = mma_ll(Qs + 16 * rt * L::LQ, L::LQ, Ks + 16 * ct * L::LQ, L::LQ, L::DK, acc, lane);
#pragma unroll
            for (int j = 0; j < 4; ++j) { const int it_ = 16 * rt + 4 * q + j, jt = 16 * ct + (lane & 15); Sc[it_ * L::LT + jt] = (bf16)f2bf(jt <= it_ ? acc[j] : 0.f); } }
    }
    __syncthreads();
    f32x4 oacc[RET ? 8 : 4];
    { const int rt = RET ? wave : (wave & 3), vt0 = RET ? 0 : 4 * (wave >> 2); constexpr int NV = RET ? 8 : 4;
#pragma unroll
      for (int vi = 0; vi < NV; ++vi) { const int vt = vt0 + vi; f32x4 a1 = {0.f, 0.f, 0.f, 0.f}, a2 = {0.f, 0.f, 0.f, 0.f};
          a1 = mma_ll(Sc + 16 * rt * L::LT, L::LT, Vt + 16 * vt * L::LT, L::LT, L::C, a1, lane);
          if (RET) a2 = mma_lg(Qs + 16 * rt * L::LQ, L::LQ, state + (size_t)16 * vt * L::DK, L::DK, L::DK, a2, lane);
          else { const LAS bf16* xp = Qs + (16 * rt + (lane & 15)) * L::LQ + 8 * (lane >> 4);
              a2 = __builtin_amdgcn_mfma_f32_16x16x32_bf16(*(const LAS bf16x8*)xp, sf[vi & 3][0], a2, 0, 0, 0); a2 = __builtin_amdgcn_mfma_f32_16x16x32_bf16(*(const LAS bf16x8*)(xp + 32), sf[vi & 3][1], a2, 0, 0, 0); }
          oacc[vi] = a1 + a2 * inter_scale; }
      if (RET) __syncthreads();
#pragma unroll
      for (int vi = 0; vi < NV; ++vi) { const int vt = vt0 + vi;
#pragma unroll
          for (int j = 0; j < 4; ++j) Of[(16 * rt + 4 * q + j) * 133 + 16 * vt + (lane & 15)] = oacc[vi][j]; } }
    __syncthreads();
    { const int tl = tid / L::TPT, v0 = (tid % L::TPT) * L::VPT; float s = 0.f, s2 = 0.f;
#pragma unroll
      for (int i = 0; i < L::VPT; ++i) { const float o = Of[tl * 133 + v0 + i]; s += o; s2 += o * o; }
#pragma unroll
      for (int m = 1; m < L::TPT; m <<= 1) { s += __shfl_xor(s, m); s2 += __shfl_xor(s2, m); }
      float mean = 0.f, var = s2 * (1.0f / 128.0f);
      if (RET) { mean = s * (1.0f / 128.0f); var = fmaxf(var - mean * mean, 0.f); }
      const float rstd = __builtin_amdgcn_rsqf(var + 1e-5f);
      const bf16* gsrc = RET ? proj + (size_t)(t0 + tl) * NP1 + 1536 + 128 * h + v0 : proj + (size_t)(t0 + tl) * NP0 + 2048 + 128 * h + v0;
      const float* gn = (RET ? p.in[16] : p.in[13]) + 128 * h + v0;
      bf16* dst = RET ? proj + (size_t)(t0 + tl) * NP1 + 128 * h + v0 : (bf16*)(p.ws + WS_Y) + (size_t)(t0 + tl) * 1024 + 512 + 128 * h + v0;
#pragma unroll
      for (int s8 = 0; s8 < L::VPT / 8; ++s8) { float gv[8], o[8]; unpack8(graw[s8], gv); const float gg[8] = {gnr[2 * s8][0], gnr[2 * s8][1], gnr[2 * s8][2], gnr[2 * s8][3], gnr[2 * s8 + 1][0], gnr[2 * s8 + 1][1], gnr[2 * s8 + 1][2], gnr[2 * s8 + 1][3]};
#pragma unroll
          for (int i = 0; i < 8; ++i) { const float x = (Of[tl * 133 + v0 + 8 * s8 + i] - mean) * rstd * gg[i]; o[i] = x * (gv[i] * sigmf(gv[i])); }
          *(v4u*)(dst + 8 * s8) = pack8(o); } }
    __syncthreads();
}

__device__ __forceinline__ void rwkv_prep(PRef p, int gtid, int NGT) {
    const bf16* proj = (const bf16*)(p.ws + WS_PROJ); bf16* alr = (bf16*)(p.ws + WS_ALR); const float* mu = p.in[17];
    for (int it = gtid; it < T * 32; it += NGT) { const int row = it >> 5, c8 = (it & 31) * 8, col = 1536 + c8; float cur[8], prv[8], o[8];
        ld8(proj + (size_t)row * NP1 + 2048 + col, cur);
        if ((row & 2047) != 0) ld8(proj + (size_t)(row - 1) * NP1 + 2048 + col, prv); else {
#pragma unroll
            for (int i = 0; i < 8; ++i) prv[i] = 0.f; }
        float mv[8]; ldf8(mu + col, mv);
#pragma unroll
        for (int i = 0; i < 8; ++i) { const float d = cur[i] + mv[i] * (prv[i] - cur[i]); o[i] = c8 < 64 ? tanh_fast(d) : (c8 < 128 ? d : sigmf(d)); }
        *(v4u*)(alr + (size_t)row * 256 + c8) = pack8(o); }
}
__device__ __forceinline__ float row_sum16(float x) {
    x += __int_as_float(__builtin_amdgcn_update_dpp(0, __float_as_int(x), 0x128, 0xf, 0xf, false));
    x += __int_as_float(__builtin_amdgcn_update_dpp(0, __float_as_int(x), 0x124, 0xf, 0xf, false));
    x += __int_as_float(__builtin_amdgcn_update_dpp(0, __float_as_int(x), 0x122, 0xf, 0xf, false));
    x += __int_as_float(__builtin_amdgcn_update_dpp(0, __float_as_int(x), 0x121, 0xf, 0xf, false));
    return x;
}
constexpr int SC_STR = 344, SC_STEPS = 32;
__device__ __forceinline__ void rwkv_stage(PRef p, LAS float* buf, int b, int h, int part, int ch, int pt,
                                           const float* mur, const float* muk, const float* muv, const float* kkp, const float* kap, const float* rkp, const float* w0p, const float* a0p) {
    const bf16* proj = (const bf16*)(p.ws + WS_PROJ); const bf16* wag = (const bf16*)(p.ws + WS_Y);
    const int tl = pt >> 3, kc = pt & 7, t = SC_STEPS * ch + tl, row = b * SEQ + t, c0 = 64 * h + 8 * kc;
    float r[8], k[8], v[8], pr[8], pk[8], pv[8], e[8], a[8];
    ld8(proj + (size_t)row * NP1 + 2048 + c0, r); ld8(proj + (size_t)row * NP1 + 2560 + c0, k); ld8(proj + (size_t)row * NP1 + 3072 + c0, v);
    if (t > 0) { ld8(proj + (size_t)(row - 1) * NP1 + 2048 + c0, pr); ld8(proj + (size_t)(row - 1) * NP1 + 2560 + c0, pk); ld8(proj + (size_t)(row - 1) * NP1 + 3072 + c0, pv); }
    else {
#pragma unroll
        for (int i = 0; i < 8; ++i) { pr[i] = 0.f; pk[i] = 0.f; pv[i] = 0.f; } }
    ld8(wag + (size_t)row * 1536 + c0, e); ld8(wag + (size_t)row * 1536 + 512 + c0, a);
    float kkr[8], ss = 0.f;
#pragma unroll
    for (int i = 0; i < 8; ++i) { r[i] += mur[i] * (pr[i] - r[i]); k[i] += muk[i] * (pk[i] - k[i]); v[i] += muv[i] * (pv[i] - v[i]); kkr[i] = k[i] * kkp[i]; ss += kkr[i] * kkr[i]; }
    ss += __shfl_xor(ss, 1); ss += __shfl_xor(ss, 2); ss += __shfl_xor(ss, 4);
    const float rn = __builtin_amdgcn_rsqf(ss + 1e-12f);
    LAS float* base = buf + tl * SC_STR; float br = 0.f, kr = 0.f, rkr = 0.f;
    f32x4 o0[2], o1[2], o2[2], o3[2], o4[2];
#pragma unroll
    for (int i = 0; i < 8; ++i) { const float kk = kkr[i] * rn, w = __expf(-e[i]), km = k[i] * (1.0f + (a[i] - 1.0f) * kap[i]), bb = kk * a[i];
        o0[i >> 2][i & 3] = -kk; o1[i >> 2][i & 3] = w * r[i]; o2[i >> 2][i & 3] = w; o3[i >> 2][i & 3] = bb; o4[i >> 2][i & 3] = km;
        br += bb * r[i]; kr += km * r[i]; rkr += r[i] * km * rkp[i]; }
#pragma unroll
    for (int s = 0; s < 2; ++s) { *(LAS f32x4*)(base + 16 * kc + 8 * s) = (f32x4){o0[s][0], o1[s][0], o0[s][1], o1[s][1]}; *(LAS f32x4*)(base + 16 * kc + 8 * s + 4) = (f32x4){o0[s][2], o1[s][2], o0[s][3], o1[s][3]}; *(LAS f32x4*)(base + 128 + 8 * kc + 4 * s) = o2[s];
        *(LAS f32x4*)(base + 192 + 8 * kc + 4 * s) = o3[s]; *(LAS f32x4*)(base + 256 + 8 * kc + 4 * s) = o4[s]; }
    if ((kc >> 1) == part) {
#pragma unroll
        for (int i = 0; i < 8; ++i) base[320 + (kc & 1) * 8 + i] = v[i]; }
#pragma unroll
    for (int m = 1; m < 8; m <<= 1) { br += __shfl_xor(br, m); kr += __shfl_xor(kr, m); rkr += __shfl_xor(rkr, m); }
    if (kc == 0) { base[336] = br; base[337] = kr; if (part == 0) ((float*)(p.ws + WS_RKR))[(size_t)(b * 8 + h) * SEQ + t] = rkr; }
}
__device__ __forceinline__ void rwkv_scan_item(PRef p, LAS unsigned char* lds, int item, int tid, int wave, int lane, bool do_cvt) {
    const int part = item & 3, h = (item >> 2) & 7, b = item >> 5;
    LAS float* buf = (LAS float*)lds; LAS float* ybuf = (LAS float*)(lds + 2 * SC_STEPS * SC_STR * 4);
    bf16* yraw = (bf16*)(p.ws + WS_HB) + (size_t)T * 512;
    constexpr int NCHK = SEQ / SC_STEPS;
    if (wave >= 4) {
        const int pt = tid - 256, kc = pt & 7, c0 = 64 * h + 8 * kc; float mur[8], muk[8], muv[8], kkp[8], kap[8], rkp[8], w0p[8], a0p[8];
#pragma unroll
        for (int i = 0; i < 8; ++i) { mur[i] = p.in[17][c0 + i]; muk[i] = p.in[17][512 + c0 + i]; muv[i] = p.in[17][1024 + c0 + i]; kkp[i] = p.in[23][c0 + i]; kap[i] = p.in[24][c0 + i]; rkp[i] = p.in[25][c0 + i]; w0p[i] = p.in[18][c0 + i]; a0p[i] = p.in[20][c0 + i]; }
        rwkv_stage(p, buf, b, h, part, 0, pt, mur, muk, muv, kkp, kap, rkp, w0p, a0p);
        LAS float* scr = (LAS float*)(lds + 2 * SC_STEPS * SC_STR * 4 + 8192 + (wave - 4) * 8704);
        f32x4 creg[8];
#pragma unroll
        for (int i = 0; i < 8; ++i) creg[i] = (f32x4){0.f, 0.f, 0.f, 0.f};
        for (int ch = 0; ch < NCHK; ++ch) { __syncthreads(); if (ch + 1 < NCHK) rwkv_stage(p, buf + ((ch + 1) & 1) * SC_STEPS * SC_STR, b, h, part, ch + 1, pt, mur, muk, muv, kkp, kap, rkp, w0p, a0p);
#ifndef NO_SCAN_CVT
            if (do_cvt) { const int idx = (int)blockIdx.x * 4 + (wave - 4) + (ch >> 3) * ((int)gridDim.x * 4);
                if ((ch & 7) == 0) { if (idx < CVT1_ITEMS) cvt1_load(p, idx, lane, creg); } else if ((ch & 7) == 1) { if (idx < CVT1_ITEMS) cvt1_store(p, idx, scr, lane, creg); } }
#endif
        }
    } else {
        const int vl = lane >> 4, kg = lane & 15; f32x4 S = {0.f, 0.f, 0.f, 0.f}; LAS float* yb = ybuf + wave * 512;
        bf16* yp = yraw + (size_t)(item * SEQ) * 16;
        for (int ch = 0; ch < NCHK; ++ch) { __syncthreads(); const LAS float* cb = buf + (ch & 1) * SC_STEPS * SC_STR;
            typedef float f32x2 __attribute__((ext_vector_type(2)));
            const LAS float* b0 = cb;
            f32x4 c_nw0 = *(const LAS f32x4*)(b0 + 8 * kg), c_nw1 = *(const LAS f32x4*)(b0 + 8 * kg + 4), c_w = *(const LAS f32x4*)(b0 + 128 + 4 * kg),
                  c_bb = *(const LAS f32x4*)(b0 + 192 + 4 * kg), c_kk = *(const LAS f32x4*)(b0 + 256 + 4 * kg);
            float c_vv = b0[320 + 4 * wave + vl], c_br = b0[336], c_kr = b0[337];
#pragma unroll
            for (int s = 0; s < SC_STEPS; ++s) { const LAS float* base = cb + (s + 1 < SC_STEPS ? s + 1 : s) * SC_STR;
                const f32x4 n_nw0 = *(const LAS f32x4*)(base + 8 * kg), n_nw1 = *(const LAS f32x4*)(base + 8 * kg + 4), n_w = *(const LAS f32x4*)(base + 128 + 4 * kg),
                            n_bb = *(const LAS f32x4*)(base + 192 + 4 * kg), n_kk = *(const LAS f32x4*)(base + 256 + 4 * kg);
                const float n_vv = base[320 + 4 * wave + vl], n_br = base[336], n_kr = base[337];
                const f32x4 tS = S * c_w + c_kk * c_vv;
                f32x2 dd = (f32x2){S[0], S[0]} * (f32x2){c_nw0[0], c_nw0[1]};
                dd = (f32x2){S[1], S[1]} * (f32x2){c_nw0[2], c_nw0[3]} + dd;
                dd = (f32x2){S[2], S[2]} * (f32x2){c_nw1[0], c_nw1[1]} + dd;
                dd = (f32x2){S[3], S[3]} * (f32x2){c_nw1[2], c_nw1[3]} + dd;
                const float d1 = row_sum16(dd.x);
                S = tS + c_bb * d1;
                float d2 = dd.y;
                d2 += __int_as_float(__builtin_amdgcn_update_dpp(0, __float_as_int(d2), 0x128, 0xf, 0xf, false));
                d2 += __int_as_float(__builtin_amdgcn_update_dpp(0, __float_as_int(d2), 0x124, 0xf, 0xf, false));
                yb[(s * 4 + vl) * 4 + (kg & 3)] = d2 + 0.25f * (d1 * c_br + c_vv * c_kr);
                c_nw0 = n_nw0; c_nw1 = n_nw1; c_w = n_w; c_bb = n_bb; c_kk = n_kk; c_vv = n_vv; c_br = n_br; c_kr = n_kr; }
            { const int s = lane >> 1, pr = lane & 1; const f32x4 q0 = *(const LAS f32x4*)(yb + (s * 4 + 2 * pr) * 4), q1 = *(const LAS f32x4*)(yb + (s * 4 + 2 * pr + 1) * 4); const float y0 = (q0[0] + q0[1]) + (q0[2] + q0[3]), y1 = (q1[0] + q1[1]) + (q1[2] + q1[3]);
              *(unsigned*)(yp + (size_t)(SC_STEPS * ch + s) * 16 + 4 * wave + 2 * pr) = pk2(y0, y1); } }
    }
    __syncthreads();
}
__device__ __forceinline__ void rwkv_post(PRef p, int gtid, int NGT) {
    bf16* proj = (bf16*)(p.ws + WS_PROJ); const bf16* wag = (const bf16*)(p.ws + WS_Y); const bf16* yraw = (const bf16*)(p.ws + WS_HB) + (size_t)T * 512; const float* rkr = (const float*)(p.ws + WS_RKR);
    for (int it = gtid; it < T * 64; it += NGT) { const int row = it >> 6, h = (it >> 3) & 7, c0 = 64 * h + 8 * (it & 7); float y[8], v[8], pv[8], g[8], o[8];
        { const int b_ = row >> 11, t_ = row & 2047, j_ = it & 7; ld8(yraw + ((size_t)(((b_ * 8 + h) * 4 + (j_ >> 1)) * SEQ + t_)) * 16 + (j_ & 1) * 8, y); } float s = 0.f;
#pragma unroll
        for (int i = 0; i < 8; ++i) s += y[i];
        s += __shfl_xor(s, 1); s += __shfl_xor(s, 2); s += __shfl_xor(s, 4); const float mean = s * (1.0f / 64.0f); float s2 = 0.f;
#pragma unroll
        for (int i = 0; i < 8; ++i) { y[i] -= mean; s2 += y[i] * y[i]; }
        s2 += __shfl_xor(s2, 1); s2 += __shfl_xor(s2, 2); s2 += __shfl_xor(s2, 4); const float rstd = __builtin_amdgcn_rsqf(s2 * (1.0f / 64.0f) + 64e-5f);
        ld8(proj + (size_t)row * NP1 + 3072 + c0, v);
        if ((row & 2047) != 0) ld8(proj + (size_t)(row - 1) * NP1 + 3072 + c0, pv); else {
#pragma unroll
            for (int i = 0; i < 8; ++i) pv[i] = 0.f; }
        ld8(wag + (size_t)row * 1536 + 1024 + c0, g); const float rk = rkr[(size_t)((row >> 11) * 8 + h) * SEQ + (row & 2047)];
        float mv[8], ng[8]; ldf8(p.in[17] + 1024 + c0, mv); ldf8(p.in[26] + c0, ng);
#pragma unroll
        for (int i = 0; i < 8; ++i) { const float vs = v[i] + mv[i] * (pv[i] - v[i]); o[i] = (y[i] * rstd * ng[i] + rk * vs) * g[i]; }
#ifdef SANITIZE
#pragma unroll
        for (int i = 0; i < 8; ++i) if (!(fabsf(o[i]) < 1e30f)) o[i] = 0.f;
#endif
        *(v4u*)(proj + (size_t)row * NP1 + 512 + c0) = pack8(o); }
}
__device__ __forceinline__ void final_norm(PRef p, int gw, int NGW, int lane) {
    const float* part = pg8::rpart(p.ws, 6); const float* g = p.in[37]; const bf16* hf = (const bf16*)(p.ws + 107 * MiB);
    f32x4 gv[4];
#pragma unroll
    for (int j = 0; j < 4; ++j) gv[j] = *((const f32x4*)g + lane + 64 * j);
    int m = gw; if (m >= T) return;
    v2u cur[4]; float rs = pg8::rs16(part, m);
#pragma unroll
    for (int j = 0; j < 4; ++j) cur[j] = *((const v2u*)(hf + (size_t)m * 1024) + lane + 64 * j);
    for (;;) { const int nx = m + NGW; const bool more = nx < T; v2u nxt[4]; float nrs = rs;
#pragma unroll
        for (int j = 0; j < 4; ++j) nxt[j] = cur[j];
        if (more) { nrs = pg8::rs16(part, nx);
#pragma unroll
            for (int j = 0; j < 4; ++j) nxt[j] = *((const v2u*)(hf + (size_t)nx * 1024) + lane + 64 * j); }
        f32x4* xr = (f32x4*)(p.out + (size_t)m * 1024) + lane;
#pragma unroll
        for (int j = 0; j < 4; ++j) { const v2u hw = cur[j]; f32x4 v = {__uint_as_float(hw.x << 16), __uint_as_float(hw.x & 0xffff0000u), __uint_as_float(hw.y << 16), __uint_as_float(hw.y & 0xffff0000u)}; v = v * rs * gv[j]; xr[64 * j] = v; }
        if (!more) break; m = nx; rs = nrs;
#pragma unroll
        for (int j = 0; j < 4; ++j) cur[j] = nxt[j]; }
}

#define TID (fresh_tid())
#define LANE (TID & 63)
#define WAVE (__builtin_amdgcn_readfirstlane(TID >> 6))
#define GRD (fresh_s((int)gridDim.x))
#define BID (fresh_s((int)blockIdx.x))
#define GW (BID * NWAVES + WAVE)
#define NGW_ (GRD * NWAVES)
#define GTID (BID * NTHREADS + TID)
#define NGT_ (GRD * NTHREADS)
#define GSYNC_CG() cg::this_grid().sync()
#define GSYNC() do { XcdBarrier xb_; xb_.bar = (unsigned*)(FP.ws + WS_XBAR); xb_.x = xb_xcc_id(); xb_.st = (volatile LAS unsigned*)(lds + LDS_XST); xcd_barrier(xb_); } while (0)
#define WSP(off) (FP.ws + (off))
#define ROWSS(i) ((float*)WSP(WS_ROWSS) + (size_t)(i) * T)

template <int li> __device__ __forceinline__ void layer_body(LAS unsigned char* lds) {
        { const int N = li == 0 ? NP0 : NP1; pg8::Gemm g{li == 0 ? (const bf16*)WSP(WS_HB) : (const bf16*)FP.out + (size_t)T * 1024, (const bf16*)WSP(W_IN), T, N, 1024, 1024}; pg8::StaticOrder S; S.init(T, N, GRD, BID);
          pg8::EpiScaleBf16 E{0, li};
          pg8::gemm_phase<pg8::EpiScaleBf16, pg8::StaticOrder, true, true>(lds, g, S, E);
#ifdef PROBE_INPROJ2
          pg8::gemm_phase<pg8::EpiScaleBf16, pg8::StaticOrder, true, true>(lds, g, S, E);
#endif
        }
        GSYNC();
#ifndef NO_MIX
        if (li == 0) {
#ifdef NO_MIX0
            { PRef p = FP; tr_job(p.in[15], NP1, 1024, p.in[28] + 1024, (bf16*)(p.ws + W_IN), NP1, 0, lds, GW, NGW_, WAVE, LANE); }
            GSYNC();
#else
            for (int it = BID; it < 256; it += GRD) lru_local_item(FP, lds, it, TID, WAVE, LANE);
#ifdef PROBE_LRU2
            for (int it = BID; it < 256; it += GRD) lru_local_item(FP, lds, it, TID, WAVE, LANE);
#endif
#ifdef PROBE_GLA2
            for (int it = BID; it < 1024; it += GRD) la_local_item<false>(FP, lds, it, TID, WAVE, LANE);
#endif
            for (int it = BID; it < 1024; it += GRD) la_local_item<false>(FP, lds, it, TID, WAVE, LANE);
            { PRef p = FP; tr_job(p.in[15], NP1, 1024, p.in[28] + 1024, (bf16*)(p.ws + W_IN), NP1, 0, lds, GW, NGW_, WAVE, LANE); }
            GSYNC();
            lru_prefix(FP, GTID, NGT_); la_prefix<false>(FP, GTID, NGT_);
            GSYNC();
            for (int it = BID; it < 1024; it += GRD) la_out_item<false>(FP, lds, it, TID, WAVE, LANE);
#ifdef PROBE_GLAOUT2
            for (int it = BID; it < 1024; it += GRD) la_out_item<false>(FP, lds, it, TID, WAVE, LANE);
#endif
#ifdef PROBE_LRUOUT2
            lru_out(FP, GTID, NGT_);
#endif
            lru_out(FP, GTID, NGT_);
            GSYNC();
#endif
        } else {
#ifdef NO_MIX1
            cvt_layer_weights(FP, 1, lds, GW, NGW_, WAVE, LANE);
            cvt_p(FP, 1, GW, NGW_, LANE);
            GSYNC();
#else
#ifndef NO_RET
            for (int it = BID; it < 512; it += GRD) la_local_item<true>(FP, lds, it, TID, WAVE, LANE);
#endif
#ifdef PROBE_RETLOC2
            for (int it = BID; it < 512; it += GRD) la_local_item<true>(FP, lds, it, TID, WAVE, LANE);
#endif
#ifdef PROBE_CVT2
            cvt_layer_weights(FP, 1, lds, GW, NGW_, WAVE, LANE);
#endif
#ifndef NO_RWKV
            rwkv_prep(FP, GTID, NGT_);
#endif
#ifdef NO_SCAN_CVT
            cvt_layer_weights(FP, 1, lds, GW, NGW_, WAVE, LANE);
            cvt_p(FP, 1, GW, NGW_, LANE);
#endif
            GSYNC();
#ifndef NO_RET
            la_prefix<true>(FP, GTID, NGT_);
#endif
#ifndef NO_RWKV
            { PRef p = FP; pg8::Gemm g{(const bf16*)(p.ws + WS_ALR), (const bf16*)(p.ws + W_LR), T, 1536, 256, 256}; pg8::StaticOrder S; S.init(T, 1536, GRD, BID);
              pg8::EpiLowRank E{0};
              pg8::gemm_phase<pg8::EpiLowRank, pg8::StaticOrder, true, true>(lds, g, S, E); }
#endif
            GSYNC();
#ifndef NO_RET
            for (int it = BID; it < 512; it += GRD) la_out_item<true>(FP, lds, it, TID, WAVE, LANE);
#endif
#if !defined(NO_RWKV) && !defined(NO_SCAN)
            for (int it = BID; it < 256; it += GRD) rwkv_scan_item(FP, lds, it, TID, WAVE, LANE, it < GRD);
#endif
#ifndef NO_SCAN_CVT
            { const int first = 8 * GRD * 4; for (int idx = first + GW; idx < CVT1_ITEMS; idx += NGW_) cvt1_flat(FP, idx, (LAS float*)(lds + WAVE * 8704), LANE); }
#endif
#ifdef PROBE_SCAN2
            for (int it = BID; it < 256; it += GRD) rwkv_scan_item(FP, lds, it, TID, WAVE, LANE, it < GRD);
#endif
            GSYNC();
#ifndef NO_RWKV
            rwkv_post(FP, GTID, NGT_);
#endif
            GSYNC();
#endif
        }
#endif
        { PRef p = FP;
#if defined(NO_MIX) || defined(NO_MIX0)
          pg8::Gemm g{(const bf16*)(p.ws + WS_PROJ), (const bf16*)(p.ws + W_OUT), T, 1024, 1024, li == 0 ? NP0 : NP1};
#elif defined(NO_MIX1)
          pg8::Gemm g{li == 0 ? (const bf16*)(p.ws + WS_Y) : (const bf16*)(p.ws + WS_PROJ) + 2048, (const bf16*)(p.ws + W_OUT), T, 1024, 1024, li == 0 ? 1024 : NP1};
#else
          pg8::Gemm g{li == 0 ? (const bf16*)(p.ws + WS_Y) : (const bf16*)(p.ws + WS_PROJ), (const bf16*)(p.ws + W_OUT), T, 1024, 1024, li == 0 ? 1024 : NP1};
#endif

          pg8::StaticOrder S; S.init(T, 1024, GRD, BID);
          pg8::EpiResid E{0, li};
          pg8::gemm_phase<pg8::EpiResid, pg8::StaticOrder, true, true>(lds, g, S, E); }
        GSYNC();
        { pg8::Gemm g{(const bf16*)FP.out + (size_t)li * T * 1024, (const bf16*)WSP(W_GU), T, 2 * FF, 1024, 1024}; pg8::StaticOrder S; S.init(T, 2 * FF, GRD, BID);
          pg8::EpiSwiGLU E{li};
          pg8::gemm_phase<pg8::EpiSwiGLU, pg8::StaticOrder, true, true>(lds, g, S, E);
#ifdef PROBE_GU2
          pg8::gemm_phase<pg8::EpiSwiGLU, pg8::StaticOrder, true, true>(lds, g, S, E);
#endif
          { const int G_ = GRD, b_ = BID, half = G_ / 2; pg8::Gemm g2{(const bf16*)WSP(WS_PB), (const bf16*)WSP(W_PP), T, 1024, 256, 256}; pg8::StaticOrder S2;
            if (G_ == 256) S2.init(T, 1024, half, b_ >= half ? b_ - half : (1 << 28)); else S2.init(T, 1024, G_, b_);
            pg8::EpiScaleBf16 E2{1, li};
            pg8::gemm_phase<pg8::EpiScaleBf16, pg8::StaticOrder, true, true>(lds, g2, S2, E2); }
        }
        GSYNC();
        { PRef p = FP; pg8::Gemm g{(const bf16*)(p.ws + WS_PROJ), (const bf16*)(p.ws + W_DN), T, 1024, FF, FF}; pg8::StaticOrder S; S.init(T, 1024, GRD, BID);
          pg8::EpiResid E{1, li};
          pg8::gemm_phase<pg8::EpiResid, pg8::StaticOrder, true, true>(lds, g, S, E); }
        GSYNC();
        { PRef p = FP; pg8::Gemm g{(const bf16*)p.out + (size_t)li * T * 1024, (const bf16*)(p.ws + W_PG), T, 1024, 1024, 1024}; pg8::StaticOrder S; S.init(T, 1024, GRD, BID);
          pg8::EpiPLE E{li};
          pg8::gemm_phase<pg8::EpiPLE, pg8::StaticOrder, true, true>(lds, g, S, E);
#ifdef PROBE_PLE2
          pg8::gemm_phase<pg8::EpiPLE, pg8::StaticOrder, true, true>(lds, g, S, E);
#endif
        }
        GSYNC();
    }

__global__ void __launch_bounds__(NTHREADS, 2) trunk_fwd(Params p_unused) {
    extern __shared__ __attribute__((aligned(16))) unsigned char lds_raw[];
    LAS unsigned char* lds = (LAS unsigned char*)lds_raw;
    if (threadIdx.x < 16) ((volatile LAS unsigned*)(lds + LDS_XST))[threadIdx.x] = 0u;
    __syncthreads();
    (void)xcd_barrier_post((unsigned*)(FP.ws + WS_XBAR), (volatile LAS unsigned*)(lds + LDS_XST));
#ifndef NO_PRO
    phase_prologue(FP, lds, GW, NGW_, WAVE, LANE);
#endif
    GSYNC_CG();
#ifdef PROBE_SYNC10
    for (int i_ = 0; i_ < 10; ++i_) GSYNC();
#endif
#ifdef PROBE_PRO2
    phase_prologue(FP, lds, GW, NGW_, WAVE, LANE);
    GSYNC();
#endif
    layer_body<0>(lds);
    layer_body<1>(lds);
    final_norm(FP, GW, NGW_, LANE);
}

extern "C" void kernel_launch(void* const* d_in, const int* in_sizes, int n_in, void* d_out, int out_size, void* d_ws, size_t ws_size, hipStream_t stream) {
    static int grid = 0;
    if (grid == 0) {
        if (n_in != 38 || ws_size < WS_END) { fprintf(stderr, "kernel_launch: unexpected n_in %d / ws %zu\n", n_in, ws_size); grid = -1; return; }
        int dev = 0, cus = 0, per_cu = 0;
        hipGetDevice(&dev); hipDeviceGetAttribute(&cus, hipDeviceAttributeMultiprocessorCount, dev);
        hipFuncSetAttribute((const void*)trunk_fwd, hipFuncAttributeMaxDynamicSharedMemorySize, LDS_BYTES);
        hipOccupancyMaxActiveBlocksPerMultiprocessor(&per_cu, (const void*)trunk_fwd, NTHREADS, LDS_BYTES);
        (void)hipGetLastError();
        if (per_cu < 1) { fprintf(stderr, "kernel_launch: occupancy query reports %d blocks per CU\n", per_cu); per_cu = 1; }
        grid = cus;
    }
    if (grid < 0) return;
    hipMemsetAsync((char*)d_ws + WS_CTL, 0, CTL_ZERO_BYTES, stream);
    Params prm{};
    for (int i = 0; i < 38; ++i) prm.in[i] = (const float*)d_in[i];
    prm.out = (float*)d_out; prm.ws = (unsigned char*)d_ws;
    void* args[] = {&prm};
    hipError_t e = hipLaunchCooperativeKernel((const void*)trunk_fwd, dim3(grid), dim3(NTHREADS), args, LDS_BYTES, stream);
    if (e != hipSuccess) fprintf(stderr, "cooperative launch failed: %s (grid %d)\n", hipGetErrorString(e), grid);
}
```

```cpp
#include <hip/hip_runtime.h>
#include <hip/hip_cooperative_groups.h>
#include <cstdio>
#include <cstdint>
namespace cg = cooperative_groups;
namespace pg8 {
#define PG8_LAS __attribute__((address_space(3)))
typedef unsigned short bf16_t;
typedef short bf16x8 __attribute__((ext_vector_type(8)));
typedef float f32x4 __attribute__((ext_vector_type(4)));
typedef unsigned u32x4 __attribute__((ext_vector_type(4)));
constexpr int BM = 256, BK = 64, HALF = 128, HTB = HALF * BK * 2  , STAGE_BYTES = 8 * HTB, NXCD = 8, WGM = 8;

__host__ __device__ __forceinline__ int lds_byte(int r, int c) { const int st = (r >> 4) * 2 + (c >> 5), rr = r & 15, cc = c & 31, ob = rr * 64 + cc * 2; return st * 1024 + (ob ^ (((ob >> 9) & 1) << 5)); }
__host__ __device__ __forceinline__ void stage_rc(int b, int& R, int& C) { const int st = b / 1024, sb = b % 1024, swz = sb ^ (((sb >> 9) & 1) << 5); R = (st >> 1) * 16 + swz / 64; C = (st & 1) * 32 + (swz % 64) / 2; }
__host__ __device__ __forceinline__ int perm32(int rho) { const int n = rho >> 4, i = rho & 15; return 8 * (i >> 2) + 4 * n + (i & 3); }

struct Unit { int pm, pn; };
struct Gemm { const bf16_t* A; const bf16_t* Bt; int M, N, K, lda; };

struct StaticOrder {
    int nM, nN, nwg, G, c;
    __host__ __device__ void init(int M, int N, int G_, int c_) { nM = M / BM; nN = N / BM; nwg = nM * nN; G = G_; c = c_; }
    __host__ __device__ bool next(int i, Unit& u) const {
        const long L = (long)i * G + c; if (L >= nwg) return false;
        int wgid = (int)L; { const int q = nwg / NXCD, r = nwg % NXCD, xcd = wgid % NXCD, off = wgid / NXCD; wgid = (xcd < r ? xcd * (q + 1) : r * (q + 1) + (xcd - r) * q) + off; }
        const int nig = WGM * nN, gid = wgid / nig, fm = gid * WGM, gsz = (nM - fm) < WGM ? (nM - fm) : WGM;
        u.pm = fm + ((wgid % nig) % gsz); u.pn = (wgid % nig) / gsz; return true;
    }
    __device__ __forceinline__ void a_ready(const Unit&) const {}
    __device__ __forceinline__ void done(const Unit&) const {}
};

typedef float f32x2p_t __attribute__((ext_vector_type(2))); typedef __bf16 bf16x2p_t __attribute__((ext_vector_type(2)));
__device__ __forceinline__ unsigned cvt_pk_bf16(float lo, float hi) { const f32x2p_t v = {lo, hi}; const bf16x2p_t b = __builtin_convertvector(v, bf16x2p_t); return __builtin_bit_cast(unsigned, b); }
typedef float f32x2 __attribute__((ext_vector_type(2)));
__device__ __forceinline__ f32x2 gelu_pk(f32x2 v) {
    const f32x2 av = __builtin_elementwise_abs(v), d = av * 0.2316418882f + 1.0f;
    f32x2 t; t.x = __builtin_amdgcn_rcpf(d.x); t.y = __builtin_amdgcn_rcpf(d.y);
    f32x2 q = t * 0.5307027145f + (-0.7265760135f); q = q * t + 0.7107068705f; q = q * t + (-0.142248368f); q = q * t + 0.127414796f; q = q * t;
    const f32x2 s = (v * v) * (-0.72134752044f);
    f32x2 e; e.x = __builtin_amdgcn_exp2f(s.x); e.y = __builtin_amdgcn_exp2f(s.y);
    const f32x2 m = v * (q * e), r = v - m;
    f32x2 o; o.x = v.x < 0.f ? m.x : r.x; o.y = v.y < 0.f ? m.y : r.y; return o;
}


}
struct Params { const float* in[38]; float* out; unsigned char* ws; };
typedef const __attribute__((address_space(4))) Params& PRef;
__device__ __forceinline__ const __attribute__((address_space(4))) Params* fresh_params() { unsigned long long ki = (unsigned long long)__builtin_amdgcn_kernarg_segment_ptr(); asm volatile("" : "+s"(ki)); return (const __attribute__((address_space(4))) Params*)ki; }
#define FP (*fresh_params())
constexpr size_t EPI_MiB = 1u << 20;
constexpr size_t E_ROWSS = 65536, E_HB = 35 * EPI_MiB, E_PROJ = 67 * EPI_MiB, E_Y = 187 * EPI_MiB, E_HF = 107 * EPI_MiB;
namespace pg8 {

__device__ __forceinline__ float rs_of(const float* rowss, int row) { return rowss ? __builtin_amdgcn_rsqf(rowss[row] * (1.0f / 1024.0f) + 1e-6f) : 1.0f; }
__device__ __forceinline__ float sigm(float x) { return __builtin_amdgcn_rcpf(1.0f + __expf(-x)); }
constexpr size_t E_RPART = 253 * EPI_MiB;
__device__ __forceinline__ float* rpart(unsigned char* ws, int inst) { return (float*)(ws + E_RPART + ((inst & 1) ? 0 : EPI_MiB)); }
__device__ __forceinline__ float rs16(const float* part, int row) { const f32x4* q = (const f32x4*)(part + (size_t)row * 16); const f32x4 a = q[0], b = q[1], c = q[2], d = q[3];
    const float s = (((a[0] + a[1]) + (a[2] + a[3])) + ((b[0] + b[1]) + (b[2] + b[3]))) + (((c[0] + c[1]) + (c[2] + c[3])) + ((d[0] + d[1]) + (d[2] + d[3])));
    return __builtin_amdgcn_rsqf(s * (1.0f / 1024.0f) + 1e-6f); }

struct EpiScaleBf16 {
    static constexpr bool PERM = true, AFTER_DRAIN = false;
    int mode, li;
    __device__ __forceinline__ void operator()(const f32x4 (&acc)[2][2][4][2], const Unit& u, int wr, int wc, int fr, int fq) const {
        unsigned char* ws = FP.ws; bf16_t* O = (bf16_t*)(ws + (mode == 0 ? E_PROJ : E_Y));   const int ldc = mode == 0 ? (li == 0 ? 2816 : 3840) : (mode == 2 ? 1536 : 1024);
        const float* rowss = (mode == 0 && li == 0) ? (const float*)(ws + E_ROWSS) : nullptr; const float* part = rpart(ws, 3); const bool use16 = (mode == 0 && li == 1);
        const int row0 = u.pm * BM + wr * 64 + fr, col0 = u.pn * BM + wc * 32 + 8 * fq;
#pragma unroll
        for (int ai = 0; ai < 2; ++ai)
#pragma unroll
            for (int m = 0; m < 4; ++m) { const int row = row0 + ai * HALF + m * 16; const float rs = use16 ? rs16(part, row) : rs_of(rowss, row); bf16_t* rowp = O + (size_t)row * ldc + col0;
#pragma unroll
                for (int bj = 0; bj < 2; ++bj) { const f32x4 v0 = acc[ai][bj][m][0] * rs, v1 = acc[ai][bj][m][1] * rs;
                    u32x4 w; w.x = cvt_pk_bf16(v0[0], v0[1]); w.y = cvt_pk_bf16(v0[2], v0[3]); w.z = cvt_pk_bf16(v1[0], v1[1]); w.w = cvt_pk_bf16(v1[2], v1[3]);
                    *(u32x4*)(rowp + bj * HALF) = w; } }
    }
};

__device__ __forceinline__ void unpk8(const u32x4 pw, f32x4& p0, f32x4& p1) {
    p0[0] = __uint_as_float(pw.x << 16); p0[1] = __uint_as_float(pw.x & 0xffff0000u); p0[2] = __uint_as_float(pw.y << 16); p0[3] = __uint_as_float(pw.y & 0xffff0000u);
    p1[0] = __uint_as_float(pw.z << 16); p1[1] = __uint_as_float(pw.z & 0xffff0000u); p1[2] = __uint_as_float(pw.w << 16); p1[3] = __uint_as_float(pw.w & 0xffff0000u);
}
struct EpiResid {
    static constexpr bool PERM = true, AFTER_DRAIN = false;
    int which, li;
    __device__ __forceinline__ void operator()(const f32x4 (&acc)[2][2][4][2], const Unit& u, int wr, int wc, int fr, int fq) const {
        PRef p = FP; unsigned char* ws = p.ws; bf16_t* res = (bf16_t*)p.out + (size_t)li * 16384 * 1024; const float* xin = p.in[0]; const bool from_x = (which == 0 && li == 0);
        float* part = rpart(ws, (which == 0 ? 1 : 2) + 3 * li); const int slot = 4 * u.pn + wc;
        const int row0 = u.pm * BM + wr * 64 + fr, col0 = u.pn * BM + wc * 32 + 8 * fq;
#pragma unroll
        for (int ai = 0; ai < 2; ++ai)
#pragma unroll
            for (int m = 0; m < 4; ++m) { const int row = row0 + ai * HALF + m * 16; float ss = 0.f;
#pragma unroll
                for (int bj = 0; bj < 2; ++bj) { const size_t off = (size_t)row * 1024 + col0 + bj * HALF; f32x4 v0, v1;
                    if (from_x) { v0 = *(const f32x4*)(xin + off); v1 = *(const f32x4*)(xin + off + 4); } else unpk8(*(const u32x4*)(res + off), v0, v1);
                    v0 = v0 + acc[ai][bj][m][0]; v1 = v1 + acc[ai][bj][m][1];
                    u32x4 w; w.x = cvt_pk_bf16(v0[0], v0[1]); w.y = cvt_pk_bf16(v0[2], v0[3]); w.z = cvt_pk_bf16(v1[0], v1[1]); w.w = cvt_pk_bf16(v1[2], v1[3]);
                    *(u32x4*)(res + off) = w;
                    ss += (v0[0] * v0[0] + v0[1] * v0[1]) + (v0[2] * v0[2] + v0[3] * v0[3]) + (v1[0] * v1[0] + v1[1] * v1[1]) + (v1[2] * v1[2] + v1[3] * v1[3]); }
                ss += __shfl_xor(ss, 16); ss += __shfl_xor(ss, 32);
                if (fq == 0) part[(size_t)row * 16 + slot] = ss; asm volatile("" ::: "memory"); }
    }
};

struct EpiSwiGLU {
    static constexpr bool PERM = true, AFTER_DRAIN = false;
    int li;
    __device__ __forceinline__ void operator()(const f32x4 (&acc)[2][2][4][2], const Unit& u, int wr, int wc, int fr, int fq) const {
        typedef unsigned u32x2v __attribute__((ext_vector_type(2)));
        unsigned char* ws = FP.ws; bf16_t* O = (bf16_t*)(ws + E_PROJ); const int ldc = 2816; const float* part = rpart(ws, 1 + 3 * li);
        const int row0 = u.pm * BM + wr * 64 + fr, col0 = u.pn * 128 + wc * 16 + 4 * fq;
#pragma unroll
        for (int ai = 0; ai < 2; ++ai)
#pragma unroll
            for (int m = 0; m < 4; ++m) { const int row = row0 + ai * HALF + m * 16; const float rs = rs16(part, row); bf16_t* rowp = O + (size_t)row * ldc + col0;
#pragma unroll
                for (int bj = 0; bj < 2; ++bj) { const f32x4 g = acc[ai][bj][m][0] * rs, up = acc[ai][bj][m][1] * rs; f32x4 o;
#pragma unroll
                    for (int i = 0; i < 4; ++i) o[i] = g[i] * sigm(g[i]) * up[i];
                    u32x2v w; w.x = cvt_pk_bf16(o[0], o[1]); w.y = cvt_pk_bf16(o[2], o[3]);
                    *(u32x2v*)(rowp + bj * 64) = w; } }
    }
};

struct EpiPLE {
    static constexpr bool PERM = true, AFTER_DRAIN = false;
    int li;
    __device__ __forceinline__ void operator()(const f32x4 (&acc)[2][2][4][2], const Unit& u, int wr, int wc, int fr, int fq) const {
        PRef p = FP; unsigned char* ws = p.ws; const bf16_t* rin = (const bf16_t*)p.out + (size_t)li * 16384 * 1024; bf16_t* rout = (bf16_t*)p.out + (size_t)16384 * 1024; bf16_t* hf = (bf16_t*)(ws + E_HF);
        const bf16_t* pp = (const bf16_t*)(ws + E_Y); const float* bias = p.in[35] + li * 1024;
        const float* rs_in = rpart(ws, 2 + 3 * li); float* part = rpart(ws, 3 + 3 * li); const int slot = 4 * u.pn + wc;
        const int row0 = u.pm * BM + wr * 64 + fr, col0 = u.pn * BM + wc * 32 + 8 * fq;
#pragma unroll
        for (int ai = 0; ai < 2; ++ai)
#pragma unroll
            for (int m = 0; m < 4; ++m) { const int row = row0 + ai * HALF + m * 16; const float rs = rs16(rs_in, row); float ss = 0.f;
#pragma unroll
                for (int bj = 0; bj < 2; ++bj) { const size_t off = (size_t)row * 1024 + col0 + bj * HALF;
                    const f32x4 b0 = *(const f32x4*)(bias + col0 + bj * HALF), b1 = *(const f32x4*)(bias + col0 + bj * HALF + 4);
                    f32x4 p0, p1, v0, v1; unpk8(*(const u32x4*)(pp + off), p0, p1); unpk8(*(const u32x4*)(rin + off), v0, v1);
                    const f32x4 g0 = acc[ai][bj][m][0] * rs + b0, g1 = acc[ai][bj][m][1] * rs + b1;
#pragma unroll
                    for (int i = 0; i < 4; ++i) { v0[i] += sigm(g0[i]) * p0[i]; v1[i] += sigm(g1[i]) * p1[i]; }
                    if (li == 0) { u32x4 w; w.x = cvt_pk_bf16(v0[0], v0[1]); w.y = cvt_pk_bf16(v0[2], v0[3]); w.z = cvt_pk_bf16(v1[0], v1[1]); w.w = cvt_pk_bf16(v1[2], v1[3]); *(u32x4*)(rout + off) = w; }
                    else { u32x4 w; w.x = cvt_pk_bf16(v0[0], v0[1]); w.y = cvt_pk_bf16(v0[2], v0[3]); w.z = cvt_pk_bf16(v1[0], v1[1]); w.w = cvt_pk_bf16(v1[2], v1[3]); *(u32x4*)(hf + off) = w; }
                    ss += (v0[0] * v0[0] + v0[1] * v0[1]) + (v0[2] * v0[2] + v0[3] * v0[3]) + (v1[0] * v1[0] + v1[1] * v1[1]) + (v1[2] * v1[2] + v1[3] * v1[3]); }
                ss += __shfl_xor(ss, 16); ss += __shfl_xor(ss, 32);
                if (fq == 0) part[(size_t)row * 16 + slot] = ss; asm volatile("" ::: "memory"); }
    }
};

typedef float f32x2c_t __attribute__((ext_vector_type(2))); typedef __bf16 bf16x2c_t __attribute__((ext_vector_type(2)));
__device__ __forceinline__ unsigned cvt_pk_b(float lo, float hi) { const f32x2c_t v = {lo, hi}; const bf16x2c_t b = __builtin_convertvector(v, bf16x2c_t); return __builtin_bit_cast(unsigned, b); }
struct EpiLowRank {
    static constexpr bool PERM = true, AFTER_DRAIN = false;
    int goff;
    template <int KIND> __device__ __forceinline__ void run(const f32x4 (&acc)[2][2][4][2], const Unit& u, int wr, int wc, int fr, int fq) const {
        PRef p = FP; bf16_t* O = (bf16_t*)(p.ws + E_Y); const float* bsrc = KIND == 0 ? p.in[18] : p.in[20];
        const int row0 = u.pm * BM + wr * 64 + fr, col0 = u.pn * BM + wc * 32 + 8 * fq + goff;
#pragma unroll
        for (int bj = 0; bj < 2; ++bj) { const int col = col0 + bj * HALF; f32x4 b0 = {0.f, 0.f, 0.f, 0.f}, b1 = {0.f, 0.f, 0.f, 0.f};
            if (KIND < 2) { b0 = *(const f32x4*)(bsrc + (col & 511)); b1 = *(const f32x4*)(bsrc + (col & 511) + 4); }
#pragma unroll
            for (int ai = 0; ai < 2; ++ai)
#pragma unroll
                for (int m = 0; m < 4; ++m) { const int row = row0 + ai * HALF + m * 16; f32x4 v0 = acc[ai][bj][m][0] + b0, v1 = acc[ai][bj][m][1] + b1;
#pragma unroll
                    for (int i = 0; i < 4; ++i) {
                        if (KIND == 0) { const float n0 = -v0[i], n1 = -v1[i]; const float s0 = fmaxf(n0, 0.f) + __logf(1.0f + __expf(-fabsf(n0))), s1 = fmaxf(n1, 0.f) + __logf(1.0f + __expf(-fabsf(n1)));
                            v0[i] = __expf(-s0 - 0.5f); v1[i] = __expf(-s1 - 0.5f); }
                        else if (KIND == 1) { v0[i] = sigm(v0[i]); v1[i] = sigm(v1[i]); } }
                    u32x4 w; w.x = cvt_pk_b(v0[0], v0[1]); w.y = cvt_pk_b(v0[2], v0[3]); w.z = cvt_pk_b(v1[0], v1[1]); w.w = cvt_pk_b(v1[2], v1[3]);
                    *(u32x4*)(O + (size_t)row * 1536 + col) = w; } }
    }
    __device__ __forceinline__ void operator()(const f32x4 (&acc)[2][2][4][2], const Unit& u, int wr, int wc, int fr, int fq) const {
        const int kind = goff ? 2 : (u.pn >> 1);
        if (kind == 0) run<0>(acc, u, wr, wc, fr, fq); else if (kind == 1) run<1>(acc, u, wr, wc, fr, fq); else run<2>(acc, u, wr, wc, fr, fq);
    }
};
template <class Epi, class Sched, bool ALIGN_EPI = false, bool SP2 = false>
__device__ __forceinline__ void gemm_phase(PG8_LAS unsigned char* lds, const Gemm g, const Sched& S, const Epi& E) {
    int tid_l = threadIdx.x; asm volatile("" : "+v"(tid_l));
    const int tid = tid_l, wid = __builtin_amdgcn_readfirstlane(tid >> 6), lane = tid & 63, wr = wid >> 2, wc = wid & 3, fr = lane & 15, fq = lane >> 4;
    const int K = g.K, nt = K / BK, lda = g.lda;
    unsigned voffA[2], voffB[2];
#pragma unroll
    for (int i = 0; i < 2; ++i) { int R, C; stage_rc(tid * 16 + i * 8192, R, C); const int Rb = Epi::PERM ? ((R & ~31) + perm32(R & 31)) : R;
        voffA[i] = (unsigned)(R * lda + C) * 2u; voffB[i] = (unsigned)(Rb * K + C) * 2u; }
    const size_t kstep = (size_t)(BK * 2);
    const size_t hstepB = (size_t)HALF * K * 2, hstepA = (size_t)HALF * lda * 2;
    const size_t tstepB = 2 * hstepB, tstepA = 2 * hstepA;
    const unsigned ldsw = (unsigned)wid * 1024u;
    const int aoff = lds_byte(wr * 64 + fr, fq * 8), boff = lds_byte(wc * 32 + fr, fq * 8);
#define PG8_SA(b, h) (((b) * 2 + (h)) * HTB)
#define PG8_SB(b, h) ((4 + (b) * 2 + (h)) * HTB)
#define PG8_STAGE(bufoff, gbase, voff) do { _Pragma("unroll") for (int _i = 0; _i < 2; ++_i) \
        __builtin_amdgcn_global_load_lds((const unsigned*)((const char*)(gbase) + (voff)[_i]), (PG8_LAS unsigned*)(lds + (bufoff) + ldsw + _i * 8192), 16, 0, 0); } while (0)
#define PG8_LDA(dst, b, h) do { _Pragma("unroll") for (int m = 0; m < 4; ++m) _Pragma("unroll") for (int k = 0; k < 2; ++k) dst[m][k] = *(const PG8_LAS bf16x8*)(lds + PG8_SA(b, h) + aoff + m * 2048 + k * 1024); } while (0)
#define PG8_LDB(dst, b, h) do { _Pragma("unroll") for (int n = 0; n < 2; ++n) _Pragma("unroll") for (int k = 0; k < 2; ++k) dst[n][k] = *(const PG8_LAS bf16x8*)(lds + PG8_SB(b, h) + boff + n * 2048 + k * 1024); } while (0)
#define PG8_MMA(ai, bj, At, Bt) do { __builtin_amdgcn_s_setprio(1); _Pragma("unroll") for (int m = 0; m < 4; ++m) _Pragma("unroll") for (int n = 0; n < 2; ++n) _Pragma("unroll") for (int k = 0; k < 2; ++k) \
        acc[ai][bj][m][n] = __builtin_amdgcn_mfma_f32_16x16x32_bf16(Bt[n][k], At[m][k], acc[ai][bj][m][n], 0, 0, 0); __builtin_amdgcn_s_setprio(0); } while (0)
#define PG8_WAIT_V(n) asm volatile("s_waitcnt vmcnt(" #n ")" ::: "memory")
#define PG8_WAIT_L(n) asm volatile("s_waitcnt lgkmcnt(" #n ")" ::: "memory")
#define PG8_BAR __builtin_amdgcn_s_barrier()
#define PG8_SCHED __builtin_amdgcn_sched_barrier(0)
    Unit cur, nxt; int ui = 0;
    if (!S.next(0, cur)) return;
    f32x4 acc[2][2][4][2];
#pragma unroll
    for (int a = 0; a < 2; ++a)
#pragma unroll
        for (int b = 0; b < 2; ++b)
#pragma unroll
            for (int m = 0; m < 4; ++m)
#pragma unroll
                for (int n = 0; n < 2; ++n) acc[a][b][m][n] = (f32x4){0.f, 0.f, 0.f, 0.f};
    bf16x8 At[4][2], B0[2][2], B1[2][2];
    const char* cA = (const char*)g.A + (size_t)cur.pm * tstepA; const char* cB = (const char*)g.Bt + (size_t)cur.pn * tstepB;
    S.a_ready(cur);
    if constexpr (SP2) {
        PG8_STAGE(PG8_SB(0, 0), cB, voffB); PG8_STAGE(PG8_SB(0, 1), cB + hstepB, voffB); PG8_STAGE(PG8_SA(0, 0), cA, voffA); PG8_STAGE(PG8_SA(0, 1), cA + hstepA, voffA);
        if (wr == 1) PG8_BAR;
        PG8_WAIT_V(2); PG8_BAR;
        PG8_STAGE(PG8_SB(1, 0), cB + kstep, voffB); PG8_STAGE(PG8_SA(1, 0), cA + kstep, voffA); PG8_STAGE(PG8_SB(1, 1), cB + hstepB + kstep, voffB);
        PG8_WAIT_V(6); PG8_BAR;
    } else {
        PG8_STAGE(PG8_SB(0, 0), cB, voffB); PG8_STAGE(PG8_SA(0, 0), cA, voffA); PG8_STAGE(PG8_SB(0, 1), cB + hstepB, voffB); PG8_STAGE(PG8_SA(0, 1), cA + hstepA, voffA);
        if (wr == 1) PG8_BAR;
        PG8_WAIT_V(4); PG8_BAR;
        PG8_STAGE(PG8_SB(1, 0), cB + kstep, voffB); PG8_STAGE(PG8_SA(1, 0), cA + kstep, voffA); PG8_STAGE(PG8_SB(1, 1), cB + hstepB + kstep, voffB);
        PG8_WAIT_V(6); PG8_BAR;
    }
    for (;;) {
        const bool has_next = S.next(ui + 1, nxt);
        const char* nA = has_next ? (const char*)g.A + (size_t)nxt.pm * tstepA : cA; const char* nB = has_next ? (const char*)g.Bt + (size_t)nxt.pn * tstepB : cB;
        for (int t = 0; t < nt; t += 2) {
            const bool last = (t == nt - 2);
            const char* a1 = cA + (size_t)(t + 1) * kstep;
            const char* a2 = last ? nA : cA + (size_t)(t + 2) * kstep; const char* b2 = last ? nB : cB + (size_t)(t + 2) * kstep;
            const char* a3 = a2 + kstep; const char* b3 = b2 + kstep;
            if (last && has_next) S.a_ready(nxt);
            if constexpr (SP2) {
            PG8_LDB(B0, 0, 0); PG8_LDB(B1, 0, 1); PG8_SCHED; PG8_LDA(At, 0, 0); PG8_STAGE(PG8_SA(1, 1), a1 + hstepA, voffA);
            PG8_WAIT_V(8); PG8_WAIT_L(0); PG8_BAR; PG8_MMA(0, 0, At, B0); PG8_MMA(0, 1, At, B1); PG8_BAR; PG8_SCHED;
            PG8_LDA(At, 0, 1); PG8_STAGE(PG8_SB(0, 0), b2, voffB); PG8_STAGE(PG8_SB(0, 1), b2 + hstepB, voffB); PG8_STAGE(PG8_SA(0, 0), a2, voffA);
            PG8_WAIT_V(8); PG8_WAIT_L(0); PG8_BAR; PG8_MMA(1, 0, At, B0); PG8_MMA(1, 1, At, B1); PG8_BAR; PG8_SCHED;
            PG8_LDB(B0, 1, 0); PG8_LDB(B1, 1, 1); PG8_SCHED; PG8_LDA(At, 1, 0); PG8_STAGE(PG8_SA(0, 1), a2 + hstepA, voffA);
            PG8_WAIT_V(8); PG8_WAIT_L(0); PG8_BAR; PG8_MMA(0, 0, At, B0); PG8_MMA(0, 1, At, B1); PG8_BAR; PG8_SCHED;
            PG8_LDA(At, 1, 1); PG8_STAGE(PG8_SB(1, 0), b3, voffB); PG8_STAGE(PG8_SB(1, 1), b3 + hstepB, voffB); PG8_STAGE(PG8_SA(1, 0), a3, voffA);
            PG8_WAIT_V(8); PG8_WAIT_L(0); PG8_BAR; PG8_MMA(1, 0, At, B0); PG8_MMA(1, 1, At, B1); PG8_BAR; PG8_SCHED;
            } else {
            PG8_LDB(B0, 0, 0); PG8_SCHED; PG8_LDA(At, 0, 0); PG8_STAGE(PG8_SA(1, 1), a1 + hstepA, voffA);
            PG8_WAIT_L(8); PG8_BAR; PG8_WAIT_L(0); PG8_MMA(0, 0, At, B0); PG8_BAR; PG8_SCHED;
            PG8_LDB(B1, 0, 1); PG8_STAGE(PG8_SB(0, 0), b2, voffB);
            PG8_BAR; PG8_WAIT_L(0); PG8_MMA(0, 1, At, B1); PG8_BAR;
            PG8_LDA(At, 0, 1); PG8_STAGE(PG8_SA(0, 0), a2, voffA);
            PG8_BAR; PG8_WAIT_L(0); PG8_MMA(1, 0, At, B0); PG8_BAR; PG8_SCHED;
            PG8_STAGE(PG8_SB(0, 1), b2 + hstepB, voffB);
            PG8_WAIT_V(6); PG8_BAR; PG8_MMA(1, 1, At, B1); PG8_BAR;
            PG8_LDB(B0, 1, 0); PG8_SCHED; PG8_LDA(At, 1, 0); PG8_STAGE(PG8_SA(0, 1), a2 + hstepA, voffA);
            PG8_WAIT_L(8); PG8_BAR; PG8_WAIT_L(0); PG8_MMA(0, 0, At, B0); PG8_BAR; PG8_SCHED;
            PG8_LDB(B1, 1, 1); PG8_STAGE(PG8_SB(1, 0), b3, voffB);
            PG8_BAR; PG8_WAIT_L(0); PG8_MMA(0, 1, At, B1); PG8_BAR;
            PG8_LDA(At, 1, 1); PG8_STAGE(PG8_SA(1, 0), a3, voffA);
            PG8_BAR; PG8_WAIT_L(0); PG8_MMA(1, 0, At, B0); PG8_BAR; PG8_SCHED;
            PG8_STAGE(PG8_SB(1, 1), b3 + hstepB, voffB);
            PG8_WAIT_V(6); PG8_BAR; PG8_MMA(1, 1, At, B1); PG8_BAR;
            }
        }
        if constexpr (ALIGN_EPI) { if (wr == 0) PG8_BAR; }
        if constexpr (!Epi::AFTER_DRAIN) { int tl2 = threadIdx.x; asm volatile("" : "+v"(tl2)); E(acc, cur, wr, wc, tl2 & 15, (tl2 & 63) >> 4); S.done(cur); }
        if (!has_next) break;
#pragma unroll
        for (int a = 0; a < 2; ++a)
#pragma unroll
            for (int b = 0; b < 2; ++b)
#pragma unroll
                for (int m = 0; m < 4; ++m)
#pragma unroll
                    for (int n = 0; n < 2; ++n) acc[a][b][m][n] = (f32x4){0.f, 0.f, 0.f, 0.f};
        cur = nxt; cA = nA; cB = nB; ++ui;
        if constexpr (ALIGN_EPI) { if (wr == 1) PG8_BAR; }
    }
    PG8_WAIT_V(0);
    if constexpr (!ALIGN_EPI) { if (wr == 0) PG8_BAR; }
    PG8_BAR;
    if constexpr (Epi::AFTER_DRAIN) { E.fused(acc, cur, wr, wc, fr, fq, lds, wid, lane); S.done(cur); }
#undef PG8_SA
#undef PG8_SB
#undef PG8_STAGE
#undef PG8_LDA
#undef PG8_LDB
#undef PG8_MMA
#undef PG8_WAIT_V
#undef PG8_WAIT_L
#undef PG8_BAR
#undef PG8_SCHED
}
}

#define LAS __attribute__((address_space(3)))
typedef unsigned short bf16;
typedef unsigned v4u __attribute__((ext_vector_type(4)));
typedef unsigned v2u __attribute__((ext_vector_type(2)));
typedef float f32x4 __attribute__((ext_vector_type(4)));
typedef short bf16x8 __attribute__((ext_vector_type(8)));

constexpr int T = 16384, SEQ = 2048, NP0 = 2816, NP1 = 3840, FF = 2816;
constexpr int NTHREADS = 512, NWAVES = 8;
constexpr int LDS_BYTES = 147456;
constexpr size_t MiB = 1u << 20;
constexpr size_t WS_CTL = 0, CTL_ZERO_BYTES = 65536;
constexpr size_t WS_ROWSS = 65536;
constexpr size_t WS_CARRY = 512 * 1024;
constexpr size_t WS_W = 1 * MiB;
constexpr size_t W_IN = WS_W, W_OUT = W_IN + 7680 * 1024, W_GU = W_OUT + 2 * MiB, W_DN = W_GU + 11 * MiB, W_PG = W_DN + 5632 * 1024, W_PP = W_PG + 2 * MiB,
                 W_LR = W_PP + 512 * 1024, W_LRU = W_LR + 768 * 1024, W_END = W_LRU + 128 * 1024;
static_assert(W_END <= 35 * MiB, "weights region");
constexpr size_t WS_HB = 35 * MiB;
constexpr size_t WS_PROJ = 67 * MiB;
constexpr size_t WS_Y = 187 * MiB;
constexpr size_t WS_GST = 219 * MiB;
constexpr size_t WS_ALR = 235 * MiB;
constexpr size_t WS_PB = 243 * MiB;
constexpr size_t WS_RKR = 251 * MiB;
constexpr size_t WS_GDEC = WS_RKR + 512 * 1024;
constexpr size_t WS_LEND = 252 * MiB;
constexpr size_t WS_END = 256 * MiB;

static_assert(E_ROWSS == WS_ROWSS && E_HB == WS_HB && E_PROJ == WS_PROJ && E_Y == WS_Y, "epilogue offsets");

__device__ __forceinline__ int fresh_s(int x) { asm volatile("" : "+s"(x)); return x; }
__device__ __forceinline__ int fresh_tid() { int t = threadIdx.x; asm volatile("" : "+v"(t)); return t; }
__device__ __forceinline__ float bf2f(unsigned v) { return __uint_as_float(v << 16); }
typedef float f32x2_t __attribute__((ext_vector_type(2))); typedef __bf16 bf16x2_t __attribute__((ext_vector_type(2)));
__device__ __forceinline__ unsigned pk2(float lo, float hi) { const f32x2_t v = {lo, hi}; const bf16x2_t b = __builtin_convertvector(v, bf16x2_t); return __builtin_bit_cast(unsigned, b); }
__device__ __forceinline__ unsigned f2bf(float f) { return pk2(f, f) & 0xffffu; }
__device__ __forceinline__ void unpack8(const v4u w, float* f) {
    f[0] = __uint_as_float(w.x << 16); f[1] = __uint_as_float(w.x & 0xffff0000u); f[2] = __uint_as_float(w.y << 16); f[3] = __uint_as_float(w.y & 0xffff0000u);
    f[4] = __uint_as_float(w.z << 16); f[5] = __uint_as_float(w.z & 0xffff0000u); f[6] = __uint_as_float(w.w << 16); f[7] = __uint_as_float(w.w & 0xffff0000u);
}
__device__ __forceinline__ v4u pack8(const float* f) { v4u w; w.x = pk2(f[0], f[1]); w.y = pk2(f[2], f[3]); w.z = pk2(f[4], f[5]); w.w = pk2(f[6], f[7]); return w; }
__device__ __forceinline__ void ld8(const bf16* p, float* f) { unpack8(*(const v4u*)p, f); }
__device__ __forceinline__ void ldf8(const float* p, float* f) { const f32x4 a = *(const f32x4*)p, b = *(const f32x4*)(p + 4); f[0] = a[0]; f[1] = a[1]; f[2] = a[2]; f[3] = a[3]; f[4] = b[0]; f[5] = b[1]; f[6] = b[2]; f[7] = b[3]; }
__device__ __forceinline__ float sigmf(float x) { return __builtin_amdgcn_rcpf(1.0f + __expf(-x)); }
__device__ __forceinline__ float logsigf(float z) { return fminf(z, 0.f) - __logf(1.0f + __expf(-fabsf(z))); }
__device__ __forceinline__ float wave_sum(float v) {
#pragma unroll
    for (int o = 1; o < 64; o <<= 1) v += __shfl_xor(v, o);
    return v;
}
#define LDS_WAIT() asm volatile("s_waitcnt lgkmcnt(0)" ::: "memory")

#define XB_TMO      128
#define XB_XCNT(j)  (256  + 64 * (j))
#define XB_XSUB(j)  (1280 + 64 * (j))
#define XB_XGEN(j)  (2304 + 64 * (j))
#define XB_TOP      3328
#define XB_TOPGEN   3392
#define XCD_BAR_WORDS 3456
#define XB_SPIN_CAP (1u << 18)

__device__ __forceinline__ unsigned xb_ld(unsigned* p)              { return __hip_atomic_load(p, __ATOMIC_RELAXED, __HIP_MEMORY_SCOPE_AGENT); }
__device__ __forceinline__ unsigned xb_add(unsigned* p, unsigned v) { return __hip_atomic_fetch_add(p, v, __ATOMIC_RELAXED, __HIP_MEMORY_SCOPE_AGENT); }
__device__ __forceinline__ unsigned xb_xcc_id() { return (unsigned)__builtin_amdgcn_s_getreg((3 << 11) | 20) & 0xFu; }
#define XB_SPIN(cond, bar) do { unsigned _sp = 0; while (cond) { __builtin_amdgcn_s_sleep(1); \
    if ((++_sp & 255u) == 0u) { if (xb_ld(&(bar)[XB_TMO])) break; if (_sp > XB_SPIN_CAP) { atomicAdd(&(bar)[XB_TMO], 1u); break; } } } } while (0)

struct XcdBarrier {
    unsigned* bar; unsigned x;
    volatile LAS unsigned* st;
};

__device__ __forceinline__ XcdBarrier xcd_barrier_post(unsigned* bar, volatile LAS unsigned* st) {
    XcdBarrier b; b.bar = bar; b.x = xb_xcc_id(); b.st = st;
    if (threadIdx.x == 0) (void)xb_add(&bar[XB_XCNT(b.x)], 1u);
    return b;
}
__device__ __forceinline__ void xcd_barrier_complete(unsigned* bar, unsigned x, unsigned& nloc, unsigned& nx) {
    const unsigned G = gridDim.x * gridDim.y * gridDim.z;
    unsigned sum, cnt, mine, sp = 0u;
    for (;;) {
        sum = 0u; cnt = 0u; mine = 0u;
#pragma unroll
        for (unsigned j = 0; j < 16; ++j) { const unsigned c = xb_ld(&bar[XB_XCNT(j)]); sum += c; cnt += (c > 0u) ? 1u : 0u; mine = (j == x) ? c : mine; }
        if (sum == G) break;
        __builtin_amdgcn_s_sleep(1);
        if ((++sp & 255u) == 0u) { if (xb_ld(&bar[XB_TMO])) break; if (sp > XB_SPIN_CAP) { atomicAdd(&bar[XB_TMO], 1u); break; } }
    }
    nloc = mine > 0u ? mine : 1u; nx = cnt > 0u ? cnt : 1u;
}

__device__ __forceinline__ void xcd_barrier(const XcdBarrier& b) {
    asm volatile("s_waitcnt vmcnt(0)" ::: "memory");
    __syncthreads();
    if (threadIdx.x == 0) {
        unsigned* bar = b.bar;
        __builtin_amdgcn_s_waitcnt(0);
        unsigned nloc = b.st[0], nx = b.st[1];
        if (nloc == 0u) { xcd_barrier_complete(bar, b.x, nloc, nx); b.st[0] = nloc; b.st[1] = nx; }
        const unsigned old = xb_add(&bar[XB_XSUB(b.x)], 1u);
        const unsigned gen = old / nloc;
        if (old + 1u == (gen + 1u) * nloc) {
            __builtin_amdgcn_fence(__ATOMIC_RELEASE, "agent");
            asm volatile("s_waitcnt vmcnt(0)" ::: "memory");
            const unsigned og = xb_add(&bar[XB_TOP], 1u);
            const unsigned tg = og / nx;
            if (og + 1u == (tg + 1u) * nx) xb_add(&bar[XB_TOPGEN], 1u);
            else XB_SPIN(xb_ld(&bar[XB_TOPGEN]) == tg, bar);
            __builtin_amdgcn_fence(__ATOMIC_ACQUIRE, "agent");
            xb_add(&bar[XB_XGEN(b.x)], 1u);
            asm volatile("s_waitcnt vmcnt(0)" ::: "memory");
        } else {
            XB_SPIN(xb_ld(&bar[XB_XGEN(b.x)]) == gen, bar);
            __builtin_amdgcn_fence(__ATOMIC_ACQUIRE, "agent");
            asm volatile("s_waitcnt vmcnt(0)" ::: "memory");
        }
    }
    __syncthreads();
}

constexpr size_t WS_XBAR = 16384;
constexpr int LDS_XST = LDS_BYTES - 64;

__device__ __forceinline__ f32x4 mma_ll(const LAS bf16* X, int ldx, const LAS bf16* Y, int ldy, int K, f32x4 acc, int lane) {
    const LAS bf16* xp = X + (lane & 15) * ldx + 8 * (lane >> 4);
    const LAS bf16* yp = Y + (lane & 15) * ldy + 8 * (lane >> 4);
    for (int k = 0; k < K; k += 32) {
        const bf16x8 a = *(const LAS bf16x8*)(xp + k), b = *(const LAS bf16x8*)(yp + k);
        acc = __builtin_amdgcn_mfma_f32_16x16x32_bf16(a, b, acc, 0, 0, 0);
    }
    return acc;
}
__device__ __forceinline__ f32x4 mma_lg(const LAS bf16* X, int ldx, const bf16* Y, int ldy, int K, f32x4 acc, int lane) {
    const LAS bf16* xp = X + (lane & 15) * ldx + 8 * (lane >> 4);
    const bf16* yp = Y + (size_t)(lane & 15) * ldy + 8 * (lane >> 4);
    for (int k = 0; k < K; k += 32) {
        const bf16x8 a = *(const LAS bf16x8*)(xp + k), b = *(const bf16x8*)(yp + k);
        acc = __builtin_amdgcn_mfma_f32_16x16x32_bf16(a, b, acc, 0, 0, 0);
    }
    return acc;
}

__device__ __forceinline__ void tr_load(const float* W, int ldw, const float* gain, int ncols, int item, int lane, f32x4 (&v)[8]) {
    const int nblk = ncols / 32, kb = item / nblk, nb = item % nblk, k0 = 64 * kb, n0 = 32 * nb;
#pragma unroll
    for (int i = 0; i < 8; ++i) { const int kk = 8 * i + (lane >> 3), cc = (lane & 7) * 4; v[i] = *(const f32x4*)(W + (size_t)(k0 + kk) * ldw + n0 + cc); if (gain) v[i] = v[i] * gain[k0 + kk]; }
}
__device__ __forceinline__ void tr_store(int K, bf16* WT, int ncols, int mode, LAS float* scr, int item, int lane, const f32x4 (&v)[8]) {
    const int nblk = ncols / 32, kb = item / nblk, nb = item % nblk, k0 = 64 * kb, n0 = 32 * nb;
#pragma unroll
    for (int i = 0; i < 8; ++i) { const int kk = 8 * i + (lane >> 3), cc = (lane & 7) * 4; scr[kk * 33 + cc] = v[i].x; scr[kk * 33 + cc + 1] = v[i].y; scr[kk * 33 + cc + 2] = v[i].z; scr[kk * 33 + cc + 3] = v[i].w; }
    LDS_WAIT(); asm volatile("" ::: "memory");
    const int c = lane & 7;
#pragma unroll
    for (int j = 0; j < 4; ++j) { const int n = (lane >> 3) + 8 * j; const LAS float* s = scr + (8 * c) * 33 + n;
        v4u o; o.x = pk2(s[0 * 33], s[1 * 33]); o.y = pk2(s[2 * 33], s[3 * 33]); o.z = pk2(s[4 * 33], s[5 * 33]); o.w = pk2(s[6 * 33], s[7 * 33]);
        const int nn = n0 + n; const int r = mode == 0 ? nn : (8 * (nn >> 2) + (nn & 3) + (mode == 2 ? 4 : 0));
        *(v4u*)(WT + (size_t)r * K + k0 + 8 * c) = o; }
    LDS_WAIT(); asm volatile("" ::: "memory");
}
__device__ __forceinline__ void tr_item(const float* W, int ldw, int K, const float* gain, bf16* WT, int ncols, int mode, LAS float* scr, int item, int lane) {
    f32x4 v[8]; tr_load(W, ldw, gain, ncols, item, lane, v); tr_store(K, WT, ncols, mode, scr, item, lane, v);
}
__device__ __forceinline__ void tr_job(const float* W, int ldw, int K, const float* gain, bf16* WT, int ncols, int mode, LAS unsigned char* lds, int gw, int NGW, int wave, int lane) {
    LAS float* scr = (LAS float*)(lds + wave * 8704);
    const int nitems = (K / 64) * (ncols / 32);
    for (int it = gw; it < nitems; it += NGW) tr_item(W, ldw, K, gain, WT, ncols, mode, scr, it, lane);
}
__device__ __forceinline__ void cvt_layer_weights(PRef p, int li, LAS unsigned char* lds, int gw, int NGW, int wave, int lane) {
    unsigned char* ws = p.ws;
    tr_job(li == 0 ? p.in[14] : p.in[27], 1024, 1024, nullptr, (bf16*)(ws + W_OUT), 1024, 0, lds, gw, NGW, wave, lane);
    tr_job(p.in[30] + (size_t)li * 1024 * FF, FF, 1024, p.in[29] + li * 1024, (bf16*)(ws + W_GU), FF, 1, lds, gw, NGW, wave, lane);
    tr_job(p.in[31] + (size_t)li * 1024 * FF, FF, 1024, p.in[29] + li * 1024, (bf16*)(ws + W_GU), FF, 2, lds, gw, NGW, wave, lane);
    tr_job(p.in[32] + (size_t)li * FF * 1024, 1024, FF, nullptr, (bf16*)(ws + W_DN), 1024, 0, lds, gw, NGW, wave, lane);
    tr_job(p.in[34] + (size_t)li * 1024 * 1024, 1024, 1024, p.in[33] + li * 1024, (bf16*)(ws + W_PG), 1024, 0, lds, gw, NGW, wave, lane);
    tr_job(p.in[36] + (size_t)li * 256 * 1024, 1024, 256, nullptr, (bf16*)(ws + W_PP), 1024, 0, lds, gw, NGW, wave, lane);
}
__device__ __forceinline__ void cvt_p(PRef p, int li, int gw, int NGW, int lane) {
    const float* src = p.in[1] + (size_t)li * T * 256; bf16* pb = (bf16*)(p.ws + WS_PB);
    for (int m = gw; m < T; m += NGW) { const f32x4 v = *((const f32x4*)(src + (size_t)m * 256) + lane); v2u o; o.x = pk2(v.x, v.y); o.y = pk2(v.z, v.w); *((v2u*)(pb + (size_t)m * 256) + lane) = o; }
}

constexpr int CVT1_ITEMS = 512 + 3 * 1408 + 512 + 128 + 1024;
struct Cvt1Job { const float* W; const float* gain; bf16* WT; int ldw, K, ncols, mode, item; };
__device__ __forceinline__ Cvt1Job cvt1_job(PRef p, int idx) {
    unsigned char* ws = p.ws; Cvt1Job j;
    if (idx < 512) { j = Cvt1Job{p.in[27], nullptr, (bf16*)(ws + W_OUT), 1024, 1024, 1024, 0, idx}; return j; } idx -= 512;
    if (idx < 1408) { j = Cvt1Job{p.in[30] + (size_t)1024 * FF, p.in[29] + 1024, (bf16*)(ws + W_GU), FF, 1024, FF, 1, idx}; return j; } idx -= 1408;
    if (idx < 1408) { j = Cvt1Job{p.in[31] + (size_t)1024 * FF, p.in[29] + 1024, (bf16*)(ws + W_GU), FF, 1024, FF, 2, idx}; return j; } idx -= 1408;
    if (idx < 1408) { j = Cvt1Job{p.in[32] + (size_t)FF * 1024, nullptr, (bf16*)(ws + W_DN), 1024, FF, 1024, 0, idx}; return j; } idx -= 1408;
    if (idx < 512) { j = Cvt1Job{p.in[34] + (size_t)1024 * 1024, p.in[33] + 1024, (bf16*)(ws + W_PG), 1024, 1024, 1024, 0, idx}; return j; } idx -= 512;
    j = Cvt1Job{p.in[36] + (size_t)256 * 1024, nullptr, (bf16*)(ws + W_PP), 1024, 256, 1024, 0, idx}; return j;
}
constexpr int CVT1_W_ITEMS = CVT1_ITEMS - 1024;
__device__ __forceinline__ void cvt1_load(PRef p, int idx, int lane, f32x4 (&v)[8]) {
    if (idx < CVT1_W_ITEMS) { const Cvt1Job j = cvt1_job(p, idx); tr_load(j.W, j.ldw, j.gain, j.ncols, j.item, lane, v); }
    else { const float* src = p.in[1] + (size_t)T * 256 + (size_t)(idx - CVT1_W_ITEMS) * 16 * 256;
#pragma unroll
        for (int r = 0; r < 8; ++r) v[r] = *((const f32x4*)(src + (size_t)r * 256) + lane); }
}
__device__ __forceinline__ void cvt1_store(PRef p, int idx, LAS float* scr, int lane, const f32x4 (&v)[8]) {
    if (idx < CVT1_W_ITEMS) { const Cvt1Job j = cvt1_job(p, idx); tr_store(j.K, j.WT, j.ncols, j.mode, scr, j.item, lane, v); }
    else { const int m0 = (idx - CVT1_W_ITEMS) * 16; const float* src = p.in[1] + (size_t)T * 256; bf16* pb = (bf16*)(p.ws + WS_PB);
#pragma unroll
        for (int r = 0; r < 8; ++r) { v2u o; o.x = pk2(v[r].x, v[r].y); o.y = pk2(v[r].z, v[r].w); *((v2u*)(pb + (size_t)(m0 + r) * 256) + lane) = o; }
        for (int r = 8; r < 16; ++r) { const f32x4 w = *((const f32x4*)(src + (size_t)(m0 + r) * 256) + lane); v2u o; o.x = pk2(w.x, w.y); o.y = pk2(w.z, w.w); *((v2u*)(pb + (size_t)(m0 + r) * 256) + lane) = o; } }
}
__device__ __forceinline__ void cvt1_flat(PRef p, int idx, LAS float* scr, int lane) { f32x4 v[8]; cvt1_load(p, idx, lane, v); cvt1_store(p, idx, scr, lane, v); }
__device__ __forceinline__ void phase_prologue(PRef p, LAS unsigned char* lds, int gw, int NGW, int wave, int lane) {
    unsigned char* ws = p.ws; const int gtid = gw * 64 + lane, NGT = NGW * 64;
    tr_job(p.in[3], 2576, 1024, p.in[28], (bf16*)(ws + W_IN), 2560, 0, lds, gw, NGW, wave, lane);
    for (int it = gtid; it < 256 * 128; it += NGT) { const int n = it >> 7, kc = it & 127; float o[8];
#pragma unroll
        for (int i = 0; i < 8; ++i) { const int k = 8 * kc + i; const float* wr = p.in[3] + (size_t)k * 2576 + 2560; float s = 0.f;
#pragma unroll
            for (int r = 0; r < 16; ++r) s += wr[r] * p.in[11][r * 256 + n];
            o[i] = s * p.in[28][k]; }
        *(v4u*)((bf16*)(ws + W_IN) + (size_t)(2560 + n) * 1024 + 8 * kc) = pack8(o); }
    cvt_layer_weights(p, 0, lds, gw, NGW, wave, lane);
    for (int it = gtid; it < 1536 * 16; it += NGT) { const int n = it >> 4, kc = it & 15; float o[8];
#pragma unroll
        for (int i = 0; i < 8; ++i) { const int k = 8 * kc + i; float v = 0.f;
            if (n < 512) { if (k < 64) v = p.in[19][k * 512 + n]; }
            else if (n < 1024) { if (k >= 64) v = p.in[21][(k - 64) * 512 + (n - 512)]; }
            else v = p.in[22][k * 512 + (n - 1024)];
            o[i] = v; }
        *(v4u*)((bf16*)(ws + W_LR) + (size_t)n * 128 + 8 * kc) = pack8(o); }
    for (int it = gtid; it < 2 * 8 * 64 * 8; it += NGT) { const int ic = it & 7, j = (it >> 3) & 63, g = (it >> 9) & 7, which = it >> 12; const float* src = which ? p.in[8] : p.in[6]; float o[8];
#pragma unroll
        for (int i = 0; i < 8; ++i) o[i] = src[(g * 64 + 8 * ic + i) * 64 + j];
        *(v4u*)((bf16*)(ws + W_LRU) + (size_t)which * 32768 + (g * 64 + j) * 64 + 8 * ic) = pack8(o); }
    { const float* x = p.in[0]; bf16* hb = (bf16*)(ws + WS_HB); float* rss = (float*)(ws + WS_ROWSS);
      for (int m = gw; m < T; m += NGW) { const f32x4* xr = (const f32x4*)(x + (size_t)m * 1024) + lane; float s = 0.f; v2u* o8 = (v2u*)(hb + (size_t)m * 1024) + lane;
#pragma unroll
          for (int j = 0; j < 4; ++j) { const f32x4 v = xr[64 * j]; s += (v.x * v.x + v.y * v.y) + (v.z * v.z + v.w * v.w); v2u o; o.x = pk2(v.x, v.y); o.y = pk2(v.z, v.w); o8[64 * j] = o; }
          s = wave_sum(s); if (lane == 0) rss[m] = s; } }
    cvt_p(p, 0, gw, NGW, lane);
}

__device__ __forceinline__ void lru_local_item(PRef p, LAS unsigned char* lds, int item, int tid, int wave, int lane) {
    const int c = item & 31, b = item >> 5;
    const bf16* proj = (const bf16*)(p.ws + WS_PROJ);
    constexpr int LX = 520;
    constexpr int LR = 65;
    LAS bf16* Xs = (LAS bf16*)lds; LAS float* R = (LAS float*)(lds + 66560); LAS float* I = (LAS float*)(lds + 66560 + 16640);
    LAS float* SEGH = (LAS float*)(lds + 66560 + 33280); LAS float* SEGP = SEGH + 512;
    const int tl = tid >> 3, c8 = (tid & 7) * 8, t0 = b * SEQ + 64 * c;
    LAS float* LS = SEGP + 512; LAS float* BR = LS + 512; LAS float* BI = BR + 512; LAS float* CARH = BI + 512; LAS float* CARP = CARH + 512;
    LS[tid] = logsigf(p.in[10][tid]); BR[tid] = p.in[7][tid]; BI[tid] = p.in[9][tid];
#pragma unroll 2
    for (int g = 0; g < 8; ++g) { const int ch0 = 64 * g + c8; f32x4 a0 = *(const f32x4*)(p.in[5] + ch0), a1 = *(const f32x4*)(p.in[5] + ch0 + 4);
#pragma unroll
        for (int k = 0; k < 4; ++k) { const int tt = 64 * c + tl - 3 + k; if (tt >= 0) { float xv[8]; ld8(proj + (size_t)(b * SEQ + tt) * NP0 + ch0, xv);
                const f32x4 w0 = *(const f32x4*)(p.in[4] + k * 512 + ch0), w1 = *(const f32x4*)(p.in[4] + k * 512 + ch0 + 4);
                a0 = a0 + w0 * (f32x4){xv[0], xv[1], xv[2], xv[3]}; a1 = a1 + w1 * (f32x4){xv[4], xv[5], xv[6], xv[7]}; } }
        const float av[8] = {a0[0], a0[1], a0[2], a0[3], a1[0], a1[1], a1[2], a1[3]};
        *(LAS v4u*)(Xs + tl * LX + ch0) = pack8(av); }
    __syncthreads();
    const int rt = wave & 3, gate = wave >> 2, q = lane >> 4;
    const bf16* WTb = (const bf16*)(p.ws + W_LRU) + gate * 32768 + (size_t)(lane & 15) * 64 + 8 * q;
    bf16x8 wf[4][2];
#pragma unroll
    for (int ct = 0; ct < 4; ++ct) { wf[ct][0] = *(const bf16x8*)(WTb + 16 * ct * 64); wf[ct][1] = *(const bf16x8*)(WTb + 16 * ct * 64 + 32); }
    for (int g = 0; g < 8; ++g) { const int ch0 = 64 * g + c8;
        { LAS float* dst = gate ? I : R; const LAS float* bias = gate ? BI : BR;
          const LAS bf16* xp = Xs + (16 * rt + (lane & 15)) * LX + 64 * g + 8 * q; const bf16x8 a0 = *(const LAS bf16x8*)xp, a1 = *(const LAS bf16x8*)(xp + 32);
          f32x4 acc[4];
#pragma unroll
          for (int ct = 0; ct < 4; ++ct) { acc[ct] = (f32x4){0.f, 0.f, 0.f, 0.f}; acc[ct] = __builtin_amdgcn_mfma_f32_16x16x32_bf16(a0, wf[ct][0], acc[ct], 0, 0, 0); acc[ct] = __builtin_amdgcn_mfma_f32_16x16x32_bf16(a1, wf[ct][1], acc[ct], 0, 0, 0); }
          { const int gn = g < 7 ? g + 1 : 7;
#pragma unroll
            for (int ct = 0; ct < 4; ++ct) { wf[ct][0] = *(const bf16x8*)(WTb + gn * 4096 + 16 * ct * 64); wf[ct][1] = *(const bf16x8*)(WTb + gn * 4096 + 16 * ct * 64 + 32); } }
#pragma unroll
          for (int ct = 0; ct < 4; ++ct) { const int ch = 16 * ct + (lane & 15); const float bv = bias[64 * g + ch];
#pragma unroll
              for (int j = 0; j < 4; ++j) dst[(16 * rt + 4 * q + j) * LR + ch] = sigmf(acc[ct][j] + bv); } }
        __syncthreads();
        {
#pragma unroll
          for (int i = 0; i < 8; ++i) { const float r = R[tl * LR + c8 + i], ii = I[tl * LR + c8 + i], xc = bf2f(Xs[tl * LX + ch0 + i]);
              const float la = 8.0f * r * LS[ch0 + i]; const float a = __expf(la); const float u = __builtin_amdgcn_sqrtf(fmaxf(1.0f - a * a, 0.f)) * (ii * xc);
              R[tl * LR + c8 + i] = a; I[tl * LR + c8 + i] = u; } }
        __syncthreads();
        { const int ch = tid & 63, seg = tid >> 6; float h = 0.f, P = 1.f;
#pragma unroll
          for (int t = 8 * seg; t < 8 * seg + 8; ++t) { const float a = R[t * LR + ch], u = I[t * LR + ch]; h = a * h + u; P *= a; I[t * LR + ch] = h; R[t * LR + ch] = P; }
          SEGH[seg * 64 + ch] = h; SEGP[seg * 64 + ch] = P; }
        __syncthreads();
        { const int ch = tid & 63, seg = tid >> 6; float ch_ = 0.f, cp_ = 1.f;
#pragma unroll
          for (int s2 = 0; s2 < 7; ++s2) { const float sp = SEGP[s2 * 64 + ch], sh = SEGH[s2 * 64 + ch]; if (s2 < seg) { ch_ = sp * ch_ + sh; cp_ *= sp; } }
          CARH[seg * 64 + ch] = ch_; CARP[seg * 64 + ch] = cp_; }
        __syncthreads();
        { bf16* hl = (bf16*)(p.ws + WS_HB); bf16* Pc = hl + (size_t)T * 512; const int seg = tl >> 3; float ho[8], po[8];
#pragma unroll
          for (int i = 0; i < 8; ++i) { const int ch = c8 + i; const float pl = R[tl * LR + ch]; ho[i] = I[tl * LR + ch] + pl * CARH[seg * 64 + ch]; po[i] = pl * CARP[seg * 64 + ch]; }
          *(v4u*)(hl + (size_t)(t0 + tl) * 512 + ch0) = pack8(ho); *(v4u*)(Pc + (size_t)(t0 + tl) * 512 + ch0) = pack8(po);
          if (tl == 63) { float* pe = (float*)(p.ws + WS_LEND);
#pragma unroll
              for (int i = 0; i < 8; ++i) { pe[(b * 32 + c) * 512 + ch0 + i] = po[i]; pe[131072 + (b * 32 + c) * 512 + ch0 + i] = ho[i]; } } }
        __syncthreads();
    }
}
__device__ __forceinline__ void lru_prefix(PRef p, int gtid, int NGT) {
    const float* pe = (const float*)(p.ws + WS_LEND); float* ci = (float*)(p.ws + WS_CARRY);
    for (int it = gtid; it < 4096; it += NGT) { const int b = it >> 9, ch = it & 511; float carry = 0.f; float pv[32], hv[32];
#pragma unroll
        for (int c = 0; c < 32; ++c) { const int o = (b * 32 + c) * 512 + ch; pv[c] = pe[o]; hv[c] = pe[131072 + o]; }
#pragma unroll
        for (int c = 0; c < 32; ++c) { const int o = (b * 32 + c) * 512 + ch; ci[o] = carry; carry = pv[c] * carry + hv[c]; } }
}
__device__ __forceinline__ float tanh_fast(float u) { return 1.0f - 2.0f * __builtin_amdgcn_rcpf(1.0f + __expf(2.0f * u)); }
__device__ __forceinline__ float gelu_tanh(float x) { const float u = 0.7978845608028654f * (x + 0.044715f * x * x * x); return 0.5f * x * (1.0f + tanh_fast(u)); }
__device__ __forceinline__ void lru_out(PRef p, int gtid, int NGT) {
    const bf16* proj = (const bf16*)(p.ws + WS_PROJ); const bf16* hl = (const bf16*)(p.ws + WS_HB); const bf16* Pc = hl + (size_t)T * 512; const float* ci = (const float*)(p.ws + WS_CARRY);
    bf16* y = (bf16*)(p.ws + WS_Y);
    int it = gtid; if (it >= T * 64) return;
    v4u rh, rp, rg; f32x4 c0, c1;
    { const int row = it >> 6, c8 = (it & 63) * 8, b = row >> 11, c = (row & 2047) >> 6; rh = *(const v4u*)(hl + (size_t)row * 512 + c8); rp = *(const v4u*)(Pc + (size_t)row * 512 + c8); rg = *(const v4u*)(proj + (size_t)row * NP0 + 512 + c8);
      const float* cp = ci + (b * 32 + c) * 512 + c8; c0 = *(const f32x4*)cp; c1 = *(const f32x4*)(cp + 4); }
    for (;;) { const int nx = it + NGT; const bool more = nx < T * 64; v4u nh = rh, np = rp, ng = rg; f32x4 n0 = c0, n1 = c1;
        if (more) { const int row = nx >> 6, c8 = (nx & 63) * 8, b = row >> 11, c = (row & 2047) >> 6; nh = *(const v4u*)(hl + (size_t)row * 512 + c8); np = *(const v4u*)(Pc + (size_t)row * 512 + c8); ng = *(const v4u*)(proj + (size_t)row * NP0 + 512 + c8);
            const float* cp = ci + (b * 32 + c) * 512 + c8; n0 = *(const f32x4*)cp; n1 = *(const f32x4*)(cp + 4); }
        { const int row = it >> 6, c8 = (it & 63) * 8; float h[8], P[8], gt[8], o[8]; unpack8(rh, h); unpack8(rp, P); unpack8(rg, gt); const float cr[8] = {c0[0], c0[1], c0[2], c0[3], c1[0], c1[1], c1[2], c1[3]};
#pragma unroll
          for (int i = 0; i < 8; ++i) o[i] = (h[i] + P[i] * cr[i]) * gelu_tanh(gt[i]);
          *(v4u*)(y + (size_t)row * 1024 + c8) = pack8(o); }
        if (!more) break; it = nx; rh = nh; rp = np; rg = ng; c0 = n0; c1 = n1; }
}

template <bool RET> struct LA {
    static constexpr int DK = RET ? 128 : 64, C = RET ? 128 : 64, NCH = SEQ / C, TPT = NTHREADS / C, KPT = DK / TPT, VPT = 128 / TPT, LQ = DK + 8, LT = C + 8;
    static constexpr int O_QS = 0, O_KS = O_QS + C * LQ * 2, O_VT = O_KS + C * LQ * 2, O_SC = O_VT + 128 * LT * 2, O_F = O_SC + C * LT * 2, O_OF = RET ? 0 : O_F + 16640;
    static constexpr int O_KT = O_QS;
    static_assert(DK * LT * 2 <= 2 * C * LQ * 2, "Kt fits");
    static_assert(RET ? (O_SC + C * LT * 2 <= LDS_BYTES - 256 && 128 * 133 * 4 <= 2 * 128 * 136 * 2) : (O_OF + 64 * 133 * 4 <= 98304 && 98304 + 2048 <= LDS_BYTES - 256), "LA LDS");
};
__device__ __forceinline__ void gla_cum(PRef p, LAS unsigned char* lds, const bf16* proj, int t0, int h, int tid) {
    LAS float* F = (LAS float*)(lds + LA<false>::O_F); const int tl = tid >> 3, c8 = (tid & 7) * 8;
    float z[8], bg[8]; ld8(proj + (size_t)(t0 + tl) * NP0 + 2560 + 64 * h + c8, z); ldf8(p.in[12] + 64 * h + c8, bg);
#pragma unroll
    for (int i = 0; i < 8; ++i) F[tl * 65 + c8 + i] = logsigf(z[i] + bg[i]) * (1.0f / 16.0f);
    __syncthreads();
    LAS float* SEG = (LAS float*)(lds + 98304);
    { const int ch = tid & 63, seg = tid >> 6; float run = 0.f;
#pragma unroll
      for (int t = 8 * seg; t < 8 * seg + 8; ++t) { run += F[t * 65 + ch]; F[t * 65 + ch] = run; }
      SEG[seg * 64 + ch] = run; }
    __syncthreads();
    { const int ch = tid & 63, seg = tid >> 6; float off = 0.f;
#pragma unroll
      for (int s2 = 0; s2 < 7; ++s2) { const float v = SEG[s2 * 64 + ch]; if (s2 < seg) off += v; }
#pragma unroll
      for (int t = 8 * seg; t < 8 * seg + 8; ++t) F[t * 65 + ch] += off; }
    __syncthreads();
}
template <bool RET> __device__ __forceinline__ void la_load_vt(LAS unsigned char* lds, const bf16* vsrc  , int ld, int tid) {
    typedef LA<RET> L; LAS bf16* Vt = (LAS bf16*)(lds + L::O_VT); const int tl = tid / L::TPT, v0 = (tid % L::TPT) * L::VPT;
#pragma unroll
    for (int s = 0; s < L::VPT / 8; ++s) { float v[8]; ld8(vsrc + (size_t)tl * ld + v0 + 8 * s, v);
#pragma unroll
        for (int i = 0; i < 8; ++i) Vt[(v0 + 8 * s + i) * L::LT + tl] = (bf16)f2bf(v[i]); }
}
__device__ __forceinline__ void rot_cs(int pos_i, int part, float* cs, float* sn) {
    const float pos = (float)pos_i;
#pragma unroll
    for (int i = 0; i < 16; ++i) { const float invr = __builtin_amdgcn_exp2f(-(float)(16 * part + i) * (13.287712379549449f / 64.0f)) * 0.15915494309189535f;
        const float hi = __uint_as_float(__float_as_uint(invr) & 0xfffff000u), lo = invr - hi;
        const float rev = __builtin_amdgcn_fractf(pos * hi) + pos * lo;
        sn[i] = __builtin_amdgcn_sinf(rev); cs[i] = __builtin_amdgcn_cosf(rev); }
}
__device__ __forceinline__ void ret_rot16(const bf16* src, const float* cs, const float* sn, int part, float* o1, float* o2) {
    float x1[16], x2[16]; ld8(src + 16 * part, x1); ld8(src + 16 * part + 8, x1 + 8); ld8(src + 64 + 16 * part, x2); ld8(src + 64 + 16 * part + 8, x2 + 8);
#pragma unroll
    for (int i = 0; i < 16; ++i) { o1[i] = x1[i] * cs[i] - x2[i] * sn[i]; o2[i] = x2[i] * cs[i] + x1[i] * sn[i]; }
}

template <bool RET> __device__ __forceinline__ void la_local_item(PRef p, LAS unsigned char* lds, int item, int tid, int wave, int lane) {
    typedef LA<RET> L; const int c = item % L::NCH, h = (item / L::NCH) & 3, b = item / (L::NCH * 4), t0 = b * SEQ + L::C * c;
    const bf16* proj = (const bf16*)(p.ws + WS_PROJ); LAS bf16* Kt = (LAS bf16*)(lds + L::O_KT); LAS bf16* Vt = (LAS bf16*)(lds + L::O_VT);
    bf16* state = RET ? (bf16*)(p.ws + WS_HB) : (bf16*)(p.ws + WS_GST);
    if (!RET) {
        la_load_vt<false>(lds, proj + (size_t)t0 * NP0 + 1536 + 128 * h, NP0, tid);
        const int tl = tid >> 3, c8 = (tid & 7) * 8; const v4u kraw = *(const v4u*)(proj + (size_t)(t0 + tl) * NP0 + 1280 + 64 * h + c8);
        gla_cum(p, lds, proj, t0, h, tid);
        LAS float* F = (LAS float*)(lds + L::O_F); float kv[8]; unpack8(kraw, kv);
#pragma unroll
        for (int i = 0; i < 8; ++i) { const float ge = F[63 * 65 + c8 + i], gt = F[tl * 65 + c8 + i]; Kt[(c8 + i) * L::LT + tl] = (bf16)f2bf(kv[i] * __expf(ge - gt));
            if (tl == 63) ((float*)(p.ws + WS_GDEC))[item * 64 + c8 + i] = __expf(ge); }
    } else {
        la_load_vt<true>(lds, proj + (size_t)t0 * NP1 + 1024 + 128 * h, NP1, tid);
        const int tl = tid >> 2, part = tid & 3; float cs[16], sn[16]; rot_cs(((const int*)p.in[2])[t0 + tl], part, cs, sn); const float lg = log1pf(-exp2f(-5.0f - (float)h));
        float k1[16], k2[16]; ret_rot16(proj + (size_t)(t0 + tl) * NP1 + 512 + 128 * h, cs, sn, part, k1, k2); const float f = __expf((float)(127 - tl) * lg);
#pragma unroll
        for (int i = 0; i < 16; ++i) { Kt[(16 * part + i) * L::LT + tl] = (bf16)f2bf(k1[i] * f); Kt[(64 + 16 * part + i) * L::LT + tl] = (bf16)f2bf(k2[i] * f); }
    }
    __syncthreads();
    { const int q = lane >> 4; bf16* dst = state + (size_t)item * 128 * L::DK;
      for (int kt = 0; kt < L::DK / 16; ++kt) { f32x4 acc = {0.f, 0.f, 0.f, 0.f}; acc = mma_ll(Vt + 16 * wave * L::LT, L::LT, Kt + 16 * kt * L::LT, L::LT, L::C, acc, lane);
#pragma unroll
          for (int j = 0; j < 4; ++j) dst[(16 * wave + 4 * q + j) * L::DK + 16 * kt + (lane & 15)] = (bf16)f2bf(acc[j]); } }
    __syncthreads();
}
template <bool RET> __device__ __forceinline__ void la_prefix(PRef p, int gtid, int NGT) {
    typedef LA<RET> L; constexpr int NP = 128 * L::DK / 2; unsigned* state = RET ? (unsigned*)(p.ws + WS_HB) : (unsigned*)(p.ws + WS_GST); const float* dec = (const float*)(p.ws + WS_GDEC);
    for (int it = gtid; it < 32 * NP; it += NGT) { const int bh = it / NP, pe = it % NP, k = (2 * pe) % L::DK; float s0 = 0.f, s1 = 0.f;
        unsigned w[L::NCH]; float d0[L::NCH], d1[L::NCH];
        float dr = 0.f; if (RET) { const float lg = log1pf(-exp2f(-5.0f - (float)(bh & 3))); dr = __expf(128.0f * lg); }
#pragma unroll
        for (int c = 0; c < L::NCH; ++c) { w[c] = state[(size_t)(bh * L::NCH + c) * NP + pe];
            if (RET) { d0[c] = dr; d1[c] = dr; } else { d0[c] = dec[(bh * L::NCH + c) * 64 + k]; d1[c] = dec[(bh * L::NCH + c) * 64 + k + 1]; } }
#pragma unroll
        for (int c = 0; c < L::NCH; ++c) { state[(size_t)(bh * L::NCH + c) * NP + pe] = pk2(s0, s1);
            s0 = s0 * d0[c] + __uint_as_float(w[c] << 16); s1 = s1 * d1[c] + __uint_as_float(w[c] & 0xffff0000u); } }
}
template <bool RET> __device__ __forceinline__ void la_out_item(PRef p, LAS unsigned char* lds, int item, int tid, int wave, int lane) {
    typedef LA<RET> L; const int c = item % L::NCH, h = (item / L::NCH) & 3, b = item / (L::NCH * 4), t0 = b * SEQ + L::C * c;
    bf16* proj = (bf16*)(p.ws + WS_PROJ); LAS bf16* Qs = (LAS bf16*)(lds + L::O_QS); LAS bf16* Ks = (LAS bf16*)(lds + L::O_KS); LAS bf16* Vt = (LAS bf16*)(lds + L::O_VT); LAS bf16* Sc = (LAS bf16*)(lds + L::O_SC);
    LAS float* Of = (LAS float*)(lds + L::O_OF);
    const bf16* state = (RET ? (const bf16*)(p.ws + WS_HB) : (const bf16*)(p.ws + WS_GST)) + (size_t)item * 128 * L::DK;
    float inter_scale = 1.0f;
    const int ptl = tid / L::TPT, pv0 = (tid % L::TPT) * L::VPT;
    const bf16* gsrc0 = RET ? proj + (size_t)(t0 + ptl) * NP1 + 1536 + 128 * h + pv0 : proj + (size_t)(t0 + ptl) * NP0 + 2048 + 128 * h + pv0;
    const float* gn0 = (RET ? p.in[16] : p.in[13]) + 128 * h + pv0;
    v4u graw[L::VPT / 8]; f32x4 gnr[L::VPT / 4];
#pragma unroll
    for (int s8 = 0; s8 < L::VPT / 8; ++s8) graw[s8] = *(const v4u*)(gsrc0 + 8 * s8);
#pragma unroll
    for (int s4 = 0; s4 < L::VPT / 4; ++s4) gnr[s4] = *(const f32x4*)(gn0 + 4 * s4);
    if (!RET) {
        la_load_vt<false>(lds, proj + (size_t)t0 * NP0 + 1536 + 128 * h, NP0, tid);
        const int tl = tid >> 3, c8 = (tid & 7) * 8; const v4u qraw = *(const v4u*)(proj + (size_t)(t0 + tl) * NP0 + 1024 + 64 * h + c8), kraw = *(const v4u*)(proj + (size_t)(t0 + tl) * NP0 + 1280 + 64 * h + c8);
        gla_cum(p, lds, proj, t0, h, tid);
        LAS float* F = (LAS float*)(lds + L::O_F); float qv[8], kv[8], qo[8], ko[8]; unpack8(qraw, qv); unpack8(kraw, kv);
#pragma unroll
        for (int i = 0; i < 8; ++i) { const float gt = F[tl * 65 + c8 + i]; qo[i] = qv[i] * 0.125f * __expf(gt); ko[i] = kv[i] * __expf(-gt); }
        *(LAS v4u*)(Qs + tl * L::LQ + c8) = pack8(qo); *(LAS v4u*)(Ks + tl * L::LQ + c8) = pack8(ko);
    } else {
        la_load_vt<true>(lds, proj + (size_t)t0 * NP1 + 1024 + 128 * h, NP1, tid);
        const int tl = tid >> 2, part = tid & 3; float cs[16], sn[16]; rot_cs(((const int*)p.in[2])[t0 + tl], part, cs, sn); const float lg = log1pf(-exp2f(-5.0f - (float)h)); inter_scale = __expf(lg);
        float a1[16], a2[16];
        ret_rot16(proj + (size_t)(t0 + tl) * NP1 + 128 * h, cs, sn, part, a1, a2); const float fq_ = 0.08838834764831845f * __expf((float)tl * lg);
#pragma unroll
        for (int i = 0; i < 16; ++i) { a1[i] *= fq_; a2[i] *= fq_; }
        *(LAS v4u*)(Qs + tl * L::LQ + 16 * part) = pack8(a1); *(LAS v4u*)(Qs + tl * L::LQ + 16 * part + 8) = pack8(a1 + 8);
        *(LAS v4u*)(Qs + tl * L::LQ + 64 + 16 * part) = pack8(a2); *(LAS v4u*)(Qs + tl * L::LQ + 64 + 16 * part + 8) = pack8(a2 + 8);
        ret_rot16(proj + (size_t)(t0 + tl) * NP1 + 512 + 128 * h, cs, sn, part, a1, a2); const float fk_ = __expf(-(float)tl * lg);
#pragma unroll
        for (int i = 0; i < 16; ++i) { a1[i] *= fk_; a2[i] *= fk_; }
        *(LAS v4u*)(Ks + tl * L::LQ + 16 * part) = pack8(a1); *(LAS v4u*)(Ks + tl * L::LQ + 16 * part + 8) = pack8(a1 + 8);
        *(LAS v4u*)(Ks + tl * L::LQ + 64 + 16 * part) = pack8(a2); *(LAS v4u*)(Ks + tl * L::LQ + 64 + 16 * part + 8) = pack8(a2 + 8);
    }
    bf16x8 sf[4][2];
    if (!RET) {
#pragma unroll
        for (int vi = 0; vi < 4; ++vi)
#pragma unroll
            for (int ks = 0; ks < 2; ++ks) sf[vi][ks] = *(const bf16x8*)(state + (size_t)(16 * (4 * (wave >> 2) + vi) + (lane & 15)) * 64 + 8 * (lane >> 4) + 32 * ks);
    }
    __syncthreads();
    const int q = lane >> 4; constexpr int RT = L::C / 16;
    if (!RET) { const int rt = wave & 3;
#pragma unroll
        for (int cc = 0; cc < 2; ++cc) { const int ct = 2 * (wave >> 2) + cc; f32x4 acc = {0.f, 0.f, 0.f, 0.f};
            if (ct <= rt) acc = mma_ll(Qs + 16 * rt * L::LQ, L::LQ, Ks + 16 * ct * L::LQ, L::LQ, L::DK, acc, lane);
#pragma unroll
            for (int j = 0; j < 4; ++j) { const int it_ = 16 * rt + 4 * q + j, jt = 16 * ct + (lane & 15); Sc[it_ * L::LT + jt] = (bf16)f2bf(jt <= it_ ? acc[j] : 0.f); } }
    } else { const int rt = wave;
        for (int ct = 0; ct < RT; ++ct) { f32x4 acc = {0.f, 0.f, 0.f, 0.f};
            if (ct <= rt) acc = mma_ll(Qs + 16 * rt * L::LQ, L::LQ, Ks + 16 * ct * L::LQ, L::LQ, L::DK, acc, lane);
#pragma unroll
            for (int j = 0; j < 4; ++j) { const int it_ = 16 * rt + 4 * q + j, jt = 16 * ct + (lane & 15); Sc[it_ * L::LT + jt] = (bf16)f2bf(jt <= it_ ? acc[j] : 0.f); } }
    }
    __syncthreads();
    f32x4 oacc[RET ? 8 : 4];
    { const int rt = RET ? wave : (wave & 3), vt0 = RET ? 0 : 4 * (wave >> 2); constexpr int NV = RET ? 8 : 4;
#pragma unroll
      for (int vi = 0; vi < NV; ++vi) { const int vt = vt0 + vi; f32x4 a1 = {0.f, 0.f, 0.f, 0.f}, a2 = {0.f, 0.f, 0.f, 0.f};
          a1 = mma_ll(Sc + 16 * rt * L::LT, L::LT, Vt + 16 * vt * L::LT, L::LT, L::C, a1, lane);
          if (RET) a2 = mma_lg(Qs + 16 * rt * L::LQ, L::LQ, state + (size_t)16 * vt * L::DK, L::DK, L::DK, a2, lane);
          else { const LAS bf16* xp = Qs + (16 * rt + (lane & 15)) * L::LQ + 8 * (lane >> 4);
              a2 = __builtin_amdgcn_mfma_f32_16x16x32_bf16(*(const LAS bf16x8*)xp, sf[vi & 3][0], a2, 0, 0, 0); a2 = __builtin_amdgcn_mfma_f32_16x16x32_bf16(*(const LAS bf16x8*)(xp + 32), sf[vi & 3][1], a2, 0, 0, 0); }
          oacc[vi] = a1 + a2 * inter_scale; }
      if (RET) __syncthreads();
#pragma unroll
      for (int vi = 0; vi < NV; ++vi) { const int vt = vt0 + vi;
#pragma unroll
          for (int j = 0; j < 4; ++j) Of[(16 * rt + 4 * q + j) * 133 + 16 * vt + (lane & 15)] = oacc[vi][j]; } }
    __syncthreads();
    { const int tl = tid / L::TPT, v0 = (tid % L::TPT) * L::VPT; float s = 0.f, s2 = 0.f;
#pragma unroll
      for (int i = 0; i < L::VPT; ++i) { const float o = Of[tl * 133 + v0 + i]; s += o; s2 += o * o; }
#pragma unroll
      for (int m = 1; m < L::TPT; m <<= 1) { s += __shfl_xor(s, m); s2 += __shfl_xor(s2, m); }
      float mean = 0.f, var = s2 * (1.0f / 128.0f);
      if (RET) { mean = s * (1.0f / 128.0f); var = fmaxf(var - mean * mean, 0.f); }
      const float rstd = __builtin_amdgcn_rsqf(var + 1e-5f);
      const bf16* gsrc = RET ? proj + (size_t)(t0 + tl) * NP1 + 1536 + 128 * h + v0 : proj + (size_t)(t0 + tl) * NP0 + 2048 + 128 * h + v0;
      const float* gn = (RET ? p.in[16] : p.in[13]) + 128 * h + v0;
      bf16* dst = RET ? proj + (size_t)(t0 + tl) * NP1 + 128 * h + v0 : (bf16*)(p.ws + WS_Y) + (size_t)(t0 + tl) * 1024 + 512 + 128 * h + v0;
#pragma unroll
      for (int s8 = 0; s8 < L::VPT / 8; ++s8) { float gv[8], o[8]; unpack8(graw[s8], gv); const float gg[8] = {gnr[2 * s8][0], gnr[2 * s8][1], gnr[2 * s8][2], gnr[2 * s8][3], gnr[2 * s8 + 1][0], gnr[2 * s8 + 1][1], gnr[2 * s8 + 1][2], gnr[2 * s8 + 1][3]};
#pragma unroll
          for (int i = 0; i < 8; ++i) { const float x = (Of[tl * 133 + v0 + 8 * s8 + i] - mean) * rstd * gg[i]; o[i] = x * (gv[i] * sigmf(gv[i])); }
          *(v4u*)(dst + 8 * s8) = pack8(o); } }
    __syncthreads();
}

__device__ __forceinline__ void rwkv_prep(PRef p, int gtid, int NGT) {
    const bf16* proj = (const bf16*)(p.ws + WS_PROJ); bf16* alr = (bf16*)(p.ws + WS_ALR); const float* mu = p.in[17];
    for (int it = gtid; it < T * 32; it += NGT) { const int row = it >> 5, c8 = (it & 31) * 8, col = 1536 + c8; float cur[8], prv[8], o[8];
        ld8(proj + (size_t)row * NP1 + 2048 + col, cur);
        if ((row & 2047) != 0) ld8(proj + (size_t)(row - 1) * NP1 + 2048 + col, prv); else {
#pragma unroll
            for (int i = 0; i < 8; ++i) prv[i] = 0.f; }
        float mv[8]; ldf8(mu + col, mv);
#pragma unroll
        for (int i = 0; i < 8; ++i) { const float d = cur[i] + mv[i] * (prv[i] - cur[i]); o[i] = c8 < 64 ? tanh_fast(d) : (c8 < 128 ? d : sigmf(d)); }
        *(v4u*)(alr + (size_t)row * 256 + c8) = pack8(o); }
}
__device__ __forceinline__ float row_sum16(float x) {
    x += __int_as_float(__builtin_amdgcn_update_dpp(0, __float_as_int(x), 0x128, 0xf, 0xf, false));
    x += __int_as_float(__builtin_amdgcn_update_dpp(0, __float_as_int(x), 0x124, 0xf, 0xf, false));
    x += __int_as_float(__builtin_amdgcn_update_dpp(0, __float_as_int(x), 0x122, 0xf, 0xf, false));
    x += __int_as_float(__builtin_amdgcn_update_dpp(0, __float_as_int(x), 0x121, 0xf, 0xf, false));
    return x;
}
constexpr int SC_STR = 344, SC_STEPS = 32;
__device__ __forceinline__ void rwkv_stage(PRef p, LAS float* buf, int b, int h, int part, int ch, int pt,
                                           const float* mur, const float* muk, const float* muv, const float* kkp, const float* kap, const float* rkp, const float* w0p, const float* a0p) {
    const bf16* proj = (const bf16*)(p.ws + WS_PROJ); const bf16* wag = (const bf16*)(p.ws + WS_Y);
    const int tl = pt >> 3, kc = pt & 7, t = SC_STEPS * ch + tl, row = b * SEQ + t, c0 = 64 * h + 8 * kc;
    float r[8], k[8], v[8], pr[8], pk[8], pv[8], e[8], a[8];
    ld8(proj + (size_t)row * NP1 + 2048 + c0, r); ld8(proj + (size_t)row * NP1 + 2560 + c0, k); ld8(proj + (size_t)row * NP1 + 3072 + c0, v);
    if (t > 0) { ld8(proj + (size_t)(row - 1) * NP1 + 2048 + c0, pr); ld8(proj + (size_t)(row - 1) * NP1 + 2560 + c0, pk); ld8(proj + (size_t)(row - 1) * NP1 + 3072 + c0, pv); }
    else {
#pragma unroll
        for (int i = 0; i < 8; ++i) { pr[i] = 0.f; pk[i] = 0.f; pv[i] = 0.f; } }
    ld8(wag + (size_t)row * 1536 + c0, e); ld8(wag + (size_t)row * 1536 + 512 + c0, a);
    float kkr[8], ss = 0.f;
#pragma unroll
    for (int i = 0; i < 8; ++i) { r[i] += mur[i] * (pr[i] - r[i]); k[i] += muk[i] * (pk[i] - k[i]); v[i] += muv[i] * (pv[i] - v[i]); kkr[i] = k[i] * kkp[i]; ss += kkr[i] * kkr[i]; }
    ss += __shfl_xor(ss, 1); ss += __shfl_xor(ss, 2); ss += __shfl_xor(ss, 4);
    const float rn = __builtin_amdgcn_rsqf(ss + 1e-12f);
    LAS float* base = buf + tl * SC_STR; float br = 0.f, kr = 0.f, rkr = 0.f;
    f32x4 o0[2], o1[2], o2[2], o3[2], o4[2];
#pragma unroll
    for (int i = 0; i < 8; ++i) { const float kk = kkr[i] * rn, w = __expf(-e[i]), km = k[i] * (1.0f + (a[i] - 1.0f) * kap[i]), bb = kk * a[i];
        o0[i >> 2][i & 3] = -kk; o1[i >> 2][i & 3] = w * r[i]; o2[i >> 2][i & 3] = w; o3[i >> 2][i & 3] = bb; o4[i >> 2][i & 3] = km;
        br += bb * r[i]; kr += km * r[i]; rkr += r[i] * km * rkp[i]; }
#pragma unroll
    for (int s = 0; s < 2; ++s) { *(LAS f32x4*)(base + 16 * kc + 8 * s) = (f32x4){o0[s][0], o1[s][0], o0[s][1], o1[s][1]}; *(LAS f32x4*)(base + 16 * kc + 8 * s + 4) = (f32x4){o0[s][2], o1[s][2], o0[s][3], o1[s][3]}; *(LAS f32x4*)(base + 128 + 8 * kc + 4 * s) = o2[s];
        *(LAS f32x4*)(base + 192 + 8 * kc + 4 * s) = o3[s]; *(LAS f32x4*)(base + 256 + 8 * kc + 4 * s) = o4[s]; }
    if ((kc >> 1) == part) {
#pragma unroll
        for (int i = 0; i < 8; ++i) base[320 + (kc & 1) * 8 + i] = v[i]; }
#pragma unroll
    for (int m = 1; m < 8; m <<= 1) { br += __shfl_xor(br, m); kr += __shfl_xor(kr, m); rkr += __shfl_xor(rkr, m); }
    if (kc == 0) { base[336] = br; base[337] = kr; if (part == 0) ((float*)(p.ws + WS_RKR))[(size_t)(b * 8 + h) * SEQ + t] = rkr; }
}
__device__ __forceinline__ void rwkv_scan_item(PRef p, LAS unsigned char* lds, int item, int tid, int wave, int lane, bool do_cvt) {
    const int part = item & 3, h = (item >> 2) & 7, b = item >> 5;
    LAS float* buf = (LAS float*)lds; LAS float* ybuf = (LAS float*)(lds + 2 * SC_STEPS * SC_STR * 4);
    bf16* yraw = (bf16*)(p.ws + WS_HB) + (size_t)T * 512;
    constexpr int NCHK = SEQ / SC_STEPS;
    if (wave >= 4) {
        const int pt = tid - 256, kc = pt & 7, c0 = 64 * h + 8 * kc; float mur[8], muk[8], muv[8], kkp[8], kap[8], rkp[8], w0p[8], a0p[8];
#pragma unroll
        for (int i = 0; i < 8; ++i) { mur[i] = p.in[17][c0 + i]; muk[i] = p.in[17][512 + c0 + i]; muv[i] = p.in[17][1024 + c0 + i]; kkp[i] = p.in[23][c0 + i]; kap[i] = p.in[24][c0 + i]; rkp[i] = p.in[25][c0 + i]; w0p[i] = p.in[18][c0 + i]; a0p[i] = p.in[20][c0 + i]; }
        rwkv_stage(p, buf, b, h, part, 0, pt, mur, muk, muv, kkp, kap, rkp, w0p, a0p);
        LAS float* scr = (LAS float*)(lds + 2 * SC_STEPS * SC_STR * 4 + 8192 + (wave - 4) * 8704);
        f32x4 creg[8];
#pragma unroll
        for (int i = 0; i < 8; ++i) creg[i] = (f32x4){0.f, 0.f, 0.f, 0.f};
        for (int ch = 0; ch < NCHK; ++ch) { __syncthreads(); if (ch + 1 < NCHK) rwkv_stage(p, buf + ((ch + 1) & 1) * SC_STEPS * SC_STR, b, h, part, ch + 1, pt, mur, muk, muv, kkp, kap, rkp, w0p, a0p);
#ifndef NO_SCAN_CVT
            if (do_cvt) { const int idx = (int)blockIdx.x * 4 + (wave - 4) + (ch >> 3) * ((int)gridDim.x * 4);
                if ((ch & 7) == 0) { if (idx < CVT1_ITEMS) cvt1_load(p, idx, lane, creg); } else if ((ch & 7) == 1) { if (idx < CVT1_ITEMS) cvt1_store(p, idx, scr, lane, creg); } }
#endif
        }
    } else {
        const int vl = lane >> 4, kg = lane & 15; f32x4 S = {0.f, 0.f, 0.f, 0.f}; LAS float* yb = ybuf + wave * 512;
        bf16* yp = yraw + (size_t)(item * SEQ) * 16;
        for (int ch = 0; ch < NCHK; ++ch) { __syncthreads(); const LAS float* cb = buf + (ch & 1) * SC_STEPS * SC_STR;
            typedef float f32x2 __attribute__((ext_vector_type(2)));
            const LAS float* b0 = cb;
            f32x4 c_nw0 = *(const LAS f32x4*)(b0 + 8 * kg), c_nw1 = *(const LAS f32x4*)(b0 + 8 * kg + 4), c_w = *(const LAS f32x4*)(b0 + 128 + 4 * kg),
                  c_bb = *(const LAS f32x4*)(b0 + 192 + 4 * kg), c_kk = *(const LAS f32x4*)(b0 + 256 + 4 * kg);
            float c_vv = b0[320 + 4 * wave + vl], c_br = b0[336], c_kr = b0[337];
#pragma unroll
            for (int s = 0; s < SC_STEPS; ++s) { const LAS float* base = cb + (s + 1 < SC_STEPS ? s + 1 : s) * SC_STR;
                const f32x4 n_nw0 = *(const LAS f32x4*)(base + 8 * kg), n_nw1 = *(const LAS f32x4*)(base + 8 * kg + 4), n_w = *(const LAS f32x4*)(base + 128 + 4 * kg),
                            n_bb = *(const LAS f32x4*)(base + 192 + 4 * kg), n_kk = *(const LAS f32x4*)(base + 256 + 4 * kg);
                const float n_vv = base[320 + 4 * wave + vl], n_br = base[336], n_kr = base[337];
                const f32x4 tS = S * c_w + c_kk * c_vv;
                f32x2 dd = (f32x2){S[0], S[0]} * (f32x2){c_nw0[0], c_nw0[1]};
                dd = (f32x2){S[1], S[1]} * (f32x2){c_nw0[2], c_nw0[3]} + dd;
                dd = (f32x2){S[2], S[2]} * (f32x2){c_nw1[0], c_nw1[1]} + dd;
                dd = (f32x2){S[3], S[3]} * (f32x2){c_nw1[2], c_nw1[3]} + dd;
                const float d1 = row_sum16(dd.x);
                S = tS + c_bb * d1;
                float d2 = dd.y;
                d2 += __int_as_float(__builtin_amdgcn_update_dpp(0, __float_as_int(d2), 0x128, 0xf, 0xf, false));
                d2 += __int_as_float(__builtin_amdgcn_update_dpp(0, __float_as_int(d2), 0x124, 0xf, 0xf, false));
                yb[(s * 4 + vl) * 4 + (kg & 3)] = d2 + 0.25f * (d1 * c_br + c_vv * c_kr);
                c_nw0 = n_nw0; c_nw1 = n_nw1; c_w = n_w; c_bb = n_bb; c_kk = n_kk; c_vv = n_vv; c_br = n_br; c_kr = n_kr; }
            { const int s = lane >> 1, pr = lane & 1; const f32x4 q0 = *(const LAS f32x4*)(yb + (s * 4 + 2 * pr) * 4), q1 = *(const LAS f32x4*)(yb + (s * 4 + 2 * pr + 1) * 4); const float y0 = (q0[0] + q0[1]) + (q0[2] + q0[3]), y1 = (q1[0] + q1[1]) + (q1[2] + q1[3]);
              *(unsigned*)(yp + (size_t)(SC_STEPS * ch + s) * 16 + 4 * wave + 2 * pr) = pk2(y0, y1); } }
    }
    __syncthreads();
}
__device__ __forceinline__ void rwkv_post(PRef p, int gtid, int NGT) {
    bf16* proj = (bf16*)(p.ws + WS_PROJ); const bf16* wag = (const bf16*)(p.ws + WS_Y); const bf16* yraw = (const bf16*)(p.ws + WS_HB) + (size_t)T * 512; const float* rkr = (const float*)(p.ws + WS_RKR);
    for (int it = gtid; it < T * 64; it += NGT) { const int row = it >> 6, h = (it >> 3) & 7, c0 = 64 * h + 8 * (it & 7); float y[8], v[8], pv[8], g[8], o[8];
        { const int b_ = row >> 11, t_ = row & 2047, j_ = it & 7; ld8(yraw + ((size_t)(((b_ * 8 + h) * 4 + (j_ >> 1)) * SEQ + t_)) * 16 + (j_ & 1) * 8, y); } float s = 0.f;
#pragma unroll
        for (int i = 0; i < 8; ++i) s += y[i];
        s += __shfl_xor(s, 1); s += __shfl_xor(s, 2); s += __shfl_xor(s, 4); const float mean = s * (1.0f / 64.0f); float s2 = 0.f;
#pragma unroll
        for (int i = 0; i < 8; ++i) { y[i] -= mean; s2 += y[i] * y[i]; }
        s2 += __shfl_xor(s2, 1); s2 += __shfl_xor(s2, 2); s2 += __shfl_xor(s2, 4); const float rstd = __builtin_amdgcn_rsqf(s2 * (1.0f / 64.0f) + 64e-5f);
        ld8(proj + (size_t)row * NP1 + 3072 + c0, v);
        if ((row & 2047) != 0) ld8(proj + (size_t)(row - 1) * NP1 + 3072 + c0, pv); else {
#pragma unroll
            for (int i = 0; i < 8; ++i) pv[i] = 0.f; }
        ld8(wag + (size_t)row * 1536 + 1024 + c0, g); const float rk = rkr[(size_t)((row >> 11) * 8 + h) * SEQ + (row & 2047)];
        float mv[8], ng[8]; ldf8(p.in[17] + 1024 + c0, mv); ldf8(p.in[26] + c0, ng);
#pragma unroll
        for (int i = 0; i < 8; ++i) { const float vs = v[i] + mv[i] * (pv[i] - v[i]); o[i] = (y[i] * rstd * ng[i] + rk * vs) * g[i]; }
#ifdef SANITIZE
#pragma unroll
        for (int i = 0; i < 8; ++i) if (!(fabsf(o[i]) < 1e30f)) o[i] = 0.f;
#endif
        *(v4u*)(proj + (size_t)row * NP1 + 512 + c0) = pack8(o); }
}
__device__ __forceinline__ void final_norm(PRef p, int gw, int NGW, int lane) {
    const float* part = pg8::rpart(p.ws, 6); const float* g = p.in[37]; const bf16* hf = (const bf16*)(p.ws + 107 * MiB);
    f32x4 gv[4];
#pragma unroll
    for (int j = 0; j < 4; ++j) gv[j] = *((const f32x4*)g + lane + 64 * j);
    int m = gw; if (m >= T) return;
    v2u cur[4]; float rs = pg8::rs16(part, m);
#pragma unroll
    for (int j = 0; j < 4; ++j) cur[j] = *((const v2u*)(hf + (size_t)m * 1024) + lane + 64 * j);
    for (;;) { const int nx = m + NGW; const bool more = nx < T; v2u nxt[4]; float nrs = rs;
#pragma unroll
        for (int j = 0; j < 4; ++j) nxt[j] = cur[j];
        if (more) { nrs = pg8::rs16(part, nx);
#pragma unroll
            for (int j = 0; j < 4; ++j) nxt[j] = *((const v2u*)(hf + (size_t)nx * 1024) + lane + 64 * j); }
        f32x4* xr = (f32x4*)(p.out + (size_t)m * 1024) + lane;
#pragma unroll
        for (int j = 0; j < 4; ++j) { const v2u hw = cur[j]; f32x4 v = {__uint_as_float(hw.x << 16), __uint_as_float(hw.x & 0xffff0000u), __uint_as_float(hw.y << 16), __uint_as_float(hw.y & 0xffff0000u)}; v = v * rs * gv[j]; xr[64 * j] = v; }
        if (!more) break; m = nx; rs = nrs;
#pragma unroll
        for (int j = 0; j < 4; ++j) cur[j] = nxt[j]; }
}

#define TID (fresh_tid())
#define LANE (TID & 63)
#define WAVE (__builtin_amdgcn_readfirstlane(TID >> 6))
#define GRD (fresh_s((int)gridDim.x))
#define BID (fresh_s((int)blockIdx.x))
#define GW (BID * NWAVES + WAVE)
#define NGW_ (GRD * NWAVES)
#define GTID (BID * NTHREADS + TID)
#define NGT_ (GRD * NTHREADS)
#define GSYNC_CG() cg::this_grid().sync()
#define GSYNC() do { XcdBarrier xb_; xb_.bar = (unsigned*)(FP.ws + WS_XBAR); xb_.x = xb_xcc_id(); xb_.st = (volatile LAS unsigned*)(lds + LDS_XST); xcd_barrier(xb_); } while (0)
#define WSP(off) (FP.ws + (off))
#define ROWSS(i) ((float*)WSP(WS_ROWSS) + (size_t)(i) * T)

template <int li> __device__ __forceinline__ void layer_body(LAS unsigned char* lds) {
        { const int N = li == 0 ? NP0 : NP1; pg8::Gemm g{li == 0 ? (const bf16*)WSP(WS_HB) : (const bf16*)FP.out + (size_t)T * 1024, (const bf16*)WSP(W_IN), T, N, 1024, 1024}; pg8::StaticOrder S; S.init(T, N, GRD, BID);
          pg8::EpiScaleBf16 E{0, li};
          pg8::gemm_phase<pg8::EpiScaleBf16, pg8::StaticOrder, true, true>(lds, g, S, E);
#ifdef PROBE_INPROJ2
          pg8::gemm_phase<pg8::EpiScaleBf16, pg8::StaticOrder, true, true>(lds, g, S, E);
#endif
        }
        GSYNC();
#ifndef NO_MIX
        if (li == 0) {
#ifdef NO_MIX0
            { PRef p = FP; tr_job(p.in[15], NP1, 1024, p.in[28] + 1024, (bf16*)(p.ws + W_IN), NP1, 0, lds, GW, NGW_, WAVE, LANE); }
            GSYNC();
#else
            for (int it = BID; it < 256; it += GRD) lru_local_item(FP, lds, it, TID, WAVE, LANE);
#ifdef PROBE_LRU2
            for (int it = BID; it < 256; it += GRD) lru_local_item(FP, lds, it, TID, WAVE, LANE);
#endif
#ifdef PROBE_GLA2
            for (int it = BID; it < 1024; it += GRD) la_local_item<false>(FP, lds, it, TID, WAVE, LANE);
#endif
            for (int it = BID; it < 1024; it += GRD) la_local_item<false>(FP, lds, it, TID, WAVE, LANE);
            { PRef p = FP; tr_job(p.in[15], NP1, 1024, p.in[28] + 1024, (bf16*)(p.ws + W_IN), NP1, 0, lds, GW, NGW_, WAVE, LANE); }
            GSYNC();
            lru_prefix(FP, GTID, NGT_); la_prefix<false>(FP, GTID, NGT_);
            GSYNC();
            for (int it = BID; it < 1024; it += GRD) la_out_item<false>(FP, lds, it, TID, WAVE, LANE);
#ifdef PROBE_GLAOUT2
            for (int it = BID; it < 1024; it += GRD) la_out_item<false>(FP, lds, it, TID, WAVE, LANE);
#endif
#ifdef PROBE_LRUOUT2
            lru_out(FP, GTID, NGT_);
#endif
            lru_out(FP, GTID, NGT_);
            GSYNC();
#endif
        } else {
#ifdef NO_MIX1
            cvt_layer_weights(FP, 1, lds, GW, NGW_, WAVE, LANE);
            cvt_p(FP, 1, GW, NGW_, LANE);
            GSYNC();
#else
#ifndef NO_RET
            for (int it = BID; it < 512; it += GRD) la_local_item<true>(FP, lds, it, TID, WAVE, LANE);
#endif
#ifdef PROBE_RETLOC2
            for (int it = BID; it < 512; it += GRD) la_local_item<true>(FP, lds, it, TID, WAVE, LANE);
#endif
#ifdef PROBE_CVT2
            cvt_layer_weights(FP, 1, lds, GW, NGW_, WAVE, LANE);
#endif
#ifndef NO_RWKV
            rwkv_prep(FP, GTID, NGT_);
#endif
#ifdef NO_SCAN_CVT
            cvt_layer_weights(FP, 1, lds, GW, NGW_, WAVE, LANE);
            cvt_p(FP, 1, GW, NGW_, LANE);
#endif
            GSYNC();
#ifndef NO_RET
            la_prefix<true>(FP, GTID, NGT_);
#endif
#ifndef NO_RWKV
            { PRef p = FP; pg8::Gemm g{(const bf16*)(p.ws + WS_ALR), (const bf16*)(p.ws + W_LR), T, 1024, 128, 256}; pg8::StaticOrder S; S.init(T, 1024, GRD, BID);
              pg8::EpiLowRank E{0};
              pg8::gemm_phase<pg8::EpiLowRank, pg8::StaticOrder, true, true>(lds, g, S, E); }
            { PRef p = FP; pg8::Gemm g{(const bf16*)(p.ws + WS_ALR) + 128, (const bf16*)(p.ws + W_LR) + 1024 * 128, T, 512, 128, 256}; pg8::StaticOrder S; S.init(T, 512, GRD, BID);
              pg8::EpiLowRank E{1024};
              pg8::gemm_phase<pg8::EpiLowRank, pg8::StaticOrder, true, true>(lds, g, S, E); }
#endif
            GSYNC();
#ifndef NO_RET
            for (int it = BID; it < 512; it += GRD) la_out_item<true>(FP, lds, it, TID, WAVE, LANE);
#endif
#if !defined(NO_RWKV) && !defined(NO_SCAN)
            for (int it = BID; it < 256; it += GRD) rwkv_scan_item(FP, lds, it, TID, WAVE, LANE, it < GRD);
#endif
#ifndef NO_SCAN_CVT
            { const int first = 8 * GRD * 4; for (int idx = first + GW; idx < CVT1_ITEMS; idx += NGW_) cvt1_flat(FP, idx, (LAS float*)(lds + WAVE * 8704), LANE); }
#endif
#ifdef PROBE_SCAN2
            for (int it = BID; it < 256; it += GRD) rwkv_scan_item(FP, lds, it, TID, WAVE, LANE, it < GRD);
#endif
            GSYNC();
#ifndef NO_RWKV
            rwkv_post(FP, GTID, NGT_);
#endif
            GSYNC();
#endif
        }
#endif
        { PRef p = FP;
#if defined(NO_MIX) || defined(NO_MIX0)
          pg8::Gemm g{(const bf16*)(p.ws + WS_PROJ), (const bf16*)(p.ws + W_OUT), T, 1024, 1024, li == 0 ? NP0 : NP1};
#elif defined(NO_MIX1)
          pg8::Gemm g{li == 0 ? (const bf16*)(p.ws + WS_Y) : (const bf16*)(p.ws + WS_PROJ) + 2048, (const bf16*)(p.ws + W_OUT), T, 1024, 1024, li == 0 ? 1024 : NP1};
#else
          pg8::Gemm g{li == 0 ? (const bf16*)(p.ws + WS_Y) : (const bf16*)(p.ws + WS_PROJ), (const bf16*)(p.ws + W_OUT), T, 1024, 1024, li == 0 ? 1024 : NP1};
#endif

          pg8::StaticOrder S; S.init(T, 1024, GRD, BID);
          pg8::EpiResid E{0, li};
          pg8::gemm_phase<pg8::EpiResid, pg8::StaticOrder, true, true>(lds, g, S, E); }
        GSYNC();
        { pg8::Gemm g{(const bf16*)FP.out + (size_t)li * T * 1024, (const bf16*)WSP(W_GU), T, 2 * FF, 1024, 1024}; pg8::StaticOrder S; S.init(T, 2 * FF, GRD, BID);
          pg8::EpiSwiGLU E{li};
          pg8::gemm_phase<pg8::EpiSwiGLU, pg8::StaticOrder, true, true>(lds, g, S, E);
#ifdef PROBE_GU2
          pg8::gemm_phase<pg8::EpiSwiGLU, pg8::StaticOrder, true, true>(lds, g, S, E);
#endif
          { const int G_ = GRD, b_ = BID, half = G_ / 2; pg8::Gemm g2{(const bf16*)WSP(WS_PB), (const bf16*)WSP(W_PP), T, 1024, 256, 256}; pg8::StaticOrder S2;
            if (G_ == 256) S2.init(T, 1024, half, b_ >= half ? b_ - half : (1 << 28)); else S2.init(T, 1024, G_, b_);
            pg8::EpiScaleBf16 E2{1, li};
            pg8::gemm_phase<pg8::EpiScaleBf16, pg8::StaticOrder, true, true>(lds, g2, S2, E2); }
        }
        GSYNC();
        { PRef p = FP; pg8::Gemm g{(const bf16*)(p.ws + WS_PROJ), (const bf16*)(p.ws + W_DN), T, 1024, FF, FF}; pg8::StaticOrder S; S.init(T, 1024, GRD, BID);
          pg8::EpiResid E{1, li};
          pg8::gemm_phase<pg8::EpiResid, pg8::StaticOrder, true, true>(lds, g, S, E); }
        GSYNC();
        { PRef p = FP; pg8::Gemm g{(const bf16*)p.out + (size_t)li * T * 1024, (const bf16*)(p.ws + W_PG), T, 1024, 1024, 1024}; pg8::StaticOrder S; S.init(T, 1024, GRD, BID);
          pg8::EpiPLE E{li};
          pg8::gemm_phase<pg8::EpiPLE, pg8::StaticOrder, true, true>(lds, g, S, E);
#ifdef PROBE_PLE2
          pg8::gemm_phase<pg8::EpiPLE, pg8::StaticOrder, true, true>(lds, g, S, E);
#endif
        }
        GSYNC();
    }

__global__ void __launch_bounds__(NTHREADS, 2) trunk_fwd(Params p_unused) {
    extern __shared__ __attribute__((aligned(16))) unsigned char lds_raw[];
    LAS unsigned char* lds = (LAS unsigned char*)lds_raw;
    if (threadIdx.x < 16) ((volatile LAS unsigned*)(lds + LDS_XST))[threadIdx.x] = 0u;
    __syncthreads();
    (void)xcd_barrier_post((unsigned*)(FP.ws + WS_XBAR), (volatile LAS unsigned*)(lds + LDS_XST));
#ifndef NO_PRO
    phase_prologue(FP, lds, GW, NGW_, WAVE, LANE);
#endif
    GSYNC_CG();
#ifdef PROBE_SYNC10
    for (int i_ = 0; i_ < 10; ++i_) GSYNC();
#endif
#ifdef PROBE_PRO2
    phase_prologue(FP, lds, GW, NGW_, WAVE, LANE);
    GSYNC();
#endif
    layer_body<0>(lds);
    layer_body<1>(lds);
    final_norm(FP, GW, NGW_, LANE);
}

extern "C" void kernel_launch(void* const* d_in, const int* in_sizes, int n_in, void* d_out, int out_size, void* d_ws, size_t ws_size, hipStream_t stream) {
    static int grid = 0;
    if (grid == 0) {
        if (n_in != 38 || ws_size < WS_END) { fprintf(stderr, "kernel_launch: unexpected n_in %d / ws %zu\n", n_in, ws_size); grid = -1; return; }
        int dev = 0, cus = 0, per_cu = 0;
        hipGetDevice(&dev); hipDeviceGetAttribute(&cus, hipDeviceAttributeMultiprocessorCount, dev);
        hipFuncSetAttribute((const void*)trunk_fwd, hipFuncAttributeMaxDynamicSharedMemorySize, LDS_BYTES);
        hipOccupancyMaxActiveBlocksPerMultiprocessor(&per_cu, (const void*)trunk_fwd, NTHREADS, LDS_BYTES);
        (void)hipGetLastError();
        if (per_cu < 1) { fprintf(stderr, "kernel_launch: occupancy query reports %d blocks per CU\n", per_cu); per_cu = 1; }
        grid = cus;
    }
    if (grid < 0) return;
    hipMemsetAsync((char*)d_ws + WS_CTL, 0, CTL_ZERO_BYTES, stream);
    Params prm{};
    for (int i = 0; i < 38; ++i) prm.in[i] = (const float*)d_in[i];
    prm.out = (float*)d_out; prm.ws = (unsigned char*)d_ws;
    void* args[] = {&prm};
    hipError_t e = hipLaunchCooperativeKernel((const void*)trunk_fwd, dim3(grid), dim3(NTHREADS), args, LDS_BYTES, stream);
    if (e != hipSuccess) fprintf(stderr, "cooperative launch failed: %s (grid %d)\n", hipGetErrorString(e), grid);
}
```

```cpp
#include <hip/hip_runtime.h>
#include <hip/hip_cooperative_groups.h>
#include <cstdio>
#include <cstdint>
namespace cg = cooperative_groups;
namespace pg8 {
#define PG8_LAS __attribute__((address_space(3)))
typedef unsigned short bf16_t;
typedef short bf16x8 __attribute__((ext_vector_type(8)));
typedef float f32x4 __attribute__((ext_vector_type(4)));
typedef unsigned u32x4 __attribute__((ext_vector_type(4)));
constexpr int BM = 256, BK = 64, HALF = 128, HTB = HALF * BK * 2  , STAGE_BYTES = 8 * HTB, NXCD = 8, WGM = 8;

__host__ __device__ __forceinline__ int lds_byte(int r, int c) { const int st = (r >> 4) * 2 + (c >> 5), rr = r & 15, cc = c & 31, ob = rr * 64 + cc * 2; return st * 1024 + (ob ^ (((ob >> 9) & 1) << 5)); }
__host__ __device__ __forceinline__ void stage_rc(int b, int& R, int& C) { const int st = b / 1024, sb = b % 1024, swz = sb ^ (((sb >> 9) & 1) << 5); R = (st >> 1) * 16 + swz / 64; C = (st & 1) * 32 + (swz % 64) / 2; }
__host__ __device__ __forceinline__ int perm32(int rho) { const int n = rho >> 4, i = rho & 15; return 8 * (i >> 2) + 4 * n + (i & 3); }

struct Unit { int pm, pn; };
struct Gemm { const bf16_t* A; const bf16_t* Bt; int M, N, K, lda; };

struct StaticOrder {
    int nM, nN, nwg, G, c;
    __host__ __device__ void init(int M, int N, int G_, int c_) { nM = M / BM; nN = N / BM; nwg = nM * nN; G = G_; c = c_; }
    __host__ __device__ bool next(int i, Unit& u) const {
        const long L = (long)i * G + c; if (L >= nwg) return false;
        int wgid = (int)L; { const int q = nwg / NXCD, r = nwg % NXCD, xcd = wgid % NXCD, off = wgid / NXCD; wgid = (xcd < r ? xcd * (q + 1) : r * (q + 1) + (xcd - r) * q) + off; }
        const int nig = WGM * nN, gid = wgid / nig, fm = gid * WGM, gsz = (nM - fm) < WGM ? (nM - fm) : WGM;
        u.pm = fm + ((wgid % nig) % gsz); u.pn = (wgid % nig) / gsz; return true;
    }
    __device__ __forceinline__ void a_ready(const Unit&) const {}
    __device__ __forceinline__ void done(const Unit&) const {}
};

typedef float f32x2p_t __attribute__((ext_vector_type(2))); typedef __bf16 bf16x2p_t __attribute__((ext_vector_type(2)));
__device__ __forceinline__ unsigned cvt_pk_bf16(float lo, float hi) { const f32x2p_t v = {lo, hi}; const bf16x2p_t b = __builtin_convertvector(v, bf16x2p_t); return __builtin_bit_cast(unsigned, b); }
typedef float f32x2 __attribute__((ext_vector_type(2)));
__device__ __forceinline__ f32x2 gelu_pk(f32x2 v) {
    const f32x2 av = __builtin_elementwise_abs(v), d = av * 0.2316418882f + 1.0f;
    f32x2 t; t.x = __builtin_amdgcn_rcpf(d.x); t.y = __builtin_amdgcn_rcpf(d.y);
    f32x2 q = t * 0.5307027145f + (-0.7265760135f); q = q * t + 0.7107068705f; q = q * t + (-0.142248368f); q = q * t + 0.127414796f; q = q * t;
    const f32x2 s = (v * v) * (-0.72134752044f);
    f32x2 e; e.x = __builtin_amdgcn_exp2f(s.x); e.y = __builtin_amdgcn_exp2f(s.y);
    const f32x2 m = v * (q * e), r = v - m;
    f32x2 o; o.x = v.x < 0.f ? m.x : r.x; o.y = v.y < 0.f ? m.y : r.y; return o;
}


}
struct Params { const float* in[38]; float* out; unsigned char* ws; };
typedef const __attribute__((address_space(4))) Params& PRef;
__device__ __forceinline__ const __attribute__((address_space(4))) Params* fresh_params() { unsigned long long ki = (unsigned long long)__builtin_amdgcn_kernarg_segment_ptr(); asm volatile("" : "+s"(ki)); return (const __attribute__((address_space(4))) Params*)ki; }
#define FP (*fresh_params())
constexpr size_t EPI_MiB = 1u << 20;
constexpr size_t E_ROWSS = 65536, E_HB = 35 * EPI_MiB, E_PROJ = 67 * EPI_MiB, E_Y = 187 * EPI_MiB, E_HF = 107 * EPI_MiB;
namespace pg8 {

__device__ __forceinline__ float rs_of(const float* rowss, int row) { return rowss ? __builtin_amdgcn_rsqf(rowss[row] * (1.0f / 1024.0f) + 1e-6f) : 1.0f; }
__device__ __forceinline__ float sigm(float x) { return __builtin_amdgcn_rcpf(1.0f + __expf(-x)); }
constexpr size_t E_RPART = 253 * EPI_MiB;
__device__ __forceinline__ float* rpart(unsigned char* ws, int inst) { return (float*)(ws + E_RPART + ((inst & 1) ? 0 : EPI_MiB)); }
__device__ __forceinline__ float rs16(const float* part, int row) { const f32x4* q = (const f32x4*)(part + (size_t)row * 16); const f32x4 a = q[0], b = q[1], c = q[2], d = q[3];
    const float s = (((a[0] + a[1]) + (a[2] + a[3])) + ((b[0] + b[1]) + (b[2] + b[3]))) + (((c[0] + c[1]) + (c[2] + c[3])) + ((d[0] + d[1]) + (d[2] + d[3])));
    return __builtin_amdgcn_rsqf(s * (1.0f / 1024.0f) + 1e-6f); }

struct EpiScaleBf16 {
    static constexpr bool PERM = true, AFTER_DRAIN = false;
    int mode, li;
    __device__ __forceinline__ void operator()(const f32x4 (&acc)[2][2][4][2], const Unit& u, int wr, int wc, int fr, int fq) const {
        unsigned char* ws = FP.ws; bf16_t* O = (bf16_t*)(ws + (mode == 0 ? E_PROJ : E_Y));   const int ldc = mode == 0 ? (li == 0 ? 2816 : 3840) : (mode == 2 ? 1536 : 1024);
        const float* rowss = (mode == 0 && li == 0) ? (const float*)(ws + E_ROWSS) : nullptr; const float* part = rpart(ws, 3); const bool use16 = (mode == 0 && li == 1);
        const int row0 = u.pm * BM + wr * 64 + fr, col0 = u.pn * BM + wc * 32 + 8 * fq;
#pragma unroll
        for (int ai = 0; ai < 2; ++ai)
#pragma unroll
            for (int m = 0; m < 4; ++m) { const int row = row0 + ai * HALF + m * 16; const float rs = use16 ? rs16(part, row) : rs_of(rowss, row); bf16_t* rowp = O + (size_t)row * ldc + col0;
#pragma unroll
                for (int bj = 0; bj < 2; ++bj) { const f32x4 v0 = acc[ai][bj][m][0] * rs, v1 = acc[ai][bj][m][1] * rs;
                    u32x4 w; w.x = cvt_pk_bf16(v0[0], v0[1]); w.y = cvt_pk_bf16(v0[2], v0[3]); w.z = cvt_pk_bf16(v1[0], v1[1]); w.w = cvt_pk_bf16(v1[2], v1[3]);
                    *(u32x4*)(rowp + bj * HALF) = w; } }
    }
};

__device__ __forceinline__ void unpk8(const u32x4 pw, f32x4& p0, f32x4& p1) {
    p0[0] = __uint_as_float(pw.x << 16); p0[1] = __uint_as_float(pw.x & 0xffff0000u); p0[2] = __uint_as_float(pw.y << 16); p0[3] = __uint_as_float(pw.y & 0xffff0000u);
    p1[0] = __uint_as_float(pw.z << 16); p1[1] = __uint_as_float(pw.z & 0xffff0000u); p1[2] = __uint_as_float(pw.w << 16); p1[3] = __uint_as_float(pw.w & 0xffff0000u);
}
struct EpiResid {
    static constexpr bool PERM = true, AFTER_DRAIN = false;
    int which, li;
    __device__ __forceinline__ void operator()(const f32x4 (&acc)[2][2][4][2], const Unit& u, int wr, int wc, int fr, int fq) const {
        PRef p = FP; unsigned char* ws = p.ws; bf16_t* res = (bf16_t*)p.out + (size_t)li * 16384 * 1024; const float* xin = p.in[0]; const bool from_x = (which == 0 && li == 0);
        float* part = rpart(ws, (which == 0 ? 1 : 2) + 3 * li); const int slot = 4 * u.pn + wc;
        const int row0 = u.pm * BM + wr * 64 + fr, col0 = u.pn * BM + wc * 32 + 8 * fq;
#pragma unroll
        for (int ai = 0; ai < 2; ++ai)
#pragma unroll
            for (int m = 0; m < 4; ++m) { const int row = row0 + ai * HALF + m * 16; float ss = 0.f;
#pragma unroll
                for (int bj = 0; bj < 2; ++bj) { const size_t off = (size_t)row * 1024 + col0 + bj * HALF; f32x4 v0, v1;
                    if (from_x) { v0 = *(const f32x4*)(xin + off); v1 = *(const f32x4*)(xin + off + 4); } else unpk8(*(const u32x4*)(res + off), v0, v1);
                    v0 = v0 + acc[ai][bj][m][0]; v1 = v1 + acc[ai][bj][m][1];
                    u32x4 w; w.x = cvt_pk_bf16(v0[0], v0[1]); w.y = cvt_pk_bf16(v0[2], v0[3]); w.z = cvt_pk_bf16(v1[0], v1[1]); w.w = cvt_pk_bf16(v1[2], v1[3]);
                    *(u32x4*)(res + off) = w;
                    ss += (v0[0] * v0[0] + v0[1] * v0[1]) + (v0[2] * v0[2] + v0[3] * v0[3]) + (v1[0] * v1[0] + v1[1] * v1[1]) + (v1[2] * v1[2] + v1[3] * v1[3]); }
                ss += __shfl_xor(ss, 16); ss += __shfl_xor(ss, 32);
                if (fq == 0) part[(size_t)row * 16 + slot] = ss; asm volatile("" ::: "memory"); }
    }
};

struct EpiSwiGLU {
    static constexpr bool PERM = true, AFTER_DRAIN = false;
    int li;
    __device__ __forceinline__ void operator()(const f32x4 (&acc)[2][2][4][2], const Unit& u, int wr, int wc, int fr, int fq) const {
        typedef unsigned u32x2v __attribute__((ext_vector_type(2)));
        unsigned char* ws = FP.ws; bf16_t* O = (bf16_t*)(ws + E_PROJ); const int ldc = 2816; const float* part = rpart(ws, 1 + 3 * li);
        const int row0 = u.pm * BM + wr * 64 + fr, col0 = u.pn * 128 + wc * 16 + 4 * fq;
#pragma unroll
        for (int ai = 0; ai < 2; ++ai)
#pragma unroll
            for (int m = 0; m < 4; ++m) { const int row = row0 + ai * HALF + m * 16; const float rs = rs16(part, row); bf16_t* rowp = O + (size_t)row * ldc + col0;
#pragma unroll
                for (int bj = 0; bj < 2; ++bj) { const f32x4 g = acc[ai][bj][m][0] * rs, up = acc[ai][bj][m][1] * rs; f32x4 o;
#pragma unroll
                    for (int i = 0; i < 4; ++i) o[i] = g[i] * sigm(g[i]) * up[i];
                    u32x2v w; w.x = cvt_pk_bf16(o[0], o[1]); w.y = cvt_pk_bf16(o[2], o[3]);
                    *(u32x2v*)(rowp + bj * 64) = w; } }
    }
};

struct EpiPLE {
    static constexpr bool PERM = true, AFTER_DRAIN = false;
    int li;
    __device__ __forceinline__ void operator()(const f32x4 (&acc)[2][2][4][2], const Unit& u, int wr, int wc, int fr, int fq) const {
        PRef p = FP; unsigned char* ws = p.ws; const bf16_t* rin = (const bf16_t*)p.out + (size_t)li * 16384 * 1024; bf16_t* rout = (bf16_t*)p.out + (size_t)16384 * 1024; bf16_t* hf = (bf16_t*)(ws + E_HF);
        const bf16_t* pp = (const bf16_t*)(ws + E_Y); const float* bias = p.in[35] + li * 1024;
        const float* rs_in = rpart(ws, 2 + 3 * li); float* part = rpart(ws, 3 + 3 * li); const int slot = 4 * u.pn + wc;
        const int row0 = u.pm * BM + wr * 64 + fr, col0 = u.pn * BM + wc * 32 + 8 * fq;
#pragma unroll
        for (int ai = 0; ai < 2; ++ai)
#pragma unroll
            for (int m = 0; m < 4; ++m) { const int row = row0 + ai * HALF + m * 16; const float rs = rs16(rs_in, row); float ss = 0.f;
#pragma unroll
                for (int bj = 0; bj < 2; ++bj) { const size_t off = (size_t)row * 1024 + col0 + bj * HALF;
                    const f32x4 b0 = *(const f32x4*)(bias + col0 + bj * HALF), b1 = *(const f32x4*)(bias + col0 + bj * HALF + 4);
                    f32x4 p0, p1, v0, v1; unpk8(*(const u32x4*)(pp + off), p0, p1); unpk8(*(const u32x4*)(rin + off), v0, v1);
                    const f32x4 g0 = acc[ai][bj][m][0] * rs + b0, g1 = acc[ai][bj][m][1] * rs + b1;
#pragma unroll
                    for (int i = 0; i < 4; ++i) { v0[i] += sigm(g0[i]) * p0[i]; v1[i] += sigm(g1[i]) * p1[i]; }
                    if (li == 0) { u32x4 w; w.x = cvt_pk_bf16(v0[0], v0[1]); w.y = cvt_pk_bf16(v0[2], v0[3]); w.z = cvt_pk_bf16(v1[0], v1[1]); w.w = cvt_pk_bf16(v1[2], v1[3]); *(u32x4*)(rout + off) = w; }
                    else { u32x4 w; w.x = cvt_pk_bf16(v0[0], v0[1]); w.y = cvt_pk_bf16(v0[2], v0[3]); w.z = cvt_pk_bf16(v1[0], v1[1]); w.w = cvt_pk_bf16(v1[2], v1[3]); *(u32x4*)(hf + off) = w; }
                    ss += (v0[0] * v0[0] + v0[1] * v0[1]) + (v0[2] * v0[2] + v0[3] * v0[3]) + (v1[0] * v1[0] + v1[1] * v1[1]) + (v1[2] * v1[2] + v1[3] * v1[3]); }
                ss += __shfl_xor(ss, 16); ss += __shfl_xor(ss, 32);
                if (fq == 0) part[(size_t)row * 16 + slot] = ss; asm volatile("" ::: "memory"); }
    }
};

typedef float f32x2c_t __attribute__((ext_vector_type(2))); typedef __bf16 bf16x2c_t __attribute__((ext_vector_type(2)));
__device__ __forceinline__ unsigned cvt_pk_b(float lo, float hi) { const f32x2c_t v = {lo, hi}; const bf16x2c_t b = __builtin_convertvector(v, bf16x2c_t); return __builtin_bit_cast(unsigned, b); }
struct EpiLowRank {
    static constexpr bool PERM = true, AFTER_DRAIN = false;
    int goff;
    template <int KIND> __device__ __forceinline__ void run(const f32x4 (&acc)[2][2][4][2], const Unit& u, int wr, int wc, int fr, int fq) const {
        PRef p = FP; bf16_t* O = (bf16_t*)(p.ws + E_Y); const float* bsrc = KIND == 0 ? p.in[18] : p.in[20];
        const int row0 = u.pm * BM + wr * 64 + fr, col0 = u.pn * BM + wc * 32 + 8 * fq + goff;
#pragma unroll
        for (int bj = 0; bj < 2; ++bj) { const int col = col0 + bj * HALF; f32x4 b0 = {0.f, 0.f, 0.f, 0.f}, b1 = {0.f, 0.f, 0.f, 0.f};
            if (KIND < 2) { b0 = *(const f32x4*)(bsrc + (col & 511)); b1 = *(const f32x4*)(bsrc + (col & 511) + 4); }
#pragma unroll
            for (int ai = 0; ai < 2; ++ai)
#pragma unroll
                for (int m = 0; m < 4; ++m) { const int row = row0 + ai * HALF + m * 16; f32x4 v0 = acc[ai][bj][m][0] + b0, v1 = acc[ai][bj][m][1] + b1;
#pragma unroll
                    for (int i = 0; i < 4; ++i) {
                        if (KIND == 0) { const float n0 = -v0[i], n1 = -v1[i]; const float s0 = fmaxf(n0, 0.f) + __logf(1.0f + __expf(-fabsf(n0))), s1 = fmaxf(n1, 0.f) + __logf(1.0f + __expf(-fabsf(n1)));
                            v0[i] = __expf(-s0 - 0.5f); v1[i] = __expf(-s1 - 0.5f); }
                        else if (KIND == 1) { v0[i] = sigm(v0[i]); v1[i] = sigm(v1[i]); } }
                    u32x4 w; w.x = cvt_pk_b(v0[0], v0[1]); w.y = cvt_pk_b(v0[2], v0[3]); w.z = cvt_pk_b(v1[0], v1[1]); w.w = cvt_pk_b(v1[2], v1[3]);
                    *(u32x4*)(O + (size_t)row * 1536 + col) = w; } }
    }
    __device__ __forceinline__ void operator()(const f32x4 (&acc)[2][2][4][2], const Unit& u, int wr, int wc, int fr, int fq) const {
        const int kind = goff ? 2 : (u.pn >> 1);
        if (kind == 0) run<0>(acc, u, wr, wc, fr, fq); else if (kind == 1) run<1>(acc, u, wr, wc, fr, fq); else run<2>(acc, u, wr, wc, fr, fq);
    }
};
template <class Epi, class Sched, bool ALIGN_EPI = false, bool SP2 = false>
__device__ __forceinline__ void gemm_phase(PG8_LAS unsigned char* lds, const Gemm g, const Sched& S, const Epi& E) {
    int tid_l = threadIdx.x; asm volatile("" : "+v"(tid_l));
    const int tid = tid_l, wid = __builtin_amdgcn_readfirstlane(tid >> 6), lane = tid & 63, wr = wid >> 2, wc = wid & 3, fr = lane & 15, fq = lane >> 4;
    const int K = g.K, nt = K / BK, lda = g.lda;
    unsigned voffA[2], voffB[2];
#pragma unroll
    for (int i = 0; i < 2; ++i) { int R, C; stage_rc(tid * 16 + i * 8192, R, C); const int Rb = Epi::PERM ? ((R & ~31) + perm32(R & 31)) : R;
        voffA[i] = (unsigned)(R * lda + C) * 2u; voffB[i] = (unsigned)(Rb * K + C) * 2u; }
    const size_t kstep = (size_t)(BK * 2);
    const size_t hstepB = (size_t)HALF * K * 2, hstepA = (size_t)HALF * lda * 2;
    const size_t tstepB = 2 * hstepB, tstepA = 2 * hstepA;
    const unsigned ldsw = (unsigned)wid * 1024u;
    const int aoff = lds_byte(wr * 64 + fr, fq * 8), boff = lds_byte(wc * 32 + fr, fq * 8);
#define PG8_SA(b, h) (((b) * 2 + (h)) * HTB)
#define PG8_SB(b, h) ((4 + (b) * 2 + (h)) * HTB)
#define PG8_STAGE(bufoff, gbase, voff) do { _Pragma("unroll") for (int _i = 0; _i < 2; ++_i) \
        __builtin_amdgcn_global_load_lds((const unsigned*)((const char*)(gbase) + (voff)[_i]), (PG8_LAS unsigned*)(lds + (bufoff) + ldsw + _i * 8192), 16, 0, 0); } while (0)
#define PG8_LDA(dst, b, h) do { _Pragma("unroll") for (int m = 0; m < 4; ++m) _Pragma("unroll") for (int k = 0; k < 2; ++k) dst[m][k] = *(const PG8_LAS bf16x8*)(lds + PG8_SA(b, h) + aoff + m * 2048 + k * 1024); } while (0)
#define PG8_LDB(dst, b, h) do { _Pragma("unroll") for (int n = 0; n < 2; ++n) _Pragma("unroll") for (int k = 0; k < 2; ++k) dst[n][k] = *(const PG8_LAS bf16x8*)(lds + PG8_SB(b, h) + boff + n * 2048 + k * 1024); } while (0)
#define PG8_MMA(ai, bj, At, Bt) do { __builtin_amdgcn_s_setprio(1); _Pragma("unroll") for (int m = 0; m < 4; ++m) _Pragma("unroll") for (int n = 0; n < 2; ++n) _Pragma("unroll") for (int k = 0; k < 2; ++k) \
        acc[ai][bj][m][n] = __builtin_amdgcn_mfma_f32_16x16x32_bf16(Bt[n][k], At[m][k], acc[ai][bj][m][n], 0, 0, 0); __builtin_amdgcn_s_setprio(0); } while (0)
#define PG8_WAIT_V(n) asm volatile("s_waitcnt vmcnt(" #n ")" ::: "memory")
#define PG8_WAIT_L(n) asm volatile("s_waitcnt lgkmcnt(" #n ")" ::: "memory")
#define PG8_BAR __builtin_amdgcn_s_barrier()
#define PG8_SCHED __builtin_amdgcn_sched_barrier(0)
    Unit cur, nxt; int ui = 0;
    if (!S.next(0, cur)) return;
    f32x4 acc[2][2][4][2];
#pragma unroll
    for (int a = 0; a < 2; ++a)
#pragma unroll
        for (int b = 0; b < 2; ++b)
#pragma unroll
            for (int m = 0; m < 4; ++m)
#pragma unroll
                for (int n = 0; n < 2; ++n) acc[a][b][m][n] = (f32x4){0.f, 0.f, 0.f, 0.f};
    bf16x8 At[4][2], B0[2][2], B1[2][2];
    const char* cA = (const char*)g.A + (size_t)cur.pm * tstepA; const char* cB = (const char*)g.Bt + (size_t)cur.pn * tstepB;
    S.a_ready(cur);
    if constexpr (SP2) {
        PG8_STAGE(PG8_SB(0, 0), cB, voffB); PG8_STAGE(PG8_SB(0, 1), cB + hstepB, voffB); PG8_STAGE(PG8_SA(0, 0), cA, voffA); PG8_STAGE(PG8_SA(0, 1), cA + hstepA, voffA);
        if (wr == 1) PG8_BAR;
        PG8_WAIT_V(2); PG8_BAR;
        PG8_STAGE(PG8_SB(1, 0), cB + kstep, voffB); PG8_STAGE(PG8_SA(1, 0), cA + kstep, voffA); PG8_STAGE(PG8_SB(1, 1), cB + hstepB + kstep, voffB);
        PG8_WAIT_V(6); PG8_BAR;
    } else {
        PG8_STAGE(PG8_SB(0, 0), cB, voffB); PG8_STAGE(PG8_SA(0, 0), cA, voffA); PG8_STAGE(PG8_SB(0, 1), cB + hstepB, voffB); PG8_STAGE(PG8_SA(0, 1), cA + hstepA, voffA);
        if (wr == 1) PG8_BAR;
        PG8_WAIT_V(4); PG8_BAR;
        PG8_STAGE(PG8_SB(1, 0), cB + kstep, voffB); PG8_STAGE(PG8_SA(1, 0), cA + kstep, voffA); PG8_STAGE(PG8_SB(1, 1), cB + hstepB + kstep, voffB);
        PG8_WAIT_V(6); PG8_BAR;
    }
    for (;;) {
        const bool has_next = S.next(ui + 1, nxt);
        const char* nA = has_next ? (const char*)g.A + (size_t)nxt.pm * tstepA : cA; const char* nB = has_next ? (const char*)g.Bt + (size_t)nxt.pn * tstepB : cB;
        for (int t = 0; t < nt; t += 2) {
            const bool last = (t == nt - 2);
            const char* a1 = cA + (size_t)(t + 1) * kstep;
            const char* a2 = last ? nA : cA + (size_t)(t + 2) * kstep; const char* b2 = last ? nB : cB + (size_t)(t + 2) * kstep;
            const char* a3 = a2 + kstep; const char* b3 = b2 + kstep;
            if (last && has_next) S.a_ready(nxt);
            if constexpr (SP2) {
            PG8_LDB(B0, 0, 0); PG8_LDB(B1, 0, 1); PG8_SCHED; PG8_LDA(At, 0, 0); PG8_STAGE(PG8_SA(1, 1), a1 + hstepA, voffA);
            PG8_WAIT_V(8); PG8_WAIT_L(0); PG8_BAR; PG8_MMA(0, 0, At, B0); PG8_MMA(0, 1, At, B1); PG8_BAR; PG8_SCHED;
            PG8_LDA(At, 0, 1); PG8_STAGE(PG8_SB(0, 0), b2, voffB); PG8_STAGE(PG8_SB(0, 1), b2 + hstepB, voffB); PG8_STAGE(PG8_SA(0, 0), a2, voffA);
            PG8_WAIT_V(8); PG8_WAIT_L(0); PG8_BAR; PG8_MMA(1, 0, At, B0); PG8_MMA(1, 1, At, B1); PG8_BAR; PG8_SCHED;
            PG8_LDB(B0, 1, 0); PG8_LDB(B1, 1, 1); PG8_SCHED; PG8_LDA(At, 1, 0); PG8_STAGE(PG8_SA(0, 1), a2 + hstepA, voffA);
            PG8_WAIT_V(8); PG8_WAIT_L(0); PG8_BAR; PG8_MMA(0, 0, At, B0); PG8_MMA(0, 1, At, B1); PG8_BAR; PG8_SCHED;
            PG8_LDA(At, 1, 1); PG8_STAGE(PG8_SB(1, 0), b3, voffB); PG8_STAGE(PG8_SB(1, 1), b3 + hstepB, voffB); PG8_STAGE(PG8_SA(1, 0), a3, voffA);
            PG8_WAIT_V(8); PG8_WAIT_L(0); PG8_BAR; PG8_MMA(1, 0, At, B0); PG8_MMA(1, 1, At, B1); PG8_BAR; PG8_SCHED;
            } else {
            PG8_LDB(B0, 0, 0); PG8_SCHED; PG8_LDA(At, 0, 0); PG8_STAGE(PG8_SA(1, 1), a1 + hstepA, voffA);
            PG8_WAIT_L(8); PG8_BAR; PG8_WAIT_L(0); PG8_MMA(0, 0, At, B0); PG8_BAR; PG8_SCHED;
            PG8_LDB(B1, 0, 1); PG8_STAGE(PG8_SB(0, 0), b2, voffB);
            PG8_BAR; PG8_WAIT_L(0); PG8_MMA(0, 1, At, B1); PG8_BAR;
            PG8_LDA(At, 0, 1); PG8_STAGE(PG8_SA(0, 0), a2, voffA);
            PG8_BAR; PG8_WAIT_L(0); PG8_MMA(1, 0, At, B0); PG8_BAR; PG8_SCHED;
            PG8_STAGE(PG8_SB(0, 1), b2 + hstepB, voffB);
            PG8_WAIT_V(6); PG8_BAR; PG8_MMA(1, 1, At, B1); PG8_BAR;
            PG8_LDB(B0, 1, 0); PG8_SCHED; PG8_LDA(At, 1, 0); PG8_STAGE(PG8_SA(0, 1), a2 + hstepA, voffA);
            PG8_WAIT_L(8); PG8_BAR; PG8_WAIT_L(0); PG8_MMA(0, 0, At, B0); PG8_BAR; PG8_SCHED;
            PG8_LDB(B1, 1, 1); PG8_STAGE(PG8_SB(1, 0), b3, voffB);
            PG8_BAR; PG8_WAIT_L(0); PG8_MMA(0, 1, At, B1); PG8_BAR;
            PG8_LDA(At, 1, 1); PG8_STAGE(PG8_SA(1, 0), a3, voffA);
            PG8_BAR; PG8_WAIT_L(0); PG8_MMA(1, 0, At, B0); PG8_BAR; PG8_SCHED;
            PG8_STAGE(PG8_SB(1, 1), b3 + hstepB, voffB);
            PG8_WAIT_V(6); PG8_BAR; PG8_MMA(1, 1, At, B1); PG8_BAR;
            }
        }
        if constexpr (ALIGN_EPI) { if (wr == 0) PG8_BAR; }
        if constexpr (!Epi::AFTER_DRAIN) { int tl2 = threadIdx.x; asm volatile("" : "+v"(tl2)); E(acc, cur, wr, wc, tl2 & 15, (tl2 & 63) >> 4); S.done(cur); }
        if (!has_next) break;
#pragma unroll
        for (int a = 0; a < 2; ++a)
#pragma unroll
            for (int b = 0; b < 2; ++b)
#pragma unroll
                for (int m = 0; m < 4; ++m)
#pragma unroll
                    for (int n = 0; n < 2; ++n) acc[a][b][m][n] = (f32x4){0.f, 0.f, 0.f, 0.f};
        cur = nxt; cA = nA; cB = nB; ++ui;
        if constexpr (ALIGN_EPI) { if (wr == 1) PG8_BAR; }
    }
    PG8_WAIT_V(0);
    if constexpr (!ALIGN_EPI) { if (wr == 0) PG8_BAR; }
    PG8_BAR;
    if constexpr (Epi::AFTER_DRAIN) { E.fused(acc, cur, wr, wc, fr, fq, lds, wid, lane); S.done(cur); }
#undef PG8_SA
#undef PG8_SB
#undef PG8_STAGE
#undef PG8_LDA
#undef PG8_LDB
#undef PG8_MMA
#undef PG8_WAIT_V
#undef PG8_WAIT_L
#undef PG8_BAR
#undef PG8_SCHED
}
}

#define LAS __attribute__((address_space(3)))
typedef unsigned short bf16;
typedef unsigned v4u __attribute__((ext_vector_type(4)));
typedef unsigned v2u __attribute__((ext_vector_type(2)));
typedef float f32x4 __attribute__((ext_vector_type(4)));
typedef short bf16x8 __attribute__((ext_vector_type(8)));

constexpr int T = 16384, SEQ = 2048, NP0 = 2816, NP1 = 3840, FF = 2816;
constexpr int NTHREADS = 512, NWAVES = 8;
constexpr int LDS_BYTES = 147456;
constexpr size_t MiB = 1u << 20;
constexpr size_t WS_CTL = 0, CTL_ZERO_BYTES = 65536;
constexpr size_t WS_ROWSS = 65536;
constexpr size_t WS_CARRY = 512 * 1024;
constexpr size_t WS_W = 1 * MiB;
constexpr size_t W_IN = WS_W, W_OUT = W_IN + 7680 * 1024, W_GU = W_OUT + 2 * MiB, W_DN = W_GU + 11 * MiB, W_PG = W_DN + 5632 * 1024, W_PP = W_PG + 2 * MiB,
                 W_LR = W_PP + 512 * 1024, W_LRU = W_LR + 768 * 1024, W_END = W_LRU + 128 * 1024;
static_assert(W_END <= 35 * MiB, "weights region");
constexpr size_t WS_HB = 35 * MiB;
constexpr size_t WS_PROJ = 67 * MiB;
constexpr size_t WS_Y = 187 * MiB;
constexpr size_t WS_GST = 219 * MiB;
constexpr size_t WS_ALR = 235 * MiB;
constexpr size_t WS_PB = 243 * MiB;
constexpr size_t WS_RKR = 251 * MiB;
constexpr size_t WS_GDEC = WS_RKR + 512 * 1024;
constexpr size_t WS_LEND = 252 * MiB;
constexpr size_t WS_END = 256 * MiB;

static_assert(E_ROWSS == WS_ROWSS && E_HB == WS_HB && E_PROJ == WS_PROJ && E_Y == WS_Y, "epilogue offsets");

__device__ __forceinline__ int fresh_s(int x) { asm volatile("" : "+s"(x)); return x; }
__device__ __forceinline__ int fresh_tid() { int t = threadIdx.x; asm volatile("" : "+v"(t)); return t; }
__device__ __forceinline__ float bf2f(unsigned v) { return __uint_as_float(v << 16); }
typedef float f32x2_t __attribute__((ext_vector_type(2))); typedef __bf16 bf16x2_t __attribute__((ext_vector_type(2)));
__device__ __forceinline__ unsigned pk2(float lo, float hi) { const f32x2_t v = {lo, hi}; const bf16x2_t b = __builtin_convertvector(v, bf16x2_t); return __builtin_bit_cast(unsigned, b); }
__device__ __forceinline__ unsigned f2bf(float f) { return pk2(f, f) & 0xffffu; }
__device__ __forceinline__ void unpack8(const v4u w, float* f) {
    f[0] = __uint_as_float(w.x << 16); f[1] = __uint_as_float(w.x & 0xffff0000u); f[2] = __uint_as_float(w.y << 16); f[3] = __uint_as_float(w.y & 0xffff0000u);
    f[4] = __uint_as_float(w.z << 16); f[5] = __uint_as_float(w.z & 0xffff0000u); f[6] = __uint_as_float(w.w << 16); f[7] = __uint_as_float(w.w & 0xffff0000u);
}
__device__ __forceinline__ v4u pack8(const float* f) { v4u w; w.x = pk2(f[0], f[1]); w.y = pk2(f[2], f[3]); w.z = pk2(f[4], f[5]); w.w = pk2(f[6], f[7]); return w; }
__device__ __forceinline__ void ld8(const bf16* p, float* f) { unpack8(*(const v4u*)p, f); }
__device__ __forceinline__ void ldf8(const float* p, float* f) { const f32x4 a = *(const f32x4*)p, b = *(const f32x4*)(p + 4); f[0] = a[0]; f[1] = a[1]; f[2] = a[2]; f[3] = a[3]; f[4] = b[0]; f[5] = b[1]; f[6] = b[2]; f[7] = b[3]; }
__device__ __forceinline__ float sigmf(float x) { return __builtin_amdgcn_rcpf(1.0f + __expf(-x)); }
__device__ __forceinline__ float logsigf(float z) { return fminf(z, 0.f) - __logf(1.0f + __expf(-fabsf(z))); }
__device__ __forceinline__ float wave_sum(float v) {
#pragma unroll
    for (int o = 1; o < 64; o <<= 1) v += __shfl_xor(v, o);
    return v;
}
#define LDS_WAIT() asm volatile("s_waitcnt lgkmcnt(0)" ::: "memory")

#define XB_TMO      128
#define XB_XCNT(j)  (256  + 64 * (j))
#define XB_XSUB(j)  (1280 + 64 * (j))
#define XB_XGEN(j)  (2304 + 64 * (j))
#define XB_TOP      3328
#define XB_TOPGEN   3392
#define XCD_BAR_WORDS 3456
#define XB_SPIN_CAP (1u << 18)

__device__ __forceinline__ unsigned xb_ld(unsigned* p)              { return __hip_atomic_load(p, __ATOMIC_RELAXED, __HIP_MEMORY_SCOPE_AGENT); }
__device__ __forceinline__ unsigned xb_add(unsigned* p, unsigned v) { return __hip_atomic_fetch_add(p, v, __ATOMIC_RELAXED, __HIP_MEMORY_SCOPE_AGENT); }
__device__ __forceinline__ unsigned xb_xcc_id() { return (unsigned)__builtin_amdgcn_s_getreg((3 << 11) | 20) & 0xFu; }
#define XB_SPIN(cond, bar) do { unsigned _sp = 0; while (cond) { __builtin_amdgcn_s_sleep(1); \
    if ((++_sp & 255u) == 0u) { if (xb_ld(&(bar)[XB_TMO])) break; if (_sp > XB_SPIN_CAP) { atomicAdd(&(bar)[XB_TMO], 1u); break; } } } } while (0)

struct XcdBarrier {
    unsigned* bar; unsigned x;
    volatile LAS unsigned* st;
};

__device__ __forceinline__ XcdBarrier xcd_barrier_post(unsigned* bar, volatile LAS unsigned* st) {
    XcdBarrier b; b.bar = bar; b.x = xb_xcc_id(); b.st = st;
    if (threadIdx.x == 0) (void)xb_add(&bar[XB_XCNT(b.x)], 1u);
    return b;
}
__device__ __forceinline__ void xcd_barrier_complete(unsigned* bar, unsigned x, unsigned& nloc, unsigned& nx) {
    const unsigned G = gridDim.x * gridDim.y * gridDim.z;
    unsigned sum, cnt, mine, sp = 0u;
    for (;;) {
        sum = 0u; cnt = 0u; mine = 0u;
#pragma unroll
        for (unsigned j = 0; j < 16; ++j) { const unsigned c = xb_ld(&bar[XB_XCNT(j)]); sum += c; cnt += (c > 0u) ? 1u : 0u; mine = (j == x) ? c : mine; }
        if (sum == G) break;
        __builtin_amdgcn_s_sleep(1);
        if ((++sp & 255u) == 0u) { if (xb_ld(&bar[XB_TMO])) break; if (sp > XB_SPIN_CAP) { atomicAdd(&bar[XB_TMO], 1u); break; } }
    }
    nloc = mine > 0u ? mine : 1u; nx = cnt > 0u ? cnt : 1u;
}

__device__ __forceinline__ void xcd_barrier(const XcdBarrier& b) {
    asm volatile("s_waitcnt vmcnt(0)" ::: "memory");
    __syncthreads();
    if (threadIdx.x == 0) {
        unsigned* bar = b.bar;
        __builtin_amdgcn_s_waitcnt(0);
        unsigned nloc = b.st[0], nx = b.st[1];
        if (nloc == 0u) { xcd_barrier_complete(bar, b.x, nloc, nx); b.st[0] = nloc; b.st[1] = nx; }
        const unsigned old = xb_add(&bar[XB_XSUB(b.x)], 1u);
        const unsigned gen = old / nloc;
        if (old + 1u == (gen + 1u) * nloc) {
            __builtin_amdgcn_fence(__ATOMIC_RELEASE, "agent");
            asm volatile("s_waitcnt vmcnt(0)" ::: "memory");
            const unsigned og = xb_add(&bar[XB_TOP], 1u);
            const unsigned tg = og / nx;
            if (og + 1u == (tg + 1u) * nx) xb_add(&bar[XB_TOPGEN], 1u);
            else XB_SPIN(xb_ld(&bar[XB_TOPGEN]) == tg, bar);
            __builtin_amdgcn_fence(__ATOMIC_ACQUIRE, "agent");
            xb_add(&bar[XB_XGEN(b.x)], 1u);
            asm volatile("s_waitcnt vmcnt(0)" ::: "memory");
        } else {
            XB_SPIN(xb_ld(&bar[XB_XGEN(b.x)]) == gen, bar);
            __builtin_amdgcn_fence(__ATOMIC_ACQUIRE, "agent");
            asm volatile("s_waitcnt vmcnt(0)" ::: "memory");
        }
    }
    __syncthreads();
}

constexpr size_t WS_XBAR = 16384;
constexpr int LDS_XST = LDS_BYTES - 64;

__device__ __forceinline__ f32x4 mma_ll(const LAS bf16* X, int ldx, const LAS bf16* Y, int ldy, int K, f32x4 acc, int lane) {
    const LAS bf16* xp = X + (lane & 15) * ldx + 8 * (lane >> 4);
    const LAS bf16* yp = Y + (lane & 15) * ldy + 8 * (lane >> 4);
    for (int k = 0; k < K; k += 32) {
        const bf16x8 a = *(const LAS bf16x8*)(xp + k), b = *(const LAS bf16x8*)(yp + k);
        acc = __builtin_amdgcn_mfma_f32_16x16x32_bf16(a, b, acc, 0, 0, 0);
    }
    return acc;
}
__device__ __forceinline__ f32x4 mma_lg(const LAS bf16* X, int ldx, const bf16* Y, int ldy, int K, f32x4 acc, int lane) {
    const LAS bf16* xp = X + (lane & 15) * ldx + 8 * (lane >> 4);
    const bf16* yp = Y + (size_t)(lane & 15) * ldy + 8 * (lane >> 4);
    for (int k = 0; k < K; k += 32) {
        const bf16x8 a = *(const LAS bf16x8*)(xp + k), b = *(const bf16x8*)(yp + k);
        acc = __builtin_amdgcn_mfma_f32_16x16x32_bf16(a, b, acc, 0, 0, 0);
    }
    return acc;
}

__device__ __forceinline__ void tr_load(const float* W, int ldw, const float* gain, int ncols, int item, int lane, f32x4 (&v)[8]) {
    const int nblk = ncols / 32, kb = item / nblk, nb = item % nblk, k0 = 64 * kb, n0 = 32 * nb;
#pragma unroll
    for (int i = 0; i < 8; ++i) { const int kk = 8 * i + (lane >> 3), cc = (lane & 7) * 4; v[i] = *(const f32x4*)(W + (size_t)(k0 + kk) * ldw + n0 + cc); if (gain) v[i] = v[i] * gain[k0 + kk]; }
}
__device__ __forceinline__ void tr_store(int K, bf16* WT, int ncols, int mode, LAS float* scr, int item, int lane, const f32x4 (&v)[8]) {
    const int nblk = ncols / 32, kb = item / nblk, nb = item % nblk, k0 = 64 * kb, n0 = 32 * nb;
#pragma unroll
    for (int i = 0; i < 8; ++i) { const int kk = 8 * i + (lane >> 3), cc = (lane & 7) * 4; scr[kk * 33 + cc] = v[i].x; scr[kk * 33 + cc + 1] = v[i].y; scr[kk * 33 + cc + 2] = v[i].z; scr[kk * 33 + cc + 3] = v[i].w; }
    LDS_WAIT(); asm volatile("" ::: "memory");
    const int c = lane & 7;
#pragma unroll
    for (int j = 0; j < 4; ++j) { const int n = (lane >> 3) + 8 * j; const LAS float* s = scr + (8 * c) * 33 + n;
        v4u o; o.x = pk2(s[0 * 33], s[1 * 33]); o.y = pk2(s[2 * 33], s[3 * 33]); o.z = pk2(s[4 * 33], s[5 * 33]); o.w = pk2(s[6 * 33], s[7 * 33]);
        const int nn = n0 + n; const int r = mode == 0 ? nn : (8 * (nn >> 2) + (nn & 3) + (mode == 2 ? 4 : 0));
        *(v4u*)(WT + (size_t)r * K + k0 + 8 * c) = o; }
    LDS_WAIT(); asm volatile("" ::: "memory");
}
__device__ __forceinline__ void tr_item(const float* W, int ldw, int K, const float* gain, bf16* WT, int ncols, int mode, LAS float* scr, int item, int lane) {
    f32x4 v[8]; tr_load(W, ldw, gain, ncols, item, lane, v); tr_store(K, WT, ncols, mode, scr, item, lane, v);
}
__device__ __forceinline__ void tr_job(const float* W, int ldw, int K, const float* gain, bf16* WT, int ncols, int mode, LAS unsigned char* lds, int gw, int NGW, int wave, int lane) {
    LAS float* scr = (LAS float*)(lds + wave * 8704);
    const int nitems = (K / 64) * (ncols / 32);
    for (int it = gw; it < nitems; it += NGW) tr_item(W, ldw, K, gain, WT, ncols, mode, scr, it, lane);
}
__device__ __forceinline__ void cvt_layer_weights(PRef p, int li, LAS unsigned char* lds, int gw, int NGW, int wave, int lane) {
    unsigned char* ws = p.ws;
    tr_job(li == 0 ? p.in[14] : p.in[27], 1024, 1024, nullptr, (bf16*)(ws + W_OUT), 1024, 0, lds, gw, NGW, wave, lane);
    tr_job(p.in[30] + (size_t)li * 1024 * FF, FF, 1024, p.in[29] + li * 1024, (bf16*)(ws + W_GU), FF, 1, lds, gw, NGW, wave, lane);
    tr_job(p.in[31] + (size_t)li * 1024 * FF, FF, 1024, p.in[29] + li * 1024, (bf16*)(ws + W_GU), FF, 2, lds, gw, NGW, wave, lane);
    tr_job(p.in[32] + (size_t)li * FF * 1024, 1024, FF, nullptr, (bf16*)(ws + W_DN), 1024, 0, lds, gw, NGW, wave, lane);
    tr_job(p.in[34] + (size_t)li * 1024 * 1024, 1024, 1024, p.in[33] + li * 1024, (bf16*)(ws + W_PG), 1024, 0, lds, gw, NGW, wave, lane);
    tr_job(p.in[36] + (size_t)li * 256 * 1024, 1024, 256, nullptr, (bf16*)(ws + W_PP), 1024, 0, lds, gw, NGW, wave, lane);
}
__device__ __forceinline__ void cvt_p(PRef p, int li, int gw, int NGW, int lane) {
    const float* src = p.in[1] + (size_t)li * T * 256; bf16* pb = (bf16*)(p.ws + WS_PB);
    for (int m = gw; m < T; m += NGW) { const f32x4 v = *((const f32x4*)(src + (size_t)m * 256) + lane); v2u o; o.x = pk2(v.x, v.y); o.y = pk2(v.z, v.w); *((v2u*)(pb + (size_t)m * 256) + lane) = o; }
}

constexpr int CVT1_ITEMS = 512 + 3 * 1408 + 512 + 128 + 1024;
struct Cvt1Job { const float* W; const float* gain; bf16* WT; int ldw, K, ncols, mode, item; };
__device__ __forceinline__ Cvt1Job cvt1_job(PRef p, int idx) {
    unsigned char* ws = p.ws; Cvt1Job j;
    if (idx < 512) { j = Cvt1Job{p.in[27], nullptr, (bf16*)(ws + W_OUT), 1024, 1024, 1024, 0, idx}; return j; } idx -= 512;
    if (idx < 1408) { j = Cvt1Job{p.in[30] + (size_t)1024 * FF, p.in[29] + 1024, (bf16*)(ws + W_GU), FF, 1024, FF, 1, idx}; return j; } idx -= 1408;
    if (idx < 1408) { j = Cvt1Job{p.in[31] + (size_t)1024 * FF, p.in[29] + 1024, (bf16*)(ws + W_GU), FF, 1024, FF, 2, idx}; return j; } idx -= 1408;
    if (idx < 1408) { j = Cvt1Job{p.in[32] + (size_t)FF * 1024, nullptr, (bf16*)(ws + W_DN), 1024, FF, 1024, 0, idx}; return j; } idx -= 1408;
    if (idx < 512) { j = Cvt1Job{p.in[34] + (size_t)1024 * 1024, p.in[33] + 1024, (bf16*)(ws + W_PG), 1024, 1024, 1024, 0, idx}; return j; } idx -= 512;
    j = Cvt1Job{p.in[36] + (size_t)256 * 1024, nullptr, (bf16*)(ws + W_PP), 1024, 256, 1024, 0, idx}; return j;
}
constexpr int CVT1_W_ITEMS = CVT1_ITEMS - 1024;
__device__ __forceinline__ void cvt1_load(PRef p, int idx, int lane, f32x4 (&v)[8]) {
    if (idx < CVT1_W_ITEMS) { const Cvt1Job j = cvt1_job(p, idx); tr_load(j.W, j.ldw, j.gain, j.ncols, j.item, lane, v); }
    else { const float* src = p.in[1] + (size_t)T * 256 + (size_t)(idx - CVT1_W_ITEMS) * 16 * 256;
#pragma unroll
        for (int r = 0; r < 8; ++r) v[r] = *((const f32x4*)(src + (size_t)r * 256) + lane); }
}
__device__ __forceinline__ void cvt1_store(PRef p, int idx, LAS float* scr, int lane, const f32x4 (&v)[8]) {
    if (idx < CVT1_W_ITEMS) { const Cvt1Job j = cvt1_job(p, idx); tr_store(j.K, j.WT, j.ncols, j.mode, scr, j.item, lane, v); }
    else { const int m0 = (idx - CVT1_W_ITEMS) * 16; const float* src = p.in[1] + (size_t)T * 256; bf16* pb = (bf16*)(p.ws + WS_PB);
#pragma unroll
        for (int r = 0; r < 8; ++r) { v2u o; o.x = pk2(v[r].x, v[r].y); o.y = pk2(v[r].z, v[r].w); *((v2u*)(pb + (size_t)(m0 + r) * 256) + lane) = o; }
        for (int r = 8; r < 16; ++r) { const f32x4 w = *((const f32x4*)(src + (size_t)(m0 + r) * 256) + lane); v2u o; o.x = pk2(w.x, w.y); o.y = pk2(w.z, w.w); *((v2u*)(pb + (size_t)(m0 + r) * 256) + lane) = o; } }
}
__device__ __forceinline__ void cvt1_flat(PRef p, int idx, LAS float* scr, int lane) { f32x4 v[8]; cvt1_load(p, idx, lane, v); cvt1_store(p, idx, scr, lane, v); }
__device__ __forceinline__ void phase_prologue(PRef p, LAS unsigned char* lds, int gw, int NGW, int wave, int lane) {
    unsigned char* ws = p.ws; const int gtid = gw * 64 + lane, NGT = NGW * 64;
    tr_job(p.in[3], 2576, 1024, p.in[28], (bf16*)(ws + W_IN), 2560, 0, lds, gw, NGW, wave, lane);
    for (int wi = gw; wi < 2048; wi += NGW) if ((wi & 3) == 0) {
        const int it = (wi >> 2) * 64 + lane, n = it >> 7, kc = it & 127; float o[8], wg[16];
#pragma unroll
        for (int r = 0; r < 16; ++r) wg[r] = p.in[11][r * 256 + n];
#pragma unroll
        for (int i = 0; i < 8; ++i) { const int k = 8 * kc + i; const f32x4* wr = (const f32x4*)(p.in[3] + (size_t)k * 2576 + 2560); const f32x4 a = wr[0], b = wr[1], c = wr[2], d = wr[3];
            const float s_ = ((a[0] * wg[0] + a[1] * wg[1]) + (a[2] * wg[2] + a[3] * wg[3])) + ((b[0] * wg[4] + b[1] * wg[5]) + (b[2] * wg[6] + b[3] * wg[7]))
                           + ((c[0] * wg[8] + c[1] * wg[9]) + (c[2] * wg[10] + c[3] * wg[11])) + ((d[0] * wg[12] + d[1] * wg[13]) + (d[2] * wg[14] + d[3] * wg[15]));
            o[i] = s_ * p.in[28][k]; }
        *(v4u*)((bf16*)(ws + W_IN) + (size_t)(2560 + n) * 1024 + 8 * kc) = pack8(o); }
    cvt_layer_weights(p, 0, lds, gw, NGW, wave, lane);
    for (int it = gtid; it < 1536 * 16; it += NGT) { const int n = it >> 4, kc = it & 15; float o[8];
#pragma unroll
        for (int i = 0; i < 8; ++i) { const int k = 8 * kc + i; float v = 0.f;
            if (n < 512) { if (k < 64) v = p.in[19][k * 512 + n]; }
            else if (n < 1024) { if (k >= 64) v = p.in[21][(k - 64) * 512 + (n - 512)]; }
            else v = p.in[22][k * 512 + (n - 1024)];
            o[i] = v; }
        *(v4u*)((bf16*)(ws + W_LR) + (size_t)n * 128 + 8 * kc) = pack8(o); }
    for (int it = gtid; it < 2 * 8 * 64 * 8; it += NGT) { const int ic = it & 7, j = (it >> 3) & 63, g = (it >> 9) & 7, which = it >> 12; const float* src = which ? p.in[8] : p.in[6]; float o[8];
#pragma unroll
        for (int i = 0; i < 8; ++i) o[i] = src[(g * 64 + 8 * ic + i) * 64 + j];
        *(v4u*)((bf16*)(ws + W_LRU) + (size_t)which * 32768 + (g * 64 + j) * 64 + 8 * ic) = pack8(o); }
    { const float* x = p.in[0]; bf16* hb = (bf16*)(ws + WS_HB); float* rss = (float*)(ws + WS_ROWSS);
      for (int m = gw; m < T; m += NGW) { const f32x4* xr = (const f32x4*)(x + (size_t)m * 1024) + lane; float s = 0.f; v2u* o8 = (v2u*)(hb + (size_t)m * 1024) + lane;
#pragma unroll
          for (int j = 0; j < 4; ++j) { const f32x4 v = xr[64 * j]; s += (v.x * v.x + v.y * v.y) + (v.z * v.z + v.w * v.w); v2u o; o.x = pk2(v.x, v.y); o.y = pk2(v.z, v.w); o8[64 * j] = o; }
          s = wave_sum(s); if (lane == 0) rss[m] = s; } }
    cvt_p(p, 0, gw, NGW, lane);
}

__device__ __forceinline__ void lru_local_item(PRef p, LAS unsigned char* lds, int item, int tid, int wave, int lane) {
    const int c = item & 31, b = item >> 5;
    const bf16* proj = (const bf16*)(p.ws + WS_PROJ);
    constexpr int LX = 520;
    constexpr int LR = 65;
    LAS bf16* Xs = (LAS bf16*)lds; LAS float* R = (LAS float*)(lds + 66560); LAS float* I = (LAS float*)(lds + 66560 + 16640);
    LAS float* SEGH = (LAS float*)(lds + 66560 + 33280); LAS float* SEGP = SEGH + 512;
    const int tl = tid >> 3, c8 = (tid & 7) * 8, t0 = b * SEQ + 64 * c;
    LAS float* LS = SEGP + 512; LAS float* BR = LS + 512; LAS float* BI = BR + 512; LAS float* CARH = BI + 512; LAS float* CARP = CARH + 512;
    LS[tid] = logsigf(p.in[10][tid]); BR[tid] = p.in[7][tid]; BI[tid] = p.in[9][tid];
#pragma unroll 2
    for (int g = 0; g < 8; ++g) { const int ch0 = 64 * g + c8; f32x4 a0 = *(const f32x4*)(p.in[5] + ch0), a1 = *(const f32x4*)(p.in[5] + ch0 + 4);
#pragma unroll
        for (int k = 0; k < 4; ++k) { const int tt = 64 * c + tl - 3 + k; if (tt >= 0) { float xv[8]; ld8(proj + (size_t)(b * SEQ + tt) * NP0 + ch0, xv);
                const f32x4 w0 = *(const f32x4*)(p.in[4] + k * 512 + ch0), w1 = *(const f32x4*)(p.in[4] + k * 512 + ch0 + 4);
                a0 = a0 + w0 * (f32x4){xv[0], xv[1], xv[2], xv[3]}; a1 = a1 + w1 * (f32x4){xv[4], xv[5], xv[6], xv[7]}; } }
        const float av[8] = {a0[0], a0[1], a0[2], a0[3], a1[0], a1[1], a1[2], a1[3]};
        *(LAS v4u*)(Xs + tl * LX + ch0) = pack8(av); }
    __syncthreads();
    const int rt = wave & 3, gate = wave >> 2, q = lane >> 4;
    const bf16* WTb = (const bf16*)(p.ws + W_LRU) + gate * 32768 + (size_t)(lane & 15) * 64 + 8 * q;
    bf16x8 wf[4][2];
#pragma unroll
    for (int ct = 0; ct < 4; ++ct) { wf[ct][0] = *(const bf16x8*)(WTb + 16 * ct * 64); wf[ct][1] = *(const bf16x8*)(WTb + 16 * ct * 64 + 32); }
    for (int g = 0; g < 8; ++g) { const int ch0 = 64 * g + c8;
        { LAS float* dst = gate ? I : R; const LAS float* bias = gate ? BI : BR;
          const LAS bf16* xp = Xs + (16 * rt + (lane & 15)) * LX + 64 * g + 8 * q; const bf16x8 a0 = *(const LAS bf16x8*)xp, a1 = *(const LAS bf16x8*)(xp + 32);
          f32x4 acc[4];
#pragma unroll
          for (int ct = 0; ct < 4; ++ct) { acc[ct] = (f32x4){0.f, 0.f, 0.f, 0.f}; acc[ct] = __builtin_amdgcn_mfma_f32_16x16x32_bf16(a0, wf[ct][0], acc[ct], 0, 0, 0); acc[ct] = __builtin_amdgcn_mfma_f32_16x16x32_bf16(a1, wf[ct][1], acc[ct], 0, 0, 0); }
          { const int gn = g < 7 ? g + 1 : 7;
#pragma unroll
            for (int ct = 0; ct < 4; ++ct) { wf[ct][0] = *(const bf16x8*)(WTb + gn * 4096 + 16 * ct * 64); wf[ct][1] = *(const bf16x8*)(WTb + gn * 4096 + 16 * ct * 64 + 32); } }
#pragma unroll
          for (int ct = 0; ct < 4; ++ct) { const int ch = 16 * ct + (lane & 15); const float bv = bias[64 * g + ch];
#pragma unroll
              for (int j = 0; j < 4; ++j) dst[(16 * rt + 4 * q + j) * LR + ch] = sigmf(acc[ct][j] + bv); } }
        __syncthreads();
        {
#pragma unroll
          for (int i = 0; i < 8; ++i) { const float r = R[tl * LR + c8 + i], ii = I[tl * LR + c8 + i], xc = bf2f(Xs[tl * LX + ch0 + i]);
              const float la = 8.0f * r * LS[ch0 + i]; const float a = __expf(la); const float u = __builtin_amdgcn_sqrtf(fmaxf(1.0f - a * a, 0.f)) * (ii * xc);
              R[tl * LR + c8 + i] = a; I[tl * LR + c8 + i] = u; } }
        __syncthreads();
        { const int ch = tid & 63, seg = tid >> 6; float h = 0.f, P = 1.f;
#pragma unroll
          for (int t = 8 * seg; t < 8 * seg + 8; ++t) { const float a = R[t * LR + ch], u = I[t * LR + ch]; h = a * h + u; P *= a; I[t * LR + ch] = h; R[t * LR + ch] = P; }
          SEGH[seg * 64 + ch] = h; SEGP[seg * 64 + ch] = P; }
        __syncthreads();
        { const int ch = tid & 63, seg = tid >> 6; float ch_ = 0.f, cp_ = 1.f;
#pragma unroll
          for (int s2 = 0; s2 < 7; ++s2) { const float sp = SEGP[s2 * 64 + ch], sh = SEGH[s2 * 64 + ch]; if (s2 < seg) { ch_ = sp * ch_ + sh; cp_ *= sp; } }
          CARH[seg * 64 + ch] = ch_; CARP[seg * 64 + ch] = cp_; }
        __syncthreads();
        { bf16* hl = (bf16*)(p.ws + WS_HB); bf16* Pc = hl + (size_t)T * 512; const int seg = tl >> 3; float ho[8], po[8];
#pragma unroll
          for (int i = 0; i < 8; ++i) { const int ch = c8 + i; const float pl = R[tl * LR + ch]; ho[i] = I[tl * LR + ch] + pl * CARH[seg * 64 + ch]; po[i] = pl * CARP[seg * 64 + ch]; }
          *(v4u*)(hl + (size_t)(t0 + tl) * 512 + ch0) = pack8(ho); *(v4u*)(Pc + (size_t)(t0 + tl) * 512 + ch0) = pack8(po);
          if (tl == 63) { float* pe = (float*)(p.ws + WS_LEND);
#pragma unroll
              for (int i = 0; i < 8; ++i) { pe[(b * 32 + c) * 512 + ch0 + i] = po[i]; pe[131072 + (b * 32 + c) * 512 + ch0 + i] = ho[i]; } } }
        __syncthreads();
    }
}
__device__ __forceinline__ void lru_prefix(PRef p, int gtid, int NGT) {
    const float* pe = (const float*)(p.ws + WS_LEND); float* ci = (float*)(p.ws + WS_CARRY);
    for (int it = gtid; it < 4096; it += NGT) { const int b = it >> 9, ch = it & 511; float carry = 0.f; float pv[32], hv[32];
#pragma unroll
        for (int c = 0; c < 32; ++c) { const int o = (b * 32 + c) * 512 + ch; pv[c] = pe[o]; hv[c] = pe[131072 + o]; }
#pragma unroll
        for (int c = 0; c < 32; ++c) { const int o = (b * 32 + c) * 512 + ch; ci[o] = carry; carry = pv[c] * carry + hv[c]; } }
}
__device__ __forceinline__ float tanh_fast(float u) { return 1.0f - 2.0f * __builtin_amdgcn_rcpf(1.0f + __expf(2.0f * u)); }
__device__ __forceinline__ float gelu_tanh(float x) { const float u = 0.7978845608028654f * (x + 0.044715f * x * x * x); return 0.5f * x * (1.0f + tanh_fast(u)); }
__device__ __forceinline__ void lru_out(PRef p, int gtid, int NGT) {
    const bf16* proj = (const bf16*)(p.ws + WS_PROJ); const bf16* hl = (const bf16*)(p.ws + WS_HB); const bf16* Pc = hl + (size_t)T * 512; const float* ci = (const float*)(p.ws + WS_CARRY);
    bf16* y = (bf16*)(p.ws + WS_Y);
    int it = gtid; if (it >= T * 64) return;
    v4u rh, rp, rg; f32x4 c0, c1;
    { const int row = it >> 6, c8 = (it & 63) * 8, b = row >> 11, c = (row & 2047) >> 6; rh = *(const v4u*)(hl + (size_t)row * 512 + c8); rp = *(const v4u*)(Pc + (size_t)row * 512 + c8); rg = *(const v4u*)(proj + (size_t)row * NP0 + 512 + c8);
      const float* cp = ci + (b * 32 + c) * 512 + c8; c0 = *(const f32x4*)cp; c1 = *(const f32x4*)(cp + 4); }
    for (;;) { const int nx = it + NGT; const bool more = nx < T * 64; v4u nh = rh, np = rp, ng = rg; f32x4 n0 = c0, n1 = c1;
        if (more) { const int row = nx >> 6, c8 = (nx & 63) * 8, b = row >> 11, c = (row & 2047) >> 6; nh = *(const v4u*)(hl + (size_t)row * 512 + c8); np = *(const v4u*)(Pc + (size_t)row * 512 + c8); ng = *(const v4u*)(proj + (size_t)row * NP0 + 512 + c8);
            const float* cp = ci + (b * 32 + c) * 512 + c8; n0 = *(const f32x4*)cp; n1 = *(const f32x4*)(cp + 4); }
        { const int row = it >> 6, c8 = (it & 63) * 8; float h[8], P[8], gt[8], o[8]; unpack8(rh, h); unpack8(rp, P); unpack8(rg, gt); const float cr[8] = {c0[0], c0[1], c0[2], c0[3], c1[0], c1[1], c1[2], c1[3]};
#pragma unroll
          for (int i = 0; i < 8; ++i) o[i] = (h[i] + P[i] * cr[i]) * gelu_tanh(gt[i]);
          *(v4u*)(y + (size_t)row * 1024 + c8) = pack8(o); }
        if (!more) break; it = nx; rh = nh; rp = np; rg = ng; c0 = n0; c1 = n1; }
}

template <bool RET> struct LA {
    static constexpr int DK = RET ? 128 : 64, C = RET ? 128 : 64, NCH = SEQ / C, TPT = NTHREADS / C, KPT = DK / TPT, VPT = 128 / TPT, LQ = DK + 8, LT = C + 8;
    static constexpr int O_QS = 0, O_KS = O_QS + C * LQ * 2, O_VT = O_KS + C * LQ * 2, O_SC = O_VT + 128 * LT * 2, O_F = O_SC + C * LT * 2, O_OF = RET ? 0 : O_F + 16640;
    static constexpr int O_KT = O_QS;
    static_assert(DK * LT * 2 <= 2 * C * LQ * 2, "Kt fits");
    static_assert(RET ? (O_SC + C * LT * 2 <= LDS_BYTES - 256 && 128 * 133 * 4 <= 2 * 128 * 136 * 2) : (O_OF + 64 * 133 * 4 <= 98304 && 98304 + 2048 <= LDS_BYTES - 256), "LA LDS");
};
__device__ __forceinline__ void gla_cum(PRef p, LAS unsigned char* lds, const bf16* proj, int t0, int h, int tid) {
    LAS float* F = (LAS float*)(lds + LA<false>::O_F); const int tl = tid >> 3, c8 = (tid & 7) * 8;
    float z[8], bg[8]; ld8(proj + (size_t)(t0 + tl) * NP0 + 2560 + 64 * h + c8, z); ldf8(p.in[12] + 64 * h + c8, bg);
#pragma unroll
    for (int i = 0; i < 8; ++i) F[tl * 65 + c8 + i] = logsigf(z[i] + bg[i]) * (1.0f / 16.0f);
    __syncthreads();
    LAS float* SEG = (LAS float*)(lds + 98304);
    { const int ch = tid & 63, seg = tid >> 6; float run = 0.f;
#pragma unroll
      for (int t = 8 * seg; t < 8 * seg + 8; ++t) { run += F[t * 65 + ch]; F[t * 65 + ch] = run; }
      SEG[seg * 64 + ch] = run; }
    __syncthreads();
    { const int ch = tid & 63, seg = tid >> 6; float off = 0.f;
#pragma unroll
      for (int s2 = 0; s2 < 7; ++s2) { const float v = SEG[s2 * 64 + ch]; if (s2 < seg) off += v; }
#pragma unroll
      for (int t = 8 * seg; t < 8 * seg + 8; ++t) F[t * 65 + ch] += off; }
    __syncthreads();
}
template <bool RET> __device__ __forceinline__ void la_load_vt(LAS unsigned char* lds, const bf16* vsrc  , int ld, int tid) {
    typedef LA<RET> L; LAS bf16* Vt = (LAS bf16*)(lds + L::O_VT); const int tl = tid / L::TPT, v0 = (tid % L::TPT) * L::VPT;
#pragma unroll
    for (int s = 0; s < L::VPT / 8; ++s) { float v[8]; ld8(vsrc + (size_t)tl * ld + v0 + 8 * s, v);
#pragma unroll
        for (int i = 0; i < 8; ++i) Vt[(v0 + 8 * s + i) * L::LT + tl] = (bf16)f2bf(v[i]); }
}
__device__ __forceinline__ void rot_cs(int pos_i, int part, float* cs, float* sn) {
    const float pos = (float)pos_i;
#pragma unroll
    for (int i = 0; i < 16; ++i) { const float invr = __builtin_amdgcn_exp2f(-(float)(16 * part + i) * (13.287712379549449f / 64.0f)) * 0.15915494309189535f;
        const float hi = __uint_as_float(__float_as_uint(invr) & 0xfffff000u), lo = invr - hi;
        const float rev = __builtin_amdgcn_fractf(pos * hi) + pos * lo;
        sn[i] = __builtin_amdgcn_sinf(rev); cs[i] = __builtin_amdgcn_cosf(rev); }
}
__device__ __forceinline__ void ret_rot16(const bf16* src, const float* cs, const float* sn, int part, float* o1, float* o2) {
    float x1[16], x2[16]; ld8(src + 16 * part, x1); ld8(src + 16 * part + 8, x1 + 8); ld8(src + 64 + 16 * part, x2); ld8(src + 64 + 16 * part + 8, x2 + 8);
#pragma unroll
    for (int i = 0; i < 16; ++i) { o1[i] = x1[i] * cs[i] - x2[i] * sn[i]; o2[i] = x2[i] * cs[i] + x1[i] * sn[i]; }
}

template <bool RET> __device__ __forceinline__ void la_local_item(PRef p, LAS unsigned char* lds, int item, int tid, int wave, int lane) {
    typedef LA<RET> L; const int c = item % L::NCH, h = (item / L::NCH) & 3, b = item / (L::NCH * 4), t0 = b * SEQ + L::C * c;
    const bf16* proj = (const bf16*)(p.ws + WS_PROJ); LAS bf16* Kt = (LAS bf16*)(lds + L::O_KT); LAS bf16* Vt = (LAS bf16*)(lds + L::O_VT);
    bf16* state = RET ? (bf16*)(p.ws + WS_HB) : (bf16*)(p.ws + WS_GST);
    if (!RET) {
        la_load_vt<false>(lds, proj + (size_t)t0 * NP0 + 1536 + 128 * h, NP0, tid);
        const int tl = tid >> 3, c8 = (tid & 7) * 8; const v4u kraw = *(const v4u*)(proj + (size_t)(t0 + tl) * NP0 + 1280 + 64 * h + c8);
        gla_cum(p, lds, proj, t0, h, tid);
        LAS float* F = (LAS float*)(lds + L::O_F); float kv[8]; unpack8(kraw, kv);
#pragma unroll
        for (int i = 0; i < 8; ++i) { const float ge = F[63 * 65 + c8 + i], gt = F[tl * 65 + c8 + i]; Kt[(c8 + i) * L::LT + tl] = (bf16)f2bf(kv[i] * __expf(ge - gt));
            if (tl == 63) ((float*)(p.ws + WS_GDEC))[item * 64 + c8 + i] = __expf(ge); }
    } else {
        la_load_vt<true>(lds, proj + (size_t)t0 * NP1 + 1024 + 128 * h, NP1, tid);
        const int tl = tid >> 2, part = tid & 3; float cs[16], sn[16]; rot_cs(((const int*)p.in[2])[t0 + tl], part, cs, sn); const float lg = log1pf(-exp2f(-5.0f - (float)h));
        float k1[16], k2[16]; ret_rot16(proj + (size_t)(t0 + tl) * NP1 + 512 + 128 * h, cs, sn, part, k1, k2); const float f = __expf((float)(127 - tl) * lg);
#pragma unroll
        for (int i = 0; i < 16; ++i) { Kt[(16 * part + i) * L::LT + tl] = (bf16)f2bf(k1[i] * f); Kt[(64 + 16 * part + i) * L::LT + tl] = (bf16)f2bf(k2[i] * f); }
    }
    __syncthreads();
    { const int q = lane >> 4; bf16* dst = state + (size_t)item * 128 * L::DK;
      for (int kt = 0; kt < L::DK / 16; ++kt) { f32x4 acc = {0.f, 0.f, 0.f, 0.f}; acc = mma_ll(Vt + 16 * wave * L::LT, L::LT, Kt + 16 * kt * L::LT, L::LT, L::C, acc, lane);
#pragma unroll
          for (int j = 0; j < 4; ++j) dst[(16 * wave + 4 * q + j) * L::DK + 16 * kt + (lane & 15)] = (bf16)f2bf(acc[j]); } }
    __syncthreads();
}
template <bool RET> __device__ __forceinline__ void la_prefix(PRef p, int gtid, int NGT) {
    typedef LA<RET> L; constexpr int NP = 128 * L::DK / 2; unsigned* state = RET ? (unsigned*)(p.ws + WS_HB) : (unsigned*)(p.ws + WS_GST); const float* dec = (const float*)(p.ws + WS_GDEC);
    for (int it = gtid; it < 32 * NP; it += NGT) { const int bh = it / NP, pe = it % NP, k = (2 * pe) % L::DK; float s0 = 0.f, s1 = 0.f;
        unsigned w[L::NCH]; float d0[L::NCH], d1[L::NCH];
        float dr = 0.f; if (RET) { const float lg = log1pf(-exp2f(-5.0f - (float)(bh & 3))); dr = __expf(128.0f * lg); }
#pragma unroll
        for (int c = 0; c < L::NCH; ++c) { w[c] = state[(size_t)(bh * L::NCH + c) * NP + pe];
            if (RET) { d0[c] = dr; d1[c] = dr; } else { d0[c] = dec[(bh * L::NCH + c) * 64 + k]; d1[c] = dec[(bh * L::NCH + c) * 64 + k + 1]; } }
#pragma unroll
        for (int c = 0; c < L::NCH; ++c) { state[(size_t)(bh * L::NCH + c) * NP + pe] = pk2(s0, s1);
            s0 = s0 * d0[c] + __uint_as_float(w[c] << 16); s1 = s1 * d1[c] + __uint_as_float(w[c] & 0xffff0000u); } }
}
template <bool RET> __device__ __forceinline__ void la_out_item(PRef p, LAS unsigned char* lds, int item, int tid, int wave, int lane) {
    typedef LA<RET> L; const int c = item % L::NCH, h = (item / L::NCH) & 3, b = item / (L::NCH * 4), t0 = b * SEQ + L::C * c;
    bf16* proj = (bf16*)(p.ws + WS_PROJ); LAS bf16* Qs = (LAS bf16*)(lds + L::O_QS); LAS bf16* Ks = (LAS bf16*)(lds + L::O_KS); LAS bf16* Vt = (LAS bf16*)(lds + L::O_VT); LAS bf16* Sc = (LAS bf16*)(lds + L::O_SC);
    LAS float* Of = (LAS float*)(lds + L::O_OF);
    const bf16* state = (RET ? (const bf16*)(p.ws + WS_HB) : (const bf16*)(p.ws + WS_GST)) + (size_t)item * 128 * L::DK;
    float inter_scale = 1.0f;
    const int ptl = tid / L::TPT, pv0 = (tid % L::TPT) * L::VPT;
    const bf16* gsrc0 = RET ? proj + (size_t)(t0 + ptl) * NP1 + 1536 + 128 * h + pv0 : proj + (size_t)(t0 + ptl) * NP0 + 2048 + 128 * h + pv0;
    const float* gn0 = (RET ? p.in[16] : p.in[13]) + 128 * h + pv0;
    v4u graw[L::VPT / 8]; f32x4 gnr[L::VPT / 4];
#pragma unroll
    for (int s8 = 0; s8 < L::VPT / 8; ++s8) graw[s8] = *(const v4u*)(gsrc0 + 8 * s8);
#pragma unroll
    for (int s4 = 0; s4 < L::VPT / 4; ++s4) gnr[s4] = *(const f32x4*)(gn0 + 4 * s4);
    if (!RET) {
        la_load_vt<false>(lds, proj + (size_t)t0 * NP0 + 1536 + 128 * h, NP0, tid);
        const int tl = tid >> 3, c8 = (tid & 7) * 8; const v4u qraw = *(const v4u*)(proj + (size_t)(t0 + tl) * NP0 + 1024 + 64 * h + c8), kraw = *(const v4u*)(proj + (size_t)(t0 + tl) * NP0 + 1280 + 64 * h + c8);
        gla_cum(p, lds, proj, t0, h, tid);
        LAS float* F = (LAS float*)(lds + L::O_F); float qv[8], kv[8], qo[8], ko[8]; unpack8(qraw, qv); unpack8(kraw, kv);
#pragma unroll
        for (int i = 0; i < 8; ++i) { const float gt = F[tl * 65 + c8 + i]; qo[i] = qv[i] * 0.125f * __expf(gt); ko[i] = kv[i] * __expf(-gt); }
        *(LAS v4u*)(Qs + tl * L::LQ + c8) = pack8(qo); *(LAS v4u*)(Ks + tl * L::LQ + c8) = pack8(ko);
    } else {
        la_load_vt<true>(lds, proj + (size_t)t0 * NP1 + 1024 + 128 * h, NP1, tid);
        const int tl = tid >> 2, part = tid & 3; float cs[16], sn[16]; rot_cs(((const int*)p.in[2])[t0 + tl], part, cs, sn); const float lg = log1pf(-exp2f(-5.0f - (float)h)); inter_scale = __expf(lg);
        float a1[16], a2[16];
        ret_rot16(proj + (size_t)(t0 + tl) * NP1 + 128 * h, cs, sn, part, a1, a2); const float fq_ = 0.08838834764831845f * __expf((float)tl * lg);
#pragma unroll
        for (int i = 0; i < 16; ++i) { a1[i] *= fq_; a2[i] *= fq_; }
        *(LAS v4u*)(Qs + tl * L::LQ + 16 * part) = pack8(a1); *(LAS v4u*)(Qs + tl * L::LQ + 16 * part + 8) = pack8(a1 + 8);
        *(LAS v4u*)(Qs + tl * L::LQ + 64 + 16 * part) = pack8(a2); *(LAS v4u*)(Qs + tl * L::LQ + 64 + 16 * part + 8) = pack8(a2 + 8);
        ret_rot16(proj + (size_t)(t0 + tl) * NP1 + 512 + 128 * h, cs, sn, part, a1, a2); const float fk_ = __expf(-(float)tl * lg);
#pragma unroll
        for (int i = 0; i < 16; ++i) { a1[i] *= fk_; a2[i] *= fk_; }
        *(LAS v4u*)(Ks + tl * L::LQ + 16 * part) = pack8(a1); *(LAS v4u*)(Ks + tl * L::LQ + 16 * part + 8) = pack8(a1 + 8);
        *(LAS v4u*)(Ks + tl * L::LQ + 64 + 16 * part) = pack8(a2); *(LAS v4u*)(Ks + tl * L::LQ + 64 + 16 * part + 8) = pack8(a2 + 8);
    }
    bf16x8 sf[4][2];
    if (!RET) {
#pragma unroll
        for (int vi = 0; vi < 4; ++vi)
#pragma unroll
            for (int ks = 0; ks < 2; ++ks) sf[vi][ks] = *(const bf16x8*)(state + (size_t)(16 * (4 * (wave >> 2) + vi) + (lane & 15)) * 64 + 8 * (lane >> 4) + 32 * ks);
    }
    __syncthreads();
    const int q = lane >> 4; constexpr int RT = L::C / 16;
    if (!RET) { const int rt = wave & 3;
#pragma unroll
        for (int cc = 0; cc < 2; ++cc) { const int ct = 2 * (wave >> 2) + cc; f32x4 acc = {0.f, 0.f, 0.f, 0.f};
            if (ct <= rt) acc = mma_ll(Qs + 16 * rt * L::LQ, L::LQ, Ks + 16 * ct * L::LQ, L::LQ, L::DK, acc, lane);
#pragma unroll
            for (int j = 0; j < 4; ++j) { const int it_ = 16 * rt + 4 * q + j, jt = 16 * ct + (lane & 15); Sc[it_ * L::LT + jt] = (bf16)f2bf(jt <= it_ ? acc[j] : 0.f); } }
    } else { const int rt = wave;
        for (int ct = 0; ct < RT; ++ct) { f32x4 acc = {0.f, 0.f, 0.f, 0.f};
            if (ct <= rt) acc = mma_ll(Qs + 16 * rt * L::LQ, L::LQ, Ks + 16 * ct * L::LQ, L::LQ, L::DK, acc, lane);
#pragma unroll
            for (int j = 0; j < 4; ++j) { const int it_ = 16 * rt + 4 * q + j, jt = 16 * ct + (lane & 15); Sc[it_ * L::LT + jt] = (bf16)f2bf(jt <= it_ ? acc[j] : 0.f); } }
    }
    __syncthreads();
    f32x4 oacc[RET ? 8 : 4];
    { const int rt = RET ? wave : (wave & 3), vt0 = RET ? 0 : 4 * (wave >> 2); constexpr int NV = RET ? 8 : 4;
#pragma unroll
      for (int vi = 0; vi < NV; ++vi) { const int vt = vt0 + vi; f32x4 a1 = {0.f, 0.f, 0.f, 0.f}, a2 = {0.f, 0.f, 0.f, 0.f};
          a1 = mma_ll(Sc + 16 * rt * L::LT, L::LT, Vt + 16 * vt * L::LT, L::LT, L::C, a1, lane);
          if (RET) a2 = mma_lg(Qs + 16 * rt * L::LQ, L::LQ, state + (size_t)16 * vt * L::DK, L::DK, L::DK, a2, lane);
          else { const LAS bf16* xp = Qs + (16 * rt + (lane & 15)) * L::LQ + 8 * (lane >> 4);
              a2 = __builtin_amdgcn_mfma_f32_16x16x32_bf16(*(const LAS bf16x8*)xp, sf[vi & 3][0], a2, 0, 0, 0); a2 = __builtin_amdgcn_mfma_f32_16x16x32_bf16(*(const LAS bf16x8*)(xp + 32), sf[vi & 3][1], a2, 0, 0, 0); }
          oacc[vi] = a1 + a2 * inter_scale; }
      if (RET) __syncthreads();
#pragma unroll
      for (int vi = 0; vi < NV; ++vi) { const int vt = vt0 + vi;
#pragma unroll
          for (int j = 0; j < 4; ++j) Of[(16 * rt + 4 * q + j) * 133 + 16 * vt + (lane & 15)] = oacc[vi][j]; } }
    __syncthreads();
    { const int tl = tid / L::TPT, v0 = (tid % L::TPT) * L::VPT; float s = 0.f, s2 = 0.f;
#pragma unroll
      for (int i = 0; i < L::VPT; ++i) { const float o = Of[tl * 133 + v0 + i]; s += o; s2 += o * o; }
#pragma unroll
      for (int m = 1; m < L::TPT; m <<= 1) { s += __shfl_xor(s, m); s2 += __shfl_xor(s2, m); }
      float mean = 0.f, var = s2 * (1.0f / 128.0f);
      if (RET) { mean = s * (1.0f / 128.0f); var = fmaxf(var - mean * mean, 0.f); }
      const float rstd = __builtin_amdgcn_rsqf(var + 1e-5f);
      const bf16* gsrc = RET ? proj + (size_t)(t0 + tl) * NP1 + 1536 + 128 * h + v0 : proj + (size_t)(t0 + tl) * NP0 + 2048 + 128 * h + v0;
      const float* gn = (RET ? p.in[16] : p.in[13]) + 128 * h + v0;
      bf16* dst = RET ? proj + (size_t)(t0 + tl) * NP1 + 128 * h + v0 : (bf16*)(p.ws + WS_Y) + (size_t)(t0 + tl) * 1024 + 512 + 128 * h + v0;
#pragma unroll
      for (int s8 = 0; s8 < L::VPT / 8; ++s8) { float gv[8], o[8]; unpack8(graw[s8], gv); const float gg[8] = {gnr[2 * s8][0], gnr[2 * s8][1], gnr[2 * s8][2], gnr[2 * s8][3], gnr[2 * s8 + 1][0], gnr[2 * s8 + 1][1], gnr[2 * s8 + 1][2], gnr[2 * s8 + 1][3]};
#pragma unroll
          for (int i = 0; i < 8; ++i) { const float x = (Of[tl * 133 + v0 + 8 * s8 + i] - mean) * rstd * gg[i]; o[i] = x * (gv[i] * sigmf(gv[i])); }
          *(v4u*)(dst + 8 * s8) = pack8(o); } }
    __syncthreads();
}

__device__ __forceinline__ void rwkv_prep(PRef p, int gtid, int NGT) {
    const bf16* proj = (const bf16*)(p.ws + WS_PROJ); bf16* alr = (bf16*)(p.ws + WS_ALR); const float* mu = p.in[17];
    for (int it = gtid; it < T * 32; it += NGT) { const int row = it >> 5, c8 = (it & 31) * 8, col = 1536 + c8; float cur[8], prv[8], o[8];
        ld8(proj + (size_t)row * NP1 + 2048 + col, cur);
        if ((row & 2047) != 0) ld8(proj + (size_t)(row - 1) * NP1 + 2048 + col, prv); else {
#pragma unroll
            for (int i = 0; i < 8; ++i) prv[i] = 0.f; }
        float mv[8]; ldf8(mu + col, mv);
#pragma unroll
        for (int i = 0; i < 8; ++i) { const float d = cur[i] + mv[i] * (prv[i] - cur[i]); o[i] = c8 < 64 ? tanh_fast(d) : (c8 < 128 ? d : sigmf(d)); }
        *(v4u*)(alr + (size_t)row * 256 + c8) = pack8(o); }
}
__device__ __forceinline__ float row_sum16(float x) {
    x += __int_as_float(__builtin_amdgcn_update_dpp(0, __float_as_int(x), 0x128, 0xf, 0xf, false));
    x += __int_as_float(__builtin_amdgcn_update_dpp(0, __float_as_int(x), 0x124, 0xf, 0xf, false));
    x += __int_as_float(__builtin_amdgcn_update_dpp(0, __float_as_int(x), 0x122, 0xf, 0xf, false));
    x += __int_as_float(__builtin_amdgcn_update_dpp(0, __float_as_int(x), 0x121, 0xf, 0xf, false));
    return x;
}
constexpr int SC_STR = 344, SC_STEPS = 32;
__device__ __forceinline__ void rwkv_stage(PRef p, LAS float* buf, int b, int h, int part, int ch, int pt,
                                           const float* mur, const float* muk, const float* muv, const float* kkp, const float* kap, const float* rkp, const float* w0p, const float* a0p) {
    const bf16* proj = (const bf16*)(p.ws + WS_PROJ); const bf16* wag = (const bf16*)(p.ws + WS_Y);
    const int tl = pt >> 3, kc = pt & 7, t = SC_STEPS * ch + tl, row = b * SEQ + t, c0 = 64 * h + 8 * kc;
    float r[8], k[8], v[8], pr[8], pk[8], pv[8], e[8], a[8];
    ld8(proj + (size_t)row * NP1 + 2048 + c0, r); ld8(proj + (size_t)row * NP1 + 2560 + c0, k); ld8(proj + (size_t)row * NP1 + 3072 + c0, v);
    if (t > 0) { ld8(proj + (size_t)(row - 1) * NP1 + 2048 + c0, pr); ld8(proj + (size_t)(row - 1) * NP1 + 2560 + c0, pk); ld8(proj + (size_t)(row - 1) * NP1 + 3072 + c0, pv); }
    else {
#pragma unroll
        for (int i = 0; i < 8; ++i) { pr[i] = 0.f; pk[i] = 0.f; pv[i] = 0.f; } }
    ld8(wag + (size_t)row * 1536 + c0, e); ld8(wag + (size_t)row * 1536 + 512 + c0, a);
    float kkr[8], ss = 0.f;
#pragma unroll
    for (int i = 0; i < 8; ++i) { r[i] += mur[i] * (pr[i] - r[i]); k[i] += muk[i] * (pk[i] - k[i]); v[i] += muv[i] * (pv[i] - v[i]); kkr[i] = k[i] * kkp[i]; ss += kkr[i] * kkr[i]; }
    ss += __shfl_xor(ss, 1); ss += __shfl_xor(ss, 2); ss += __shfl_xor(ss, 4);
    const float rn = __builtin_amdgcn_rsqf(ss + 1e-12f);
    LAS float* base = buf + tl * SC_STR; float br = 0.f, kr = 0.f, rkr = 0.f;
    f32x4 o0[2], o1[2], o2[2], o3[2], o4[2];
#pragma unroll
    for (int i = 0; i < 8; ++i) { const float kk = kkr[i] * rn, w = __expf(-e[i]), km = k[i] * (1.0f + (a[i] - 1.0f) * kap[i]), bb = kk * a[i];
        o0[i >> 2][i & 3] = -kk; o1[i >> 2][i & 3] = w * r[i]; o2[i >> 2][i & 3] = w; o3[i >> 2][i & 3] = bb; o4[i >> 2][i & 3] = km;
        br += bb * r[i]; kr += km * r[i]; rkr += r[i] * km * rkp[i]; }
#pragma unroll
    for (int s = 0; s < 2; ++s) { *(LAS f32x4*)(base + 16 * kc + 8 * s) = (f32x4){o0[s][0], o1[s][0], o0[s][1], o1[s][1]}; *(LAS f32x4*)(base + 16 * kc + 8 * s + 4) = (f32x4){o0[s][2], o1[s][2], o0[s][3], o1[s][3]}; *(LAS f32x4*)(base + 128 + 8 * kc + 4 * s) = o2[s];
        *(LAS f32x4*)(base + 192 + 8 * kc + 4 * s) = o3[s]; *(LAS f32x4*)(base + 256 + 8 * kc + 4 * s) = o4[s]; }
    if ((kc >> 1) == part) {
#pragma unroll
        for (int i = 0; i < 8; ++i) base[320 + (kc & 1) * 8 + i] = v[i]; }
#pragma unroll
    for (int m = 1; m < 8; m <<= 1) { br += __shfl_xor(br, m); kr += __shfl_xor(kr, m); rkr += __shfl_xor(rkr, m); }
    if (kc == 0) { base[336] = br; base[337] = kr; if (part == 0) ((float*)(p.ws + WS_RKR))[(size_t)(b * 8 + h) * SEQ + t] = rkr; }
}
__device__ __forceinline__ void rwkv_scan_item(PRef p, LAS unsigned char* lds, int item, int tid, int wave, int lane, bool do_cvt) {
    const int part = item & 3, h = (item >> 2) & 7, b = item >> 5;
    LAS float* buf = (LAS float*)lds; LAS float* ybuf = (LAS float*)(lds + 2 * SC_STEPS * SC_STR * 4);
    bf16* yraw = (bf16*)(p.ws + WS_HB) + (size_t)T * 512;
    constexpr int NCHK = SEQ / SC_STEPS;
    if (wave >= 4) {
        const int pt = tid - 256, kc = pt & 7, c0 = 64 * h + 8 * kc; float mur[8], muk[8], muv[8], kkp[8], kap[8], rkp[8], w0p[8], a0p[8];
#pragma unroll
        for (int i = 0; i < 8; ++i) { mur[i] = p.in[17][c0 + i]; muk[i] = p.in[17][512 + c0 + i]; muv[i] = p.in[17][1024 + c0 + i]; kkp[i] = p.in[23][c0 + i]; kap[i] = p.in[24][c0 + i]; rkp[i] = p.in[25][c0 + i]; w0p[i] = p.in[18][c0 + i]; a0p[i] = p.in[20][c0 + i]; }
        rwkv_stage(p, buf, b, h, part, 0, pt, mur, muk, muv, kkp, kap, rkp, w0p, a0p);
        LAS float* scr = (LAS float*)(lds + 2 * SC_STEPS * SC_STR * 4 + 8192 + (wave - 4) * 8704);
        f32x4 creg[8];
#pragma unroll
        for (int i = 0; i < 8; ++i) creg[i] = (f32x4){0.f, 0.f, 0.f, 0.f};
        for (int ch = 0; ch < NCHK; ++ch) { __syncthreads(); if (ch + 1 < NCHK) rwkv_stage(p, buf + ((ch + 1) & 1) * SC_STEPS * SC_STR, b, h, part, ch + 1, pt, mur, muk, muv, kkp, kap, rkp, w0p, a0p);
#ifndef NO_SCAN_CVT
            if (do_cvt) { const int idx = (int)blockIdx.x * 4 + (wave - 4) + (ch >> 3) * ((int)gridDim.x * 4);
                if ((ch & 7) == 0) { if (idx < CVT1_ITEMS) cvt1_load(p, idx, lane, creg); } else if ((ch & 7) == 1) { if (idx < CVT1_ITEMS) cvt1_store(p, idx, scr, lane, creg); } }
#endif
        }
    } else {
        const int vl = lane >> 4, kg = lane & 15; f32x4 S = {0.f, 0.f, 0.f, 0.f}; LAS float* yb = ybuf + wave * 512;
        bf16* yp = yraw + (size_t)(item * SEQ) * 16;
        for (int ch = 0; ch < NCHK; ++ch) { __syncthreads(); const LAS float* cb = buf + (ch & 1) * SC_STEPS * SC_STR;
            typedef float f32x2 __attribute__((ext_vector_type(2)));
            const LAS float* b0 = cb;
            f32x4 c_nw0 = *(const LAS f32x4*)(b0 + 8 * kg), c_nw1 = *(const LAS f32x4*)(b0 + 8 * kg + 4), c_w = *(const LAS f32x4*)(b0 + 128 + 4 * kg),
                  c_bb = *(const LAS f32x4*)(b0 + 192 + 4 * kg), c_kk = *(const LAS f32x4*)(b0 + 256 + 4 * kg);
            float c_vv = b0[320 + 4 * wave + vl], c_br = b0[336], c_kr = b0[337];
#pragma unroll
            for (int s = 0; s < SC_STEPS; ++s) { const LAS float* base = cb + (s + 1 < SC_STEPS ? s + 1 : s) * SC_STR;
                const f32x4 n_nw0 = *(const LAS f32x4*)(base + 8 * kg), n_nw1 = *(const LAS f32x4*)(base + 8 * kg + 4), n_w = *(const LAS f32x4*)(base + 128 + 4 * kg),
                            n_bb = *(const LAS f32x4*)(base + 192 + 4 * kg), n_kk = *(const LAS f32x4*)(base + 256 + 4 * kg);
                const float n_vv = base[320 + 4 * wave + vl], n_br = base[336], n_kr = base[337];
                const f32x4 tS = S * c_w + c_kk * c_vv;
                f32x2 dd = (f32x2){S[0], S[0]} * (f32x2){c_nw0[0], c_nw0[1]};
                dd = (f32x2){S[1], S[1]} * (f32x2){c_nw0[2], c_nw0[3]} + dd;
                dd = (f32x2){S[2], S[2]} * (f32x2){c_nw1[0], c_nw1[1]} + dd;
                dd = (f32x2){S[3], S[3]} * (f32x2){c_nw1[2], c_nw1[3]} + dd;
                const float d1 = row_sum16(dd.x);
                S = tS + c_bb * d1;
                float d2 = dd.y;
                d2 += __int_as_float(__builtin_amdgcn_update_dpp(0, __float_as_int(d2), 0x128, 0xf, 0xf, false));
                d2 += __int_as_float(__builtin_amdgcn_update_dpp(0, __float_as_int(d2), 0x124, 0xf, 0xf, false));
                yb[(s * 4 + vl) * 4 + (kg & 3)] = d2 + 0.25f * (d1 * c_br + c_vv * c_kr);
                c_nw0 = n_nw0; c_nw1 = n_nw1; c_w = n_w; c_bb = n_bb; c_kk = n_kk; c_vv = n_vv; c_br = n_br; c_kr = n_kr; }
            { const int s = lane >> 1, pr = lane & 1; const f32x4 q0 = *(const LAS f32x4*)(yb + (s * 4 + 2 * pr) * 4), q1 = *(const LAS f32x4*)(yb + (s * 4 + 2 * pr + 1) * 4); const float y0 = (q0[0] + q0[1]) + (q0[2] + q0[3]), y1 = (q1[0] + q1[1]) + (q1[2] + q1[3]);
              *(unsigned*)(yp + (size_t)(SC_STEPS * ch + s) * 16 + 4 * wave + 2 * pr) = pk2(y0, y1); } }
    }
    __syncthreads();
}
__device__ __forceinline__ void rwkv_post(PRef p, int gtid, int NGT) {
    bf16* proj = (bf16*)(p.ws + WS_PROJ); const bf16* wag = (const bf16*)(p.ws + WS_Y); const bf16* yraw = (const bf16*)(p.ws + WS_HB) + (size_t)T * 512; const float* rkr = (const float*)(p.ws + WS_RKR);
    for (int it = gtid; it < T * 64; it += NGT) { const int row = it >> 6, h = (it >> 3) & 7, c0 = 64 * h + 8 * (it & 7); float y[8], v[8], pv[8], g[8], o[8];
        { const int b_ = row >> 11, t_ = row & 2047, j_ = it & 7; ld8(yraw + ((size_t)(((b_ * 8 + h) * 4 + (j_ >> 1)) * SEQ + t_)) * 16 + (j_ & 1) * 8, y); } float s = 0.f;
#pragma unroll
        for (int i = 0; i < 8; ++i) s += y[i];
        s += __shfl_xor(s, 1); s += __shfl_xor(s, 2); s += __shfl_xor(s, 4); const float mean = s * (1.0f / 64.0f); float s2 = 0.f;
#pragma unroll
        for (int i = 0; i < 8; ++i) { y[i] -= mean; s2 += y[i] * y[i]; }
        s2 += __shfl_xor(s2, 1); s2 += __shfl_xor(s2, 2); s2 += __shfl_xor(s2, 4); const float rstd = __builtin_amdgcn_rsqf(s2 * (1.0f / 64.0f) + 64e-5f);
        ld8(proj + (size_t)row * NP1 + 3072 + c0, v);
        if ((row & 2047) != 0) ld8(proj + (size_t)(row - 1) * NP1 + 3072 + c0, pv); else {
#pragma unroll
            for (int i = 0; i < 8; ++i) pv[i] = 0.f; }
        ld8(wag + (size_t)row * 1536 + 1024 + c0, g); const float rk = rkr[(size_t)((row >> 11) * 8 + h) * SEQ + (row & 2047)];
        float mv[8], ng[8]; ldf8(p.in[17] + 1024 + c0, mv); ldf8(p.in[26] + c0, ng);
#pragma unroll
        for (int i = 0; i < 8; ++i) { const float vs = v[i] + mv[i] * (pv[i] - v[i]); o[i] = (y[i] * rstd * ng[i] + rk * vs) * g[i]; }
#ifdef SANITIZE
#pragma unroll
        for (int i = 0; i < 8; ++i) if (!(fabsf(o[i]) < 1e30f)) o[i] = 0.f;
#endif
        *(v4u*)(proj + (size_t)row * NP1 + 512 + c0) = pack8(o); }
}
__device__ __forceinline__ void final_norm(PRef p, int gw, int NGW, int lane) {
    const float* part = pg8::rpart(p.ws, 6); const float* g = p.in[37]; const bf16* hf = (const bf16*)(p.ws + 107 * MiB);
    f32x4 gv[4];
#pragma unroll
    for (int j = 0; j < 4; ++j) gv[j] = *((const f32x4*)g + lane + 64 * j);
    int m = gw; if (m >= T) return;
    v2u cur[4]; float rs = pg8::rs16(part, m);
#pragma unroll
    for (int j = 0; j < 4; ++j) cur[j] = *((const v2u*)(hf + (size_t)m * 1024) + lane + 64 * j);
    for (;;) { const int nx = m + NGW; const bool more = nx < T; v2u nxt[4]; float nrs = rs;
#pragma unroll
        for (int j = 0; j < 4; ++j) nxt[j] = cur[j];
        if (more) { nrs = pg8::rs16(part, nx);
#pragma unroll
            for (int j = 0; j < 4; ++j) nxt[j] = *((const v2u*)(hf + (size_t)nx * 1024) + lane + 64 * j); }
        f32x4* xr = (f32x4*)(p.out + (size_t)m * 1024) + lane;
#pragma unroll
        for (int j = 0; j < 4; ++j) { const v2u hw = cur[j]; f32x4 v = {__uint_as_float(hw.x << 16), __uint_as_float(hw.x & 0xffff0000u), __uint_as_float(hw.y << 16), __uint_as_float(hw.y & 0xffff0000u)}; v = v * rs * gv[j]; xr[64 * j] = v; }
        if (!more) break; m = nx; rs = nrs;
#pragma unroll
        for (int j = 0; j < 4; ++j) cur[j] = nxt[j]; }
}

#define TID (fresh_tid())
#define LANE (TID & 63)
#define WAVE (__builtin_amdgcn_readfirstlane(TID >> 6))
#define GRD (fresh_s((int)gridDim.x))
#define BID (fresh_s((int)blockIdx.x))
#define GW (BID * NWAVES + WAVE)
#define NGW_ (GRD * NWAVES)
#define GTID (BID * NTHREADS + TID)
#define NGT_ (GRD * NTHREADS)
#define GSYNC_CG() cg::this_grid().sync()
#define GSYNC() do { XcdBarrier xb_; xb_.bar = (unsigned*)(FP.ws + WS_XBAR); xb_.x = xb_xcc_id(); xb_.st = (volatile LAS unsigned*)(lds + LDS_XST); xcd_barrier(xb_); } while (0)
#define WSP(off) (FP.ws + (off))
#define ROWSS(i) ((float*)WSP(WS_ROWSS) + (size_t)(i) * T)

template <int li> __device__ __forceinline__ void layer_body(LAS unsigned char* lds) {
        { const int N = li == 0 ? NP0 : NP1; pg8::Gemm g{li == 0 ? (const bf16*)WSP(WS_HB) : (const bf16*)FP.out + (size_t)T * 1024, (const bf16*)WSP(W_IN), T, N, 1024, 1024}; pg8::StaticOrder S; S.init(T, N, GRD, BID);
          pg8::EpiScaleBf16 E{0, li};
          pg8::gemm_phase<pg8::EpiScaleBf16, pg8::StaticOrder, true, true>(lds, g, S, E);
#ifdef PROBE_INPROJ2
          pg8::gemm_phase<pg8::EpiScaleBf16, pg8::StaticOrder, true, true>(lds, g, S, E);
#endif
        }
        GSYNC();
#ifndef NO_MIX
        if (li == 0) {
#ifdef NO_MIX0
            { PRef p = FP; tr_job(p.in[15], NP1, 1024, p.in[28] + 1024, (bf16*)(p.ws + W_IN), NP1, 0, lds, GW, NGW_, WAVE, LANE); }
            GSYNC();
#else
            for (int it = BID; it < 256; it += GRD) lru_local_item(FP, lds, it, TID, WAVE, LANE);
#ifdef PROBE_LRU2
            for (int it = BID; it < 256; it += GRD) lru_local_item(FP, lds, it, TID, WAVE, LANE);
#endif
#ifdef PROBE_GLA2
            for (int it = BID; it < 1024; it += GRD) la_local_item<false>(FP, lds, it, TID, WAVE, LANE);
#endif
            for (int it = BID; it < 1024; it += GRD) la_local_item<false>(FP, lds, it, TID, WAVE, LANE);
            { PRef p = FP; tr_job(p.in[15], NP1, 1024, p.in[28] + 1024, (bf16*)(p.ws + W_IN), NP1, 0, lds, GW, NGW_, WAVE, LANE); }
            GSYNC();
            lru_prefix(FP, GTID, NGT_); la_prefix<false>(FP, GTID, NGT_);
            GSYNC();
            for (int it = BID; it < 1024; it += GRD) la_out_item<false>(FP, lds, it, TID, WAVE, LANE);
#ifdef PROBE_GLAOUT2
            for (int it = BID; it < 1024; it += GRD) la_out_item<false>(FP, lds, it, TID, WAVE, LANE);
#endif
#ifdef PROBE_LRUOUT2
            lru_out(FP, GTID, NGT_);
#endif
            lru_out(FP, GTID, NGT_);
            GSYNC();
#endif
        } else {
#ifdef NO_MIX1
            cvt_layer_weights(FP, 1, lds, GW, NGW_, WAVE, LANE);
            cvt_p(FP, 1, GW, NGW_, LANE);
            GSYNC();
#else
#ifndef NO_RET
            for (int it = BID; it < 512; it += GRD) la_local_item<true>(FP, lds, it, TID, WAVE, LANE);
#endif
#ifdef PROBE_RETLOC2
            for (int it = BID; it < 512; it += GRD) la_local_item<true>(FP, lds, it, TID, WAVE, LANE);
#endif
#ifdef PROBE_CVT2
            cvt_layer_weights(FP, 1, lds, GW, NGW_, WAVE, LANE);
#endif
#ifndef NO_RWKV
            rwkv_prep(FP, GTID, NGT_);
#endif
#ifdef NO_SCAN_CVT
            cvt_layer_weights(FP, 1, lds, GW, NGW_, WAVE, LANE);
            cvt_p(FP, 1, GW, NGW_, LANE);
#endif
            GSYNC();
#ifndef NO_RET
            la_prefix<true>(FP, GTID, NGT_);
#endif
#ifndef NO_RWKV
            { PRef p = FP; pg8::Gemm g{(const bf16*)(p.ws + WS_ALR), (const bf16*)(p.ws + W_LR), T, 1024, 128, 256}; pg8::StaticOrder S; S.init(T, 1024, GRD, BID);
              pg8::EpiLowRank E{0};
              pg8::gemm_phase<pg8::EpiLowRank, pg8::StaticOrder, true, true>(lds, g, S, E); }
            { PRef p = FP; pg8::Gemm g{(const bf16*)(p.ws + WS_ALR) + 128, (const bf16*)(p.ws + W_LR) + 1024 * 128, T, 512, 128, 256}; pg8::StaticOrder S; S.init(T, 512, GRD, BID);
              pg8::EpiLowRank E{1024};
              pg8::gemm_phase<pg8::EpiLowRank, pg8::StaticOrder, true, true>(lds, g, S, E); }
#endif
            GSYNC();
#ifndef NO_RET
            for (int it = BID; it < 512; it += GRD) la_out_item<true>(FP, lds, it, TID, WAVE, LANE);
#endif
#if !defined(NO_RWKV) && !defined(NO_SCAN)
            for (int it = BID; it < 256; it += GRD) rwkv_scan_item(FP, lds, it, TID, WAVE, LANE, it < GRD);
#endif
#ifndef NO_SCAN_CVT
            { const int first = 8 * GRD * 4; for (int idx = first + GW; idx < CVT1_ITEMS; idx += NGW_) cvt1_flat(FP, idx, (LAS float*)(lds + WAVE * 8704), LANE); }
#endif
#ifdef PROBE_SCAN2
            for (int it = BID; it < 256; it += GRD) rwkv_scan_item(FP, lds, it, TID, WAVE, LANE, it < GRD);
#endif
            GSYNC();
#ifndef NO_RWKV
            rwkv_post(FP, GTID, NGT_);
#endif
            GSYNC();
#endif
        }
#endif
        { PRef p = FP;
#if defined(NO_MIX) || defined(NO_MIX0)
          pg8::Gemm g{(const bf16*)(p.ws + WS_PROJ), (const bf16*)(p.ws + W_OUT), T, 1024, 1024, li == 0 ? NP0 : NP1};
#elif defined(NO_MIX1)
          pg8::Gemm g{li == 0 ? (const bf16*)(p.ws + WS_Y) : (const bf16*)(p.ws + WS_PROJ) + 2048, (const bf16*)(p.ws + W_OUT), T, 1024, 1024, li == 0 ? 1024 : NP1};
#else
          pg8::Gemm g{li == 0 ? (const bf16*)(p.ws + WS_Y) : (const bf16*)(p.ws + WS_PROJ), (const bf16*)(p.ws + W_OUT), T, 1024, 1024, li == 0 ? 1024 : NP1};
#endif

          pg8::StaticOrder S; S.init(T, 1024, GRD, BID);
          pg8::EpiResid E{0, li};
          pg8::gemm_phase<pg8::EpiResid, pg8::StaticOrder, true, true>(lds, g, S, E); }
        GSYNC();
        { pg8::Gemm g{(const bf16*)FP.out + (size_t)li * T * 1024, (const bf16*)WSP(W_GU), T, 2 * FF, 1024, 1024}; pg8::StaticOrder S; S.init(T, 2 * FF, GRD, BID);
          pg8::EpiSwiGLU E{li};
          pg8::gemm_phase<pg8::EpiSwiGLU, pg8::StaticOrder, true, true>(lds, g, S, E);
#ifdef PROBE_GU2
          pg8::gemm_phase<pg8::EpiSwiGLU, pg8::StaticOrder, true, true>(lds, g, S, E);
#endif
          { const int G_ = GRD, b_ = BID, half = G_ / 2; pg8::Gemm g2{(const bf16*)WSP(WS_PB), (const bf16*)WSP(W_PP), T, 1024, 256, 256}; pg8::StaticOrder S2;
            if (G_ == 256) S2.init(T, 1024, half, b_ >= half ? b_ - half : (1 << 28)); else S2.init(T, 1024, G_, b_);
            pg8::EpiScaleBf16 E2{1, li};
            pg8::gemm_phase<pg8::EpiScaleBf16, pg8::StaticOrder, true, true>(lds, g2, S2, E2); }
        }
        GSYNC();
        { PRef p = FP; pg8::Gemm g{(const bf16*)(p.ws + WS_PROJ), (const bf16*)(p.ws + W_DN), T, 1024, FF, FF}; pg8::StaticOrder S; S.init(T, 1024, GRD, BID);
          pg8::EpiResid E{1, li};
          pg8::gemm_phase<pg8::EpiResid, pg8::StaticOrder, true, true>(lds, g, S, E); }
        GSYNC();
        { PRef p = FP; pg8::Gemm g{(const bf16*)p.out + (size_t)li * T * 1024, (const bf16*)(p.ws + W_PG), T, 1024, 1024, 1024}; pg8::StaticOrder S; S.init(T, 1024, GRD, BID);
          pg8::EpiPLE E{li};
          pg8::gemm_phase<pg8::EpiPLE, pg8::StaticOrder, true, true>(lds, g, S, E);
#ifdef PROBE_PLE2
          pg8::gemm_phase<pg8::EpiPLE, pg8::StaticOrder, true, true>(lds, g, S, E);
#endif
        }
        GSYNC();
    }

__global__ void __launch_bounds__(NTHREADS, 2) trunk_fwd(Params p_unused) {
    extern __shared__ __attribute__((aligned(16))) unsigned char lds_raw[];
    LAS unsigned char* lds = (LAS unsigned char*)lds_raw;
    if (threadIdx.x < 16) ((volatile LAS unsigned*)(lds + LDS_XST))[threadIdx.x] = 0u;
    __syncthreads();
    (void)xcd_barrier_post((unsigned*)(FP.ws + WS_XBAR), (volatile LAS unsigned*)(lds + LDS_XST));
#ifndef NO_PRO
    phase_prologue(FP, lds, GW, NGW_, WAVE, LANE);
#endif
    GSYNC_CG();
#ifdef PROBE_SYNC10
    for (int i_ = 0; i_ < 10; ++i_) GSYNC();
#endif
#ifdef PROBE_PRO2
    phase_prologue(FP, lds, GW, NGW_, WAVE, LANE);
    GSYNC();
#endif
    layer_body<0>(lds);
    layer_body<1>(lds);
    final_norm(FP, GW, NGW_, LANE);
}

extern "C" void kernel_launch(void* const* d_in, const int* in_sizes, int n_in, void* d_out, int out_size, void* d_ws, size_t ws_size, hipStream_t stream) {
    static int grid = 0;
    if (grid == 0) {
        if (n_in != 38 || ws_size < WS_END) { fprintf(stderr, "kernel_launch: unexpected n_in %d / ws %zu\n", n_in, ws_size); grid = -1; return; }
        int dev = 0, cus = 0, per_cu = 0;
        hipGetDevice(&dev); hipDeviceGetAttribute(&cus, hipDeviceAttributeMultiprocessorCount, dev);
        hipFuncSetAttribute((const void*)trunk_fwd, hipFuncAttributeMaxDynamicSharedMemorySize, LDS_BYTES);
        hipOccupancyMaxActiveBlocksPerMultiprocessor(&per_cu, (const void*)trunk_fwd, NTHREADS, LDS_BYTES);
        (void)hipGetLastError();
        if (per_cu < 1) { fprintf(stderr, "kernel_launch: occupancy query reports %d blocks per CU\n", per_cu); per_cu = 1; }
        grid = cus;
    }
    if (grid < 0) return;
    hipMemsetAsync((char*)d_ws + WS_CTL, 0, CTL_ZERO_BYTES, stream);
    Params prm{};
    for (int i = 0; i < 38; ++i) prm.in[i] = (const float*)d_in[i];
    prm.out = (float*)d_out; prm.ws = (unsigned char*)d_ws;
    void* args[] = {&prm};
    hipError_t e = hipLaunchCooperativeKernel((const void*)trunk_fwd, dim3(grid), dim3(NTHREADS), args, LDS_BYTES, stream);
    if (e != hipSuccess) fprintf(stderr, "cooperative launch failed: %s (grid %d)\n", hipGetErrorString(e), grid);
}
```

```cpp
#include <hip/hip_runtime.h>
#include <hip/hip_cooperative_groups.h>
#include <cstdio>
#include <cstdint>
namespace cg = cooperative_groups;
namespace pg8 {
#define PG8_LAS __attribute__((address_space(3)))
typedef unsigned short bf16_t;
typedef short bf16x8 __attribute__((ext_vector_type(8)));
typedef float f32x4 __attribute__((ext_vector_type(4)));
typedef unsigned u32x4 __attribute__((ext_vector_type(4)));
constexpr int BM = 256, BK = 64, HALF = 128, HTB = HALF * BK * 2  , STAGE_BYTES = 8 * HTB, NXCD = 8, WGM = 8;

__host__ __device__ __forceinline__ int lds_byte(int r, int c) { const int st = (r >> 4) * 2 + (c >> 5), rr = r & 15, cc = c & 31, ob = rr * 64 + cc * 2; return st * 1024 + (ob ^ (((ob >> 9) & 1) << 5)); }
__host__ __device__ __forceinline__ void stage_rc(int b, int& R, int& C) { const int st = b / 1024, sb = b % 1024, swz = sb ^ (((sb >> 9) & 1) << 5); R = (st >> 1) * 16 + swz / 64; C = (st & 1) * 32 + (swz % 64) / 2; }
__host__ __device__ __forceinline__ int perm32(int rho) { const int n = rho >> 4, i = rho & 15; return 8 * (i >> 2) + 4 * n + (i & 3); }

struct Unit { int pm, pn; };
struct Gemm { const bf16_t* A; const bf16_t* Bt; int M, N, K, lda; };

struct StaticOrder {
    int nM, nN, nwg, G, c;
    __host__ __device__ void init(int M, int N, int G_, int c_) { nM = M / BM; nN = N / BM; nwg = nM * nN; G = G_; c = c_; }
    __host__ __device__ bool next(int i, Unit& u) const {
        const long L = (long)i * G + c; if (L >= nwg) return false;
        int wgid = (int)L; { const int q = nwg / NXCD, r = nwg % NXCD, xcd = wgid % NXCD, off = wgid / NXCD; wgid = (xcd < r ? xcd * (q + 1) : r * (q + 1) + (xcd - r) * q) + off; }
        const int nig = WGM * nN, gid = wgid / nig, fm = gid * WGM, gsz = (nM - fm) < WGM ? (nM - fm) : WGM;
        u.pm = fm + ((wgid % nig) % gsz); u.pn = (wgid % nig) / gsz; return true;
    }
    __device__ __forceinline__ void a_ready(const Unit&) const {}
    __device__ __forceinline__ void done(const Unit&) const {}
};

typedef float f32x2p_t __attribute__((ext_vector_type(2))); typedef __bf16 bf16x2p_t __attribute__((ext_vector_type(2)));
__device__ __forceinline__ unsigned cvt_pk_bf16(float lo, float hi) { const f32x2p_t v = {lo, hi}; const bf16x2p_t b = __builtin_convertvector(v, bf16x2p_t); return __builtin_bit_cast(unsigned, b); }
typedef float f32x2 __attribute__((ext_vector_type(2)));
__device__ __forceinline__ f32x2 gelu_pk(f32x2 v) {
    const f32x2 av = __builtin_elementwise_abs(v), d = av * 0.2316418882f + 1.0f;
    f32x2 t; t.x = __builtin_amdgcn_rcpf(d.x); t.y = __builtin_amdgcn_rcpf(d.y);
    f32x2 q = t * 0.5307027145f + (-0.7265760135f); q = q * t + 0.7107068705f; q = q * t + (-0.142248368f); q = q * t + 0.127414796f; q = q * t;
    const f32x2 s = (v * v) * (-0.72134752044f);
    f32x2 e; e.x = __builtin_amdgcn_exp2f(s.x); e.y = __builtin_amdgcn_exp2f(s.y);
    const f32x2 m = v * (q * e), r = v - m;
    f32x2 o; o.x = v.x < 0.f ? m.x : r.x; o.y = v.y < 0.f ? m.y : r.y; return o;
}


}
struct Params { const float* in[38]; float* out; unsigned char* ws; };
typedef const __attribute__((address_space(4))) Params& PRef;
__device__ __forceinline__ const __attribute__((address_space(4))) Params* fresh_params() { unsigned long long ki = (unsigned long long)__builtin_amdgcn_kernarg_segment_ptr(); asm volatile("" : "+s"(ki)); return (const __attribute__((address_space(4))) Params*)ki; }
#define FP (*fresh_params())
constexpr size_t EPI_MiB = 1u << 20;
constexpr size_t E_ROWSS = 65536, E_HB = 35 * EPI_MiB, E_PROJ = 67 * EPI_MiB, E_Y = 187 * EPI_MiB, E_HF = 107 * EPI_MiB;
namespace pg8 {

__device__ __forceinline__ float rs_of(const float* rowss, int row) { return rowss ? __builtin_amdgcn_rsqf(rowss[row] * (1.0f / 1024.0f) + 1e-6f) : 1.0f; }
__device__ __forceinline__ float sigm(float x) { return __builtin_amdgcn_rcpf(1.0f + __expf(-x)); }
constexpr size_t E_RPART = 253 * EPI_MiB;
__device__ __forceinline__ float* rpart(unsigned char* ws, int inst) { return (float*)(ws + E_RPART + ((inst & 1) ? 0 : EPI_MiB)); }
__device__ __forceinline__ float rs16(const float* part, int row) { const f32x4* q = (const f32x4*)(part + (size_t)row * 16); const f32x4 a = q[0], b = q[1], c = q[2], d = q[3];
    const float s = (((a[0] + a[1]) + (a[2] + a[3])) + ((b[0] + b[1]) + (b[2] + b[3]))) + (((c[0] + c[1]) + (c[2] + c[3])) + ((d[0] + d[1]) + (d[2] + d[3])));
    return __builtin_amdgcn_rsqf(s * (1.0f / 1024.0f) + 1e-6f); }

struct EpiScaleBf16 {
    static constexpr bool PERM = true, AFTER_DRAIN = false;
    int mode, li;
    __device__ __forceinline__ void operator()(const f32x4 (&acc)[2][2][4][2], const Unit& u, int wr, int wc, int fr, int fq) const {
        unsigned char* ws = FP.ws; bf16_t* O = (bf16_t*)(ws + (mode == 0 ? E_PROJ : E_Y));   const int ldc = mode == 0 ? (li == 0 ? 2816 : 3840) : (mode == 2 ? 1536 : 1024);
        const float* rowss = (mode == 0 && li == 0) ? (const float*)(ws + E_ROWSS) : nullptr; const float* part = rpart(ws, 3); const bool use16 = (mode == 0 && li == 1);
        const int row0 = u.pm * BM + wr * 64 + fr, col0 = u.pn * BM + wc * 32 + 8 * fq;
#pragma unroll
        for (int ai = 0; ai < 2; ++ai)
#pragma unroll
            for (int m = 0; m < 4; ++m) { const int row = row0 + ai * HALF + m * 16; const float rs = use16 ? rs16(part, row) : rs_of(rowss, row); bf16_t* rowp = O + (size_t)row * ldc + col0;
#pragma unroll
                for (int bj = 0; bj < 2; ++bj) { const f32x4 v0 = acc[ai][bj][m][0] * rs, v1 = acc[ai][bj][m][1] * rs;
                    u32x4 w; w.x = cvt_pk_bf16(v0[0], v0[1]); w.y = cvt_pk_bf16(v0[2], v0[3]); w.z = cvt_pk_bf16(v1[0], v1[1]); w.w = cvt_pk_bf16(v1[2], v1[3]);
                    *(u32x4*)(rowp + bj * HALF) = w; } }
    }
};

__device__ __forceinline__ void unpk8(const u32x4 pw, f32x4& p0, f32x4& p1) {
    p0[0] = __uint_as_float(pw.x << 16); p0[1] = __uint_as_float(pw.x & 0xffff0000u); p0[2] = __uint_as_float(pw.y << 16); p0[3] = __uint_as_float(pw.y & 0xffff0000u);
    p1[0] = __uint_as_float(pw.z << 16); p1[1] = __uint_as_float(pw.z & 0xffff0000u); p1[2] = __uint_as_float(pw.w << 16); p1[3] = __uint_as_float(pw.w & 0xffff0000u);
}
struct EpiResid {
    static constexpr bool PERM = true, AFTER_DRAIN = false;
    int which, li;
    __device__ __forceinline__ void operator()(const f32x4 (&acc)[2][2][4][2], const Unit& u, int wr, int wc, int fr, int fq) const {
        PRef p = FP; unsigned char* ws = p.ws; bf16_t* res = (bf16_t*)p.out + (size_t)li * 16384 * 1024; const float* xin = p.in[0]; const bool from_x = (which == 0 && li == 0);
        float* part = rpart(ws, (which == 0 ? 1 : 2) + 3 * li); const int slot = 4 * u.pn + wc;
        const int row0 = u.pm * BM + wr * 64 + fr, col0 = u.pn * BM + wc * 32 + 8 * fq;
#pragma unroll
        for (int ai = 0; ai < 2; ++ai)
#pragma unroll
            for (int m = 0; m < 4; ++m) { const int row = row0 + ai * HALF + m * 16; float ss = 0.f;
#pragma unroll
                for (int bj = 0; bj < 2; ++bj) { const size_t off = (size_t)row * 1024 + col0 + bj * HALF; f32x4 v0, v1;
                    if (from_x) { v0 = *(const f32x4*)(xin + off); v1 = *(const f32x4*)(xin + off + 4); } else unpk8(*(const u32x4*)(res + off), v0, v1);
                    v0 = v0 + acc[ai][bj][m][0]; v1 = v1 + acc[ai][bj][m][1];
                    u32x4 w; w.x = cvt_pk_bf16(v0[0], v0[1]); w.y = cvt_pk_bf16(v0[2], v0[3]); w.z = cvt_pk_bf16(v1[0], v1[1]); w.w = cvt_pk_bf16(v1[2], v1[3]);
                    *(u32x4*)(res + off) = w;
                    ss += (v0[0] * v0[0] + v0[1] * v0[1]) + (v0[2] * v0[2] + v0[3] * v0[3]) + (v1[0] * v1[0] + v1[1] * v1[1]) + (v1[2] * v1[2] + v1[3] * v1[3]); }
                ss += __shfl_xor(ss, 16); ss += __shfl_xor(ss, 32);
                if (fq == 0) part[(size_t)row * 16 + slot] = ss; asm volatile("" ::: "memory"); }
    }
};

struct EpiSwiGLU {
    static constexpr bool PERM = true, AFTER_DRAIN = false;
    int li;
    __device__ __forceinline__ void operator()(const f32x4 (&acc)[2][2][4][2], const Unit& u, int wr, int wc, int fr, int fq) const {
        typedef unsigned u32x2v __attribute__((ext_vector_type(2)));
        unsigned char* ws = FP.ws; bf16_t* O = (bf16_t*)(ws + E_PROJ); const int ldc = 2816; const float* part = rpart(ws, 1 + 3 * li);
        const int row0 = u.pm * BM + wr * 64 + fr, col0 = u.pn * 128 + wc * 16 + 4 * fq;
#pragma unroll
        for (int ai = 0; ai < 2; ++ai)
#pragma unroll
            for (int m = 0; m < 4; ++m) { const int row = row0 + ai * HALF + m * 16; const float rs = rs16(part, row); bf16_t* rowp = O + (size_t)row * ldc + col0;
#pragma unroll
                for (int bj = 0; bj < 2; ++bj) { const f32x4 g = acc[ai][bj][m][0] * rs, up = acc[ai][bj][m][1] * rs; f32x4 o;
#pragma unroll
                    for (int i = 0; i < 4; ++i) o[i] = g[i] * sigm(g[i]) * up[i];
                    u32x2v w; w.x = cvt_pk_bf16(o[0], o[1]); w.y = cvt_pk_bf16(o[2], o[3]);
                    *(u32x2v*)(rowp + bj * 64) = w; } }
    }
};

struct EpiPLE {
    static constexpr bool PERM = true, AFTER_DRAIN = false;
    int li;
    __device__ __forceinline__ void operator()(const f32x4 (&acc)[2][2][4][2], const Unit& u, int wr, int wc, int fr, int fq) const {
        PRef p = FP; unsigned char* ws = p.ws; const bf16_t* rin = (const bf16_t*)p.out + (size_t)li * 16384 * 1024; bf16_t* rout = (bf16_t*)p.out + (size_t)16384 * 1024; bf16_t* hf = (bf16_t*)(ws + E_HF);
        const bf16_t* pp = (const bf16_t*)(ws + E_Y); const float* bias = p.in[35] + li * 1024;
        const float* rs_in = rpart(ws, 2 + 3 * li); float* part = rpart(ws, 3 + 3 * li); const int slot = 4 * u.pn + wc;
        const int row0 = u.pm * BM + wr * 64 + fr, col0 = u.pn * BM + wc * 32 + 8 * fq;
#pragma unroll
        for (int ai = 0; ai < 2; ++ai)
#pragma unroll
            for (int m = 0; m < 4; ++m) { const int row = row0 + ai * HALF + m * 16; const float rs = rs16(rs_in, row); float ss = 0.f;
#pragma unroll
                for (int bj = 0; bj < 2; ++bj) { const size_t off = (size_t)row * 1024 + col0 + bj * HALF;
                    const f32x4 b0 = *(const f32x4*)(bias + col0 + bj * HALF), b1 = *(const f32x4*)(bias + col0 + bj * HALF + 4);
                    f32x4 p0, p1, v0, v1; unpk8(*(const u32x4*)(pp + off), p0, p1); unpk8(*(const u32x4*)(rin + off), v0, v1);
                    const f32x4 g0 = acc[ai][bj][m][0] * rs + b0, g1 = acc[ai][bj][m][1] * rs + b1;
#pragma unroll
                    for (int i = 0; i < 4; ++i) { v0[i] += sigm(g0[i]) * p0[i]; v1[i] += sigm(g1[i]) * p1[i]; }
                    if (li == 0) { u32x4 w; w.x = cvt_pk_bf16(v0[0], v0[1]); w.y = cvt_pk_bf16(v0[2], v0[3]); w.z = cvt_pk_bf16(v1[0], v1[1]); w.w = cvt_pk_bf16(v1[2], v1[3]); *(u32x4*)(rout + off) = w; }
                    else { u32x4 w; w.x = cvt_pk_bf16(v0[0], v0[1]); w.y = cvt_pk_bf16(v0[2], v0[3]); w.z = cvt_pk_bf16(v1[0], v1[1]); w.w = cvt_pk_bf16(v1[2], v1[3]); *(u32x4*)(hf + off) = w; }
                    ss += (v0[0] * v0[0] + v0[1] * v0[1]) + (v0[2] * v0[2] + v0[3] * v0[3]) + (v1[0] * v1[0] + v1[1] * v1[1]) + (v1[2] * v1[2] + v1[3] * v1[3]); }
                ss += __shfl_xor(ss, 16); ss += __shfl_xor(ss, 32);
                if (fq == 0) part[(size_t)row * 16 + slot] = ss; asm volatile("" ::: "memory"); }
    }
};

typedef float f32x2c_t __attribute__((ext_vector_type(2))); typedef __bf16 bf16x2c_t __attribute__((ext_vector_type(2)));
__device__ __forceinline__ unsigned cvt_pk_b(float lo, float hi) { const f32x2c_t v = {lo, hi}; const bf16x2c_t b = __builtin_convertvector(v, bf16x2c_t); return __builtin_bit_cast(unsigned, b); }
struct EpiLowRank {
    static constexpr bool PERM = true, AFTER_DRAIN = false;
    int goff;
    template <int KIND> __device__ __forceinline__ void run(const f32x4 (&acc)[2][2][4][2], const Unit& u, int wr, int wc, int fr, int fq) const {
        PRef p = FP; bf16_t* O = (bf16_t*)(p.ws + E_Y); const float* bsrc = KIND == 0 ? p.in[18] : p.in[20];
        const int row0 = u.pm * BM + wr * 64 + fr, col0 = u.pn * BM + wc * 32 + 8 * fq + goff;
#pragma unroll
        for (int bj = 0; bj < 2; ++bj) { const int col = col0 + bj * HALF; f32x4 b0 = {0.f, 0.f, 0.f, 0.f}, b1 = {0.f, 0.f, 0.f, 0.f};
            if (KIND < 2) { b0 = *(const f32x4*)(bsrc + (col & 511)); b1 = *(const f32x4*)(bsrc + (col & 511) + 4); }
#pragma unroll
            for (int ai = 0; ai < 2; ++ai)
#pragma unroll
                for (int m = 0; m < 4; ++m) { const int row = row0 + ai * HALF + m * 16; f32x4 v0 = acc[ai][bj][m][0] + b0, v1 = acc[ai][bj][m][1] + b1;
#pragma unroll
                    for (int i = 0; i < 4; ++i) {
                        if (KIND == 0) { const float n0 = -v0[i], n1 = -v1[i]; const float s0 = fmaxf(n0, 0.f) + __logf(1.0f + __expf(-fabsf(n0))), s1 = fmaxf(n1, 0.f) + __logf(1.0f + __expf(-fabsf(n1)));
                            v0[i] = __expf(-s0 - 0.5f); v1[i] = __expf(-s1 - 0.5f); }
                        else if (KIND == 1) { v0[i] = sigm(v0[i]); v1[i] = sigm(v1[i]); } }
                    u32x4 w; w.x = cvt_pk_b(v0[0], v0[1]); w.y = cvt_pk_b(v0[2], v0[3]); w.z = cvt_pk_b(v1[0], v1[1]); w.w = cvt_pk_b(v1[2], v1[3]);
                    *(u32x4*)(O + (size_t)row * 1536 + col) = w; } }
    }
    __device__ __forceinline__ void operator()(const f32x4 (&acc)[2][2][4][2], const Unit& u, int wr, int wc, int fr, int fq) const {
        const int kind = goff ? 2 : (u.pn >> 1);
        if (kind == 0) run<0>(acc, u, wr, wc, fr, fq); else if (kind == 1) run<1>(acc, u, wr, wc, fr, fq); else run<2>(acc, u, wr, wc, fr, fq);
    }
};
template <class Epi, class Sched, bool ALIGN_EPI = false, bool SP2 = false>
__device__ __forceinline__ void gemm_phase(PG8_LAS unsigned char* lds, const Gemm g, const Sched& S, const Epi& E) {
    int tid_l = threadIdx.x; asm volatile("" : "+v"(tid_l));
    const int tid = tid_l, wid = __builtin_amdgcn_readfirstlane(tid >> 6), lane = tid & 63, wr = wid >> 2, wc = wid & 3, fr = lane & 15, fq = lane >> 4;
    const int K = g.K, nt = K / BK, lda = g.lda;
    unsigned voffA[2], voffB[2];
#pragma unroll
    for (int i = 0; i < 2; ++i) { int R, C; stage_rc(tid * 16 + i * 8192, R, C); const int Rb = Epi::PERM ? ((R & ~31) + perm32(R & 31)) : R;
        voffA[i] = (unsigned)(R * lda + C) * 2u; voffB[i] = (unsigned)(Rb * K + C) * 2u; }
    const size_t kstep = (size_t)(BK * 2);
    const size_t hstepB = (size_t)HALF * K * 2, hstepA = (size_t)HALF * lda * 2;
    const size_t tstepB = 2 * hstepB, tstepA = 2 * hstepA;
    const unsigned ldsw = (unsigned)wid * 1024u;
    const int aoff = lds_byte(wr * 64 + fr, fq * 8), boff = lds_byte(wc * 32 + fr, fq * 8);
#define PG8_SA(b, h) (((b) * 2 + (h)) * HTB)
#define PG8_SB(b, h) ((4 + (b) * 2 + (h)) * HTB)
#define PG8_STAGE(bufoff, gbase, voff) do { _Pragma("unroll") for (int _i = 0; _i < 2; ++_i) \
        __builtin_amdgcn_global_load_lds((const unsigned*)((const char*)(gbase) + (voff)[_i]), (PG8_LAS unsigned*)(lds + (bufoff) + ldsw + _i * 8192), 16, 0, 0); } while (0)
#define PG8_LDA(dst, b, h) do { _Pragma("unroll") for (int m = 0; m < 4; ++m) _Pragma("unroll") for (int k = 0; k < 2; ++k) dst[m][k] = *(const PG8_LAS bf16x8*)(lds + PG8_SA(b, h) + aoff + m * 2048 + k * 1024); } while (0)
#define PG8_LDB(dst, b, h) do { _Pragma("unroll") for (int n = 0; n < 2; ++n) _Pragma("unroll") for (int k = 0; k < 2; ++k) dst[n][k] = *(const PG8_LAS bf16x8*)(lds + PG8_SB(b, h) + boff + n * 2048 + k * 1024); } while (0)
#define PG8_MMA(ai, bj, At, Bt) do { __builtin_amdgcn_s_setprio(1); _Pragma("unroll") for (int m = 0; m < 4; ++m) _Pragma("unroll") for (int n = 0; n < 2; ++n) _Pragma("unroll") for (int k = 0; k < 2; ++k) \
        acc[ai][bj][m][n] = __builtin_amdgcn_mfma_f32_16x16x32_bf16(Bt[n][k], At[m][k], acc[ai][bj][m][n], 0, 0, 0); __builtin_amdgcn_s_setprio(0); } while (0)
#define PG8_WAIT_V(n) asm volatile("s_waitcnt vmcnt(" #n ")" ::: "memory")
#define PG8_WAIT_L(n) asm volatile("s_waitcnt lgkmcnt(" #n ")" ::: "memory")
#define PG8_BAR __builtin_amdgcn_s_barrier()
#define PG8_SCHED __builtin_amdgcn_sched_barrier(0)
    Unit cur, nxt; int ui = 0;
    if (!S.next(0, cur)) return;
    f32x4 acc[2][2][4][2];
#pragma unroll
    for (int a = 0; a < 2; ++a)
#pragma unroll
        for (int b = 0; b < 2; ++b)
#pragma unroll
            for (int m = 0; m < 4; ++m)
#pragma unroll
                for (int n = 0; n < 2; ++n) acc[a][b][m][n] = (f32x4){0.f, 0.f, 0.f, 0.f};
    bf16x8 At[4][2], B0[2][2], B1[2][2];
    const char* cA = (const char*)g.A + (size_t)cur.pm * tstepA; const char* cB = (const char*)g.Bt + (size_t)cur.pn * tstepB;
    S.a_ready(cur);
    if constexpr (SP2) {
        PG8_STAGE(PG8_SB(0, 0), cB, voffB); PG8_STAGE(PG8_SB(0, 1), cB + hstepB, voffB); PG8_STAGE(PG8_SA(0, 0), cA, voffA); PG8_STAGE(PG8_SA(0, 1), cA + hstepA, voffA);
        if (wr == 1) PG8_BAR;
        PG8_WAIT_V(2); PG8_BAR;
        PG8_STAGE(PG8_SB(1, 0), cB + kstep, voffB); PG8_STAGE(PG8_SA(1, 0), cA + kstep, voffA); PG8_STAGE(PG8_SB(1, 1), cB + hstepB + kstep, voffB);
        PG8_WAIT_V(6); PG8_BAR;
    } else {
        PG8_STAGE(PG8_SB(0, 0), cB, voffB); PG8_STAGE(PG8_SA(0, 0), cA, voffA); PG8_STAGE(PG8_SB(0, 1), cB + hstepB, voffB); PG8_STAGE(PG8_SA(0, 1), cA + hstepA, voffA);
        if (wr == 1) PG8_BAR;
        PG8_WAIT_V(4); PG8_BAR;
        PG8_STAGE(PG8_SB(1, 0), cB + kstep, voffB); PG8_STAGE(PG8_SA(1, 0), cA + kstep, voffA); PG8_STAGE(PG8_SB(1, 1), cB + hstepB + kstep, voffB);
        PG8_WAIT_V(6); PG8_BAR;
    }
    for (;;) {
        const bool has_next = S.next(ui + 1, nxt);
        const char* nA = has_next ? (const char*)g.A + (size_t)nxt.pm * tstepA : cA; const char* nB = has_next ? (const char*)g.Bt + (size_t)nxt.pn * tstepB : cB;
        for (int t = 0; t < nt; t += 2) {
            const bool last = (t == nt - 2);
            const char* a1 = cA + (size_t)(t + 1) * kstep;
            const char* a2 = last ? nA : cA + (size_t)(t + 2) * kstep; const char* b2 = last ? nB : cB + (size_t)(t + 2) * kstep;
            const char* a3 = a2 + kstep; const char* b3 = b2 + kstep;
            if (last && has_next) S.a_ready(nxt);
            if constexpr (SP2) {
            PG8_LDB(B0, 0, 0); PG8_LDB(B1, 0, 1); PG8_SCHED; PG8_LDA(At, 0, 0); PG8_STAGE(PG8_SA(1, 1), a1 + hstepA, voffA);
            PG8_WAIT_V(8); PG8_WAIT_L(0); PG8_BAR; PG8_MMA(0, 0, At, B0); PG8_MMA(0, 1, At, B1); PG8_BAR; PG8_SCHED;
            PG8_LDA(At, 0, 1); PG8_STAGE(PG8_SB(0, 0), b2, voffB); PG8_STAGE(PG8_SB(0, 1), b2 + hstepB, voffB); PG8_STAGE(PG8_SA(0, 0), a2, voffA);
            PG8_WAIT_V(8); PG8_WAIT_L(0); PG8_BAR; PG8_MMA(1, 0, At, B0); PG8_MMA(1, 1, At, B1); PG8_BAR; PG8_SCHED;
            PG8_LDB(B0, 1, 0); PG8_LDB(B1, 1, 1); PG8_SCHED; PG8_LDA(At, 1, 0); PG8_STAGE(PG8_SA(0, 1), a2 + hstepA, voffA);
            PG8_WAIT_V(8); PG8_WAIT_L(0); PG8_BAR; PG8_MMA(0, 0, At, B0); PG8_MMA(0, 1, At, B1); PG8_BAR; PG8_SCHED;
            PG8_LDA(At, 1, 1); PG8_STAGE(PG8_SB(1, 0), b3, voffB); PG8_STAGE(PG8_SB(1, 1), b3 + hstepB, voffB); PG8_STAGE(PG8_SA(1, 0), a3, voffA);
            PG8_WAIT_V(8); PG8_WAIT_L(0); PG8_BAR; PG8_MMA(1, 0, At, B0); PG8_MMA(1, 1, At, B1); PG8_BAR; PG8_SCHED;
            } else {
            PG8_LDB(B0, 0, 0); PG8_SCHED; PG8_LDA(At, 0, 0); PG8_STAGE(PG8_SA(1, 1), a1 + hstepA, voffA);
            PG8_WAIT_L(8); PG8_BAR; PG8_WAIT_L(0); PG8_MMA(0, 0, At, B0); PG8_BAR; PG8_SCHED;
            PG8_LDB(B1, 0, 1); PG8_STAGE(PG8_SB(0, 0), b2, voffB);
            PG8_BAR; PG8_WAIT_L(0); PG8_MMA(0, 1, At, B1); PG8_BAR;
            PG8_LDA(At, 0, 1); PG8_STAGE(PG8_SA(0, 0), a2, voffA);
            PG8_BAR; PG8_WAIT_L(0); PG8_MMA(1, 0, At, B0); PG8_BAR; PG8_SCHED;
            PG8_STAGE(PG8_SB(0, 1), b2 + hstepB, voffB);
            PG8_WAIT_V(6); PG8_BAR; PG8_MMA(1, 1, At, B1); PG8_BAR;
            PG8_LDB(B0, 1, 0); PG8_SCHED; PG8_LDA(At, 1, 0); PG8_STAGE(PG8_SA(0, 1), a2 + hstepA, voffA);
            PG8_WAIT_L(8); PG8_BAR; PG8_WAIT_L(0); PG8_MMA(0, 0, At, B0); PG8_BAR; PG8_SCHED;
            PG8_LDB(B1, 1, 1); PG8_STAGE(PG8_SB(1, 0), b3, voffB);
            PG8_BAR; PG8_WAIT_L(0); PG8_MMA(0, 1, At, B1); PG8_BAR;
            PG8_LDA(At, 1, 1); PG8_STAGE(PG8_SA(1, 0), a3, voffA);
            PG8_BAR; PG8_WAIT_L(0); PG8_MMA(1, 0, At, B0); PG8_BAR; PG8_SCHED;
            PG8_STAGE(PG8_SB(1, 1), b3 + hstepB, voffB);
            PG8_WAIT_V(6); PG8_BAR; PG8_MMA(1, 1, At, B1); PG8_BAR;
            }
        }
        if constexpr (ALIGN_EPI) { if (wr == 0) PG8_BAR; }
        if constexpr (!Epi::AFTER_DRAIN) { int tl2 = threadIdx.x; asm volatile("" : "+v"(tl2)); E(acc, cur, wr, wc, tl2 & 15, (tl2 & 63) >> 4); S.done(cur); }
        if (!has_next) break;
#pragma unroll
        for (int a = 0; a < 2; ++a)
#pragma unroll
            for (int b = 0; b < 2; ++b)
#pragma unroll
                for (int m = 0; m < 4; ++m)
#pragma unroll
                    for (int n = 0; n < 2; ++n) acc[a][b][m][n] = (f32x4){0.f, 0.f, 0.f, 0.f};
        cur = nxt; cA = nA; cB = nB; ++ui;
        if constexpr (ALIGN_EPI) { if (wr == 1) PG8_BAR; }
    }
    PG8_WAIT_V(0);
    if constexpr (!ALIGN_EPI) { if (wr == 0) PG8_BAR; }
    PG8_BAR;
    if constexpr (Epi::AFTER_DRAIN) { E.fused(acc, cur, wr, wc, fr, fq, lds, wid, lane); S.done(cur); }
#undef PG8_SA
#undef PG8_SB
#undef PG8_STAGE
#undef PG8_LDA
#undef PG8_LDB
#undef PG8_MMA
#undef PG8_WAIT_V
#undef PG8_WAIT_L
#undef PG8_BAR
#undef PG8_SCHED
}
}

#define LAS __attribute__((address_space(3)))
typedef unsigned short bf16;
typedef unsigned v4u __attribute__((ext_vector_type(4)));
typedef unsigned v2u __attribute__((ext_vector_type(2)));
typedef float f32x4 __attribute__((ext_vector_type(4)));
typedef short bf16x8 __attribute__((ext_vector_type(8)));

constexpr int T = 16384, SEQ = 2048, NP0 = 2816, NP1 = 3840, FF = 2816;
constexpr int NTHREADS = 512, NWAVES = 8;
constexpr int LDS_BYTES = 147456;
constexpr size_t MiB = 1u << 20;
constexpr size_t WS_CTL = 0, CTL_ZERO_BYTES = 65536;
constexpr size_t WS_ROWSS = 65536;
constexpr size_t WS_CARRY = 512 * 1024;
constexpr size_t WS_W = 1 * MiB;
constexpr size_t W_IN = WS_W, W_OUT = W_IN + 7680 * 1024, W_GU = W_OUT + 2 * MiB, W_DN = W_GU + 11 * MiB, W_PG = W_DN + 5632 * 1024, W_PP = W_PG + 2 * MiB,
                 W_LR = W_PP + 512 * 1024, W_LRU = W_LR + 768 * 1024, W_END = W_LRU + 128 * 1024;
static_assert(W_END <= 35 * MiB, "weights region");
constexpr size_t WS_HB = 35 * MiB;
constexpr size_t WS_PROJ = 67 * MiB;
constexpr size_t WS_Y = 187 * MiB;
constexpr size_t WS_GST = 219 * MiB;
constexpr size_t WS_ALR = 235 * MiB;
constexpr size_t WS_PB = 243 * MiB;
constexpr size_t WS_RKR = 251 * MiB;
constexpr size_t WS_GDEC = WS_RKR + 512 * 1024;
constexpr size_t WS_LEND = 252 * MiB;
constexpr size_t WS_END = 256 * MiB;

static_assert(E_ROWSS == WS_ROWSS && E_HB == WS_HB && E_PROJ == WS_PROJ && E_Y == WS_Y, "epilogue offsets");

__device__ __forceinline__ int fresh_s(int x) { asm volatile("" : "+s"(x)); return x; }
__device__ __forceinline__ int fresh_tid() { int t = threadIdx.x; asm volatile("" : "+v"(t)); return t; }
__device__ __forceinline__ float bf2f(unsigned v) { return __uint_as_float(v << 16); }
typedef float f32x2_t __attribute__((ext_vector_type(2))); typedef __bf16 bf16x2_t __attribute__((ext_vector_type(2)));
__device__ __forceinline__ unsigned pk2(float lo, float hi) { const f32x2_t v = {lo, hi}; const bf16x2_t b = __builtin_convertvector(v, bf16x2_t); return __builtin_bit_cast(unsigned, b); }
__device__ __forceinline__ unsigned f2bf(float f) { return pk2(f, f) & 0xffffu; }
__device__ __forceinline__ void unpack8(const v4u w, float* f) {
    f[0] = __uint_as_float(w.x << 16); f[1] = __uint_as_float(w.x & 0xffff0000u); f[2] = __uint_as_float(w.y << 16); f[3] = __uint_as_float(w.y & 0xffff0000u);
    f[4] = __uint_as_float(w.z << 16); f[5] = __uint_as_float(w.z & 0xffff0000u); f[6] = __uint_as_float(w.w << 16); f[7] = __uint_as_float(w.w & 0xffff0000u);
}
__device__ __forceinline__ v4u pack8(const float* f) { v4u w; w.x = pk2(f[0], f[1]); w.y = pk2(f[2], f[3]); w.z = pk2(f[4], f[5]); w.w = pk2(f[6], f[7]); return w; }
__device__ __forceinline__ void ld8(const bf16* p, float* f) { unpack8(*(const v4u*)p, f); }
__device__ __forceinline__ void ldf8(const float* p, float* f) { const f32x4 a = *(const f32x4*)p, b = *(const f32x4*)(p + 4); f[0] = a[0]; f[1] = a[1]; f[2] = a[2]; f[3] = a[3]; f[4] = b[0]; f[5] = b[1]; f[6] = b[2]; f[7] = b[3]; }
__device__ __forceinline__ float sigmf(float x) { return __builtin_amdgcn_rcpf(1.0f + __expf(-x)); }
__device__ __forceinline__ float logsigf(float z) { return fminf(z, 0.f) - __logf(1.0f + __expf(-fabsf(z))); }
__device__ __forceinline__ float wave_sum(float v) {
#pragma unroll
    for (int o = 1; o < 64; o <<= 1) v += __shfl_xor(v, o);
    return v;
}
#define LDS_WAIT() asm volatile("s_waitcnt lgkmcnt(0)" ::: "memory")

#define XB_TMO      128
#define XB_XCNT(j)  (256  + 64 * (j))
#define XB_XSUB(j)  (1280 + 64 * (j))
#define XB_XGEN(j)  (2304 + 64 * (j))
#define XB_TOP      3328
#define XB_TOPGEN   3392
#define XCD_BAR_WORDS 3456
#define XB_SPIN_CAP (1u << 18)

__device__ __forceinline__ unsigned xb_ld(unsigned* p)              { return __hip_atomic_load(p, __ATOMIC_RELAXED, __HIP_MEMORY_SCOPE_AGENT); }
__device__ __forceinline__ unsigned xb_add(unsigned* p, unsigned v) { return __hip_atomic_fetch_add(p, v, __ATOMIC_RELAXED, __HIP_MEMORY_SCOPE_AGENT); }
__device__ __forceinline__ unsigned xb_xcc_id() { return (unsigned)__builtin_amdgcn_s_getreg((3 << 11) | 20) & 0xFu; }
#define XB_SPIN(cond, bar) do { unsigned _sp = 0; while (cond) { __builtin_amdgcn_s_sleep(1); \
    if ((++_sp & 255u) == 0u) { if (xb_ld(&(bar)[XB_TMO])) break; if (_sp > XB_SPIN_CAP) { atomicAdd(&(bar)[XB_TMO], 1u); break; } } } } while (0)

struct XcdBarrier {
    unsigned* bar; unsigned x;
    volatile LAS unsigned* st;
};

__device__ __forceinline__ XcdBarrier xcd_barrier_post(unsigned* bar, volatile LAS unsigned* st) {
    XcdBarrier b; b.bar = bar; b.x = xb_xcc_id(); b.st = st;
    if (threadIdx.x == 0) (void)xb_add(&bar[XB_XCNT(b.x)], 1u);
    return b;
}
__device__ __forceinline__ void xcd_barrier_complete(unsigned* bar, unsigned x, unsigned& nloc, unsigned& nx) {
    const unsigned G = gridDim.x * gridDim.y * gridDim.z;
    unsigned sum, cnt, mine, sp = 0u;
    for (;;) {
        sum = 0u; cnt = 0u; mine = 0u;
#pragma unroll
        for (unsigned j = 0; j < 16; ++j) { const unsigned c = xb_ld(&bar[XB_XCNT(j)]); sum += c; cnt += (c > 0u) ? 1u : 0u; mine = (j == x) ? c : mine; }
        if (sum == G) break;
        __builtin_amdgcn_s_sleep(1);
        if ((++sp & 255u) == 0u) { if (xb_ld(&bar[XB_TMO])) break; if (sp > XB_SPIN_CAP) { atomicAdd(&bar[XB_TMO], 1u); break; } }
    }
    nloc = mine > 0u ? mine : 1u; nx = cnt > 0u ? cnt : 1u;
}

__device__ __forceinline__ void xcd_barrier(const XcdBarrier& b) {
    asm volatile("s_waitcnt vmcnt(0)" ::: "memory");
    __syncthreads();
    if (threadIdx.x == 0) {
        unsigned* bar = b.bar;
        __builtin_amdgcn_s_waitcnt(0);
        unsigned nloc = b.st[0], nx = b.st[1];
        if (nloc == 0u) { xcd_barrier_complete(bar, b.x, nloc, nx); b.st[0] = nloc; b.st[1] = nx; }
        const unsigned old = xb_add(&bar[XB_XSUB(b.x)], 1u);
        const unsigned gen = old / nloc;
        if (old + 1u == (gen + 1u) * nloc) {
            __builtin_amdgcn_fence(__ATOMIC_RELEASE, "agent");
            asm volatile("s_waitcnt vmcnt(0)" ::: "memory");
            const unsigned og = xb_add(&bar[XB_TOP], 1u);
            const unsigned tg = og / nx;
            if (og + 1u == (tg + 1u) * nx) xb_add(&bar[XB_TOPGEN], 1u);
            else XB_SPIN(xb_ld(&bar[XB_TOPGEN]) == tg, bar);
            __builtin_amdgcn_fence(__ATOMIC_ACQUIRE, "agent");
            xb_add(&bar[XB_XGEN(b.x)], 1u);
            asm volatile("s_waitcnt vmcnt(0)" ::: "memory");
        } else {
            XB_SPIN(xb_ld(&bar[XB_XGEN(b.x)]) == gen, bar);
            __builtin_amdgcn_fence(__ATOMIC_ACQUIRE, "agent");
            asm volatile("s_waitcnt vmcnt(0)" ::: "memory");
        }
    }
    __syncthreads();
}

constexpr size_t WS_XBAR = 16384;
constexpr int LDS_XST = LDS_BYTES - 64;

__device__ __forceinline__ f32x4 mma_ll(const LAS bf16* X, int ldx, const LAS bf16* Y, int ldy, int K, f32x4 acc, int lane) {
    const LAS bf16* xp = X + (lane & 15) * ldx + 8 * (lane >> 4);
    const LAS bf16* yp = Y + (lane & 15) * ldy + 8 * (lane >> 4);
    for (int k = 0; k < K; k += 32) {
        const bf16x8 a = *(const LAS bf16x8*)(xp + k), b = *(const LAS bf16x8*)(yp + k);
        acc = __builtin_amdgcn_mfma_f32_16x16x32_bf16(a, b, acc, 0, 0, 0);
    }
    return acc;
}
__device__ __forceinline__ f32x4 mma_lg(const LAS bf16* X, int ldx, const bf16* Y, int ldy, int K, f32x4 acc, int lane) {
    const LAS bf16* xp = X + (lane & 15) * ldx + 8 * (lane >> 4);
    const bf16* yp = Y + (size_t)(lane & 15) * ldy + 8 * (lane >> 4);
    for (int k = 0; k < K; k += 32) {
        const bf16x8 a = *(const LAS bf16x8*)(xp + k), b = *(const bf16x8*)(yp + k);
        acc = __builtin_amdgcn_mfma_f32_16x16x32_bf16(a, b, acc, 0, 0, 0);
    }
    return acc;
}

__device__ __forceinline__ void tr_load(const float* W, int ldw, const float* gain, int ncols, int item, int lane, f32x4 (&v)[8]) {
    const int nblk = ncols / 32, kb = item / nblk, nb = item % nblk, k0 = 64 * kb, n0 = 32 * nb;
#pragma unroll
    for (int i = 0; i < 8; ++i) { const int kk = 8 * i + (lane >> 3), cc = (lane & 7) * 4; v[i] = *(const f32x4*)(W + (size_t)(k0 + kk) * ldw + n0 + cc); if (gain) v[i] = v[i] * gain[k0 + kk]; }
}
__device__ __forceinline__ void tr_store(int K, bf16* WT, int ncols, int mode, LAS float* scr, int item, int lane, const f32x4 (&v)[8]) {
    const int nblk = ncols / 32, kb = item / nblk, nb = item % nblk, k0 = 64 * kb, n0 = 32 * nb;
#pragma unroll
    for (int i = 0; i < 8; ++i) { const int kk = 8 * i + (lane >> 3), cc = (lane & 7) * 4; scr[kk * 33 + cc] = v[i].x; scr[kk * 33 + cc + 1] = v[i].y; scr[kk * 33 + cc + 2] = v[i].z; scr[kk * 33 + cc + 3] = v[i].w; }
    LDS_WAIT(); asm volatile("" ::: "memory");
    const int c = lane & 7;
#pragma unroll
    for (int j = 0; j < 4; ++j) { const int n = (lane >> 3) + 8 * j; const LAS float* s = scr + (8 * c) * 33 + n;
        v4u o; o.x = pk2(s[0 * 33], s[1 * 33]); o.y = pk2(s[2 * 33], s[3 * 33]); o.z = pk2(s[4 * 33], s[5 * 33]); o.w = pk2(s[6 * 33], s[7 * 33]);
        const int nn = n0 + n; const int r = mode == 0 ? nn : (8 * (nn >> 2) + (nn & 3) + (mode == 2 ? 4 : 0));
        *(v4u*)(WT + (size_t)r * K + k0 + 8 * c) = o; }
    LDS_WAIT(); asm volatile("" ::: "memory");
}
__device__ __forceinline__ void tr_item(const float* W, int ldw, int K, const float* gain, bf16* WT, int ncols, int mode, LAS float* scr, int item, int lane) {
    f32x4 v[8]; tr_load(W, ldw, gain, ncols, item, lane, v); tr_store(K, WT, ncols, mode, scr, item, lane, v);
}
__device__ __forceinline__ void tr_job(const float* W, int ldw, int K, const float* gain, bf16* WT, int ncols, int mode, LAS unsigned char* lds, int gw, int NGW, int wave, int lane) {
    LAS float* scr = (LAS float*)(lds + wave * 8704);
    const int nitems = (K / 64) * (ncols / 32);
    for (int it = gw; it < nitems; it += NGW) tr_item(W, ldw, K, gain, WT, ncols, mode, scr, it, lane);
}
__device__ __forceinline__ void cvt_layer_weights(PRef p, int li, LAS unsigned char* lds, int gw, int NGW, int wave, int lane) {
    unsigned char* ws = p.ws;
    tr_job(li == 0 ? p.in[14] : p.in[27], 1024, 1024, nullptr, (bf16*)(ws + W_OUT), 1024, 0, lds, gw, NGW, wave, lane);
    tr_job(p.in[30] + (size_t)li * 1024 * FF, FF, 1024, p.in[29] + li * 1024, (bf16*)(ws + W_GU), FF, 1, lds, gw, NGW, wave, lane);
    tr_job(p.in[31] + (size_t)li * 1024 * FF, FF, 1024, p.in[29] + li * 1024, (bf16*)(ws + W_GU), FF, 2, lds, gw, NGW, wave, lane);
    tr_job(p.in[32] + (size_t)li * FF * 1024, 1024, FF, nullptr, (bf16*)(ws + W_DN), 1024, 0, lds, gw, NGW, wave, lane);
    tr_job(p.in[34] + (size_t)li * 1024 * 1024, 1024, 1024, p.in[33] + li * 1024, (bf16*)(ws + W_PG), 1024, 0, lds, gw, NGW, wave, lane);
    tr_job(p.in[36] + (size_t)li * 256 * 1024, 1024, 256, nullptr, (bf16*)(ws + W_PP), 1024, 0, lds, gw, NGW, wave, lane);
}
__device__ __forceinline__ void cvt_p(PRef p, int li, int gw, int NGW, int lane) {
    const float* src = p.in[1] + (size_t)li * T * 256; bf16* pb = (bf16*)(p.ws + WS_PB);
    for (int m = gw; m < T; m += NGW) { const f32x4 v = *((const f32x4*)(src + (size_t)m * 256) + lane); v2u o; o.x = pk2(v.x, v.y); o.y = pk2(v.z, v.w); *((v2u*)(pb + (size_t)m * 256) + lane) = o; }
}

constexpr int CVT1_ITEMS = 512 + 3 * 1408 + 512 + 128 + 1024;
struct Cvt1Job { const float* W; const float* gain; bf16* WT; int ldw, K, ncols, mode, item; };
__device__ __forceinline__ Cvt1Job cvt1_job(PRef p, int idx) {
    unsigned char* ws = p.ws; Cvt1Job j;
    if (idx < 512) { j = Cvt1Job{p.in[27], nullptr, (bf16*)(ws + W_OUT), 1024, 1024, 1024, 0, idx}; return j; } idx -= 512;
    if (idx < 1408) { j = Cvt1Job{p.in[30] + (size_t)1024 * FF, p.in[29] + 1024, (bf16*)(ws + W_GU), FF, 1024, FF, 1, idx}; return j; } idx -= 1408;
    if (idx < 1408) { j = Cvt1Job{p.in[31] + (size_t)1024 * FF, p.in[29] + 1024, (bf16*)(ws + W_GU), FF, 1024, FF, 2, idx}; return j; } idx -= 1408;
    if (idx < 1408) { j = Cvt1Job{p.in[32] + (size_t)FF * 1024, nullptr, (bf16*)(ws + W_DN), 1024, FF, 1024, 0, idx}; return j; } idx -= 1408;
    if (idx < 512) { j = Cvt1Job{p.in[34] + (size_t)1024 * 1024, p.in[33] + 1024, (bf16*)(ws + W_PG), 1024, 1024, 1024, 0, idx}; return j; } idx -= 512;
    j = Cvt1Job{p.in[36] + (size_t)256 * 1024, nullptr, (bf16*)(ws + W_PP), 1024, 256, 1024, 0, idx}; return j;
}
constexpr int CVT1_W_ITEMS = CVT1_ITEMS - 1024;
__device__ __forceinline__ void cvt1_load(PRef p, int idx, int lane, f32x4 (&v)[8]) {
    if (idx < CVT1_W_ITEMS) { const Cvt1Job j = cvt1_job(p, idx); tr_load(j.W, j.ldw, j.gain, j.ncols, j.item, lane, v); }
    else { const float* src = p.in[1] + (size_t)T * 256 + (size_t)(idx - CVT1_W_ITEMS) * 16 * 256;
#pragma unroll
        for (int r = 0; r < 8; ++r) v[r] = *((const f32x4*)(src + (size_t)r * 256) + lane); }
}
__device__ __forceinline__ void cvt1_store(PRef p, int idx, LAS float* scr, int lane, const f32x4 (&v)[8]) {
    if (idx < CVT1_W_ITEMS) { const Cvt1Job j = cvt1_job(p, idx); tr_store(j.K, j.WT, j.ncols, j.mode, scr, j.item, lane, v); }
    else { const int m0 = (idx - CVT1_W_ITEMS) * 16; const float* src = p.in[1] + (size_t)T * 256; bf16* pb = (bf16*)(p.ws + WS_PB);
#pragma unroll
        for (int r = 0; r < 8; ++r) { v2u o; o.x = pk2(v[r].x, v[r].y); o.y = pk2(v[r].z, v[r].w); *((v2u*)(pb + (size_t)(m0 + r) * 256) + lane) = o; }
        for (int r = 8; r < 16; ++r) { const f32x4 w = *((const f32x4*)(src + (size_t)(m0 + r) * 256) + lane); v2u o; o.x = pk2(w.x, w.y); o.y = pk2(w.z, w.w); *((v2u*)(pb + (size_t)(m0 + r) * 256) + lane) = o; } }
}
__device__ __forceinline__ void cvt1_flat(PRef p, int idx, LAS float* scr, int lane) { f32x4 v[8]; cvt1_load(p, idx, lane, v); cvt1_store(p, idx, scr, lane, v); }
__device__ __forceinline__ void phase_prologue(PRef p, LAS unsigned char* lds, int gw, int NGW, int wave, int lane) {
    unsigned char* ws = p.ws; const int gtid = gw * 64 + lane, NGT = NGW * 64;
    tr_job(p.in[3], 2576, 1024, p.in[28], (bf16*)(ws + W_IN), 2560, 0, lds, gw, NGW, wave, lane);
    for (int wi = gw; wi < 2048; wi += NGW) if ((wi & 3) == 0) {
        const int it = (wi >> 2) * 64 + lane, n = it >> 7, kc = it & 127; float o[8], wg[16];
#pragma unroll
        for (int r = 0; r < 16; ++r) wg[r] = p.in[11][r * 256 + n];
#pragma unroll
        for (int i = 0; i < 8; ++i) { const int k = 8 * kc + i; const f32x4* wr = (const f32x4*)(p.in[3] + (size_t)k * 2576 + 2560); const f32x4 a = wr[0], b = wr[1], c = wr[2], d = wr[3];
            const float s_ = ((a[0] * wg[0] + a[1] * wg[1]) + (a[2] * wg[2] + a[3] * wg[3])) + ((b[0] * wg[4] + b[1] * wg[5]) + (b[2] * wg[6] + b[3] * wg[7]))
                           + ((c[0] * wg[8] + c[1] * wg[9]) + (c[2] * wg[10] + c[3] * wg[11])) + ((d[0] * wg[12] + d[1] * wg[13]) + (d[2] * wg[14] + d[3] * wg[15]));
            o[i] = s_ * p.in[28][k]; }
        *(v4u*)((bf16*)(ws + W_IN) + (size_t)(2560 + n) * 1024 + 8 * kc) = pack8(o); }
    cvt_layer_weights(p, 0, lds, gw, NGW, wave, lane);
    for (int wi = gw; wi < 2048; wi += NGW) if ((wi % 5) == 1 && (wi / 5) < 384) { const int it = (wi / 5) * 64 + lane, n = it >> 4, kc = it & 15; float o[8];
#pragma unroll
        for (int i = 0; i < 8; ++i) { const int k = 8 * kc + i; float v = 0.f;
            if (n < 512) { if (k < 64) v = p.in[19][k * 512 + n]; }
            else if (n < 1024) { if (k >= 64) v = p.in[21][(k - 64) * 512 + (n - 512)]; }
            else v = p.in[22][k * 512 + (n - 1024)];
            o[i] = v; }
        *(v4u*)((bf16*)(ws + W_LR) + (size_t)n * 128 + 8 * kc) = pack8(o); }
    for (int wi = gw; wi < 2048; wi += NGW) if ((wi & 15) == 2) { const int it = (wi >> 4) * 64 + lane; const int ic = it & 7, j = (it >> 3) & 63, g = (it >> 9) & 7, which = it >> 12;   const float* src = which ? p.in[8] : p.in[6]; float o[8];
#pragma unroll
        for (int i = 0; i < 8; ++i) o[i] = src[(g * 64 + 8 * ic + i) * 64 + j];
        *(v4u*)((bf16*)(ws + W_LRU) + (size_t)which * 32768 + (g * 64 + j) * 64 + 8 * ic) = pack8(o); }
    { const float* x = p.in[0]; bf16* hb = (bf16*)(ws + WS_HB); float* rss = (float*)(ws + WS_ROWSS);
      for (int m = gw; m < T; m += NGW) { const f32x4* xr = (const f32x4*)(x + (size_t)m * 1024) + lane; float s = 0.f; v2u* o8 = (v2u*)(hb + (size_t)m * 1024) + lane;
#pragma unroll
          for (int j = 0; j < 4; ++j) { const f32x4 v = xr[64 * j]; s += (v.x * v.x + v.y * v.y) + (v.z * v.z + v.w * v.w); v2u o; o.x = pk2(v.x, v.y); o.y = pk2(v.z, v.w); o8[64 * j] = o; }
          s = wave_sum(s); if (lane == 0) rss[m] = s; } }
    cvt_p(p, 0, gw, NGW, lane);
}

__device__ __forceinline__ void lru_local_item(PRef p, LAS unsigned char* lds, int item, int tid, int wave, int lane) {
    const int c = item & 31, b = item >> 5;
    const bf16* proj = (const bf16*)(p.ws + WS_PROJ);
    constexpr int LX = 520;
    constexpr int LR = 65;
    LAS bf16* Xs = (LAS bf16*)lds; LAS float* R = (LAS float*)(lds + 66560); LAS float* I = (LAS float*)(lds + 66560 + 16640);
    LAS float* SEGH = (LAS float*)(lds + 66560 + 33280); LAS float* SEGP = SEGH + 512;
    const int tl = tid >> 3, c8 = (tid & 7) * 8, t0 = b * SEQ + 64 * c;
    LAS float* LS = SEGP + 512; LAS float* BR = LS + 512; LAS float* BI = BR + 512; LAS float* CARH = BI + 512; LAS float* CARP = CARH + 512;
    LS[tid] = logsigf(p.in[10][tid]); BR[tid] = p.in[7][tid]; BI[tid] = p.in[9][tid];
#pragma unroll 2
    for (int g = 0; g < 8; ++g) { const int ch0 = 64 * g + c8; f32x4 a0 = *(const f32x4*)(p.in[5] + ch0), a1 = *(const f32x4*)(p.in[5] + ch0 + 4);
#pragma unroll
        for (int k = 0; k < 4; ++k) { const int tt = 64 * c + tl - 3 + k; if (tt >= 0) { float xv[8]; ld8(proj + (size_t)(b * SEQ + tt) * NP0 + ch0, xv);
                const f32x4 w0 = *(const f32x4*)(p.in[4] + k * 512 + ch0), w1 = *(const f32x4*)(p.in[4] + k * 512 + ch0 + 4);
                a0 = a0 + w0 * (f32x4){xv[0], xv[1], xv[2], xv[3]}; a1 = a1 + w1 * (f32x4){xv[4], xv[5], xv[6], xv[7]}; } }
        const float av[8] = {a0[0], a0[1], a0[2], a0[3], a1[0], a1[1], a1[2], a1[3]};
        *(LAS v4u*)(Xs + tl * LX + ch0) = pack8(av); }
    __syncthreads();
    const int rt = wave & 3, gate = wave >> 2, q = lane >> 4;
    const bf16* WTb = (const bf16*)(p.ws + W_LRU) + gate * 32768 + (size_t)(lane & 15) * 64 + 8 * q;
    bf16x8 wf[4][2];
#pragma unroll
    for (int ct = 0; ct < 4; ++ct) { wf[ct][0] = *(const bf16x8*)(WTb + 16 * ct * 64); wf[ct][1] = *(const bf16x8*)(WTb + 16 * ct * 64 + 32); }
    for (int g = 0; g < 8; ++g) { const int ch0 = 64 * g + c8;
        { LAS float* dst = gate ? I : R; const LAS float* bias = gate ? BI : BR;
          const LAS bf16* xp = Xs + (16 * rt + (lane & 15)) * LX + 64 * g + 8 * q; const bf16x8 a0 = *(const LAS bf16x8*)xp, a1 = *(const LAS bf16x8*)(xp + 32);
          f32x4 acc[4];
#pragma unroll
          for (int ct = 0; ct < 4; ++ct) { acc[ct] = (f32x4){0.f, 0.f, 0.f, 0.f}; acc[ct] = __builtin_amdgcn_mfma_f32_16x16x32_bf16(a0, wf[ct][0], acc[ct], 0, 0, 0); acc[ct] = __builtin_amdgcn_mfma_f32_16x16x32_bf16(a1, wf[ct][1], acc[ct], 0, 0, 0); }
          { const int gn = g < 7 ? g + 1 : 7;
#pragma unroll
            for (int ct = 0; ct < 4; ++ct) { wf[ct][0] = *(const bf16x8*)(WTb + gn * 4096 + 16 * ct * 64); wf[ct][1] = *(const bf16x8*)(WTb + gn * 4096 + 16 * ct * 64 + 32); } }
#pragma unroll
          for (int ct = 0; ct < 4; ++ct) { const int ch = 16 * ct + (lane & 15); const float bv = bias[64 * g + ch];
#pragma unroll
              for (int j = 0; j < 4; ++j) dst[(16 * rt + 4 * q + j) * LR + ch] = sigmf(acc[ct][j] + bv); } }
        __syncthreads();
        {
#pragma unroll
          for (int i = 0; i < 8; ++i) { const float r = R[tl * LR + c8 + i], ii = I[tl * LR + c8 + i], xc = bf2f(Xs[tl * LX + ch0 + i]);
              const float la = 8.0f * r * LS[ch0 + i]; const float a = __expf(la); const float u = __builtin_amdgcn_sqrtf(fmaxf(1.0f - a * a, 0.f)) * (ii * xc);
              R[tl * LR + c8 + i] = a; I[tl * LR + c8 + i] = u; } }
        __syncthreads();
        { const int ch = tid & 63, seg = tid >> 6; float h = 0.f, P = 1.f;
#pragma unroll
          for (int t = 8 * seg; t < 8 * seg + 8; ++t) { const float a = R[t * LR + ch], u = I[t * LR + ch]; h = a * h + u; P *= a; I[t * LR + ch] = h; R[t * LR + ch] = P; }
          SEGH[seg * 64 + ch] = h; SEGP[seg * 64 + ch] = P; }
        __syncthreads();
        { const int ch = tid & 63, seg = tid >> 6; float ch_ = 0.f, cp_ = 1.f;
#pragma unroll
          for (int s2 = 0; s2 < 7; ++s2) { const float sp = SEGP[s2 * 64 + ch], sh = SEGH[s2 * 64 + ch]; if (s2 < seg) { ch_ = sp * ch_ + sh; cp_ *= sp; } }
          CARH[seg * 64 + ch] = ch_; CARP[seg * 64 + ch] = cp_; }
        __syncthreads();
        { bf16* hl = (bf16*)(p.ws + WS_HB); bf16* Pc = hl + (size_t)T * 512; const int seg = tl >> 3; float ho[8], po[8];
#pragma unroll
          for (int i = 0; i < 8; ++i) { const int ch = c8 + i; const float pl = R[tl * LR + ch]; ho[i] = I[tl * LR + ch] + pl * CARH[seg * 64 + ch]; po[i] = pl * CARP[seg * 64 + ch]; }
          *(v4u*)(hl + (size_t)(t0 + tl) * 512 + ch0) = pack8(ho); *(v4u*)(Pc + (size_t)(t0 + tl) * 512 + ch0) = pack8(po);
          if (tl == 63) { float* pe = (float*)(p.ws + WS_LEND);
#pragma unroll
              for (int i = 0; i < 8; ++i) { pe[(b * 32 + c) * 512 + ch0 + i] = po[i]; pe[131072 + (b * 32 + c) * 512 + ch0 + i] = ho[i]; } } }
        __syncthreads();
    }
}
__device__ __forceinline__ void lru_prefix(PRef p, int gtid, int NGT) {
    const float* pe = (const float*)(p.ws + WS_LEND); float* ci = (float*)(p.ws + WS_CARRY);
    for (int it = gtid; it < 4096; it += NGT) { const int b = it >> 9, ch = it & 511; float carry = 0.f; float pv[32], hv[32];
#pragma unroll
        for (int c = 0; c < 32; ++c) { const int o = (b * 32 + c) * 512 + ch; pv[c] = pe[o]; hv[c] = pe[131072 + o]; }
#pragma unroll
        for (int c = 0; c < 32; ++c) { const int o = (b * 32 + c) * 512 + ch; ci[o] = carry; carry = pv[c] * carry + hv[c]; } }
}
__device__ __forceinline__ float tanh_fast(float u) { return 1.0f - 2.0f * __builtin_amdgcn_rcpf(1.0f + __expf(2.0f * u)); }
__device__ __forceinline__ float gelu_tanh(float x) { const float u = 0.7978845608028654f * (x + 0.044715f * x * x * x); return 0.5f * x * (1.0f + tanh_fast(u)); }
__device__ __forceinline__ void lru_out(PRef p, int gtid, int NGT) {
    const bf16* proj = (const bf16*)(p.ws + WS_PROJ); const bf16* hl = (const bf16*)(p.ws + WS_HB); const bf16* Pc = hl + (size_t)T * 512; const float* ci = (const float*)(p.ws + WS_CARRY);
    bf16* y = (bf16*)(p.ws + WS_Y);
    int it = gtid; if (it >= T * 64) return;
    v4u rh, rp, rg; f32x4 c0, c1;
    { const int row = it >> 6, c8 = (it & 63) * 8, b = row >> 11, c = (row & 2047) >> 6; rh = *(const v4u*)(hl + (size_t)row * 512 + c8); rp = *(const v4u*)(Pc + (size_t)row * 512 + c8); rg = *(const v4u*)(proj + (size_t)row * NP0 + 512 + c8);
      const float* cp = ci + (b * 32 + c) * 512 + c8; c0 = *(const f32x4*)cp; c1 = *(const f32x4*)(cp + 4); }
    for (;;) { const int nx = it + NGT; const bool more = nx < T * 64; v4u nh = rh, np = rp, ng = rg; f32x4 n0 = c0, n1 = c1;
        if (more) { const int row = nx >> 6, c8 = (nx & 63) * 8, b = row >> 11, c = (row & 2047) >> 6; nh = *(const v4u*)(hl + (size_t)row * 512 + c8); np = *(const v4u*)(Pc + (size_t)row * 512 + c8); ng = *(const v4u*)(proj + (size_t)row * NP0 + 512 + c8);
            const float* cp = ci + (b * 32 + c) * 512 + c8; n0 = *(const f32x4*)cp; n1 = *(const f32x4*)(cp + 4); }
        { const int row = it >> 6, c8 = (it & 63) * 8; float h[8], P[8], gt[8], o[8]; unpack8(rh, h); unpack8(rp, P); unpack8(rg, gt); const float cr[8] = {c0[0], c0[1], c0[2], c0[3], c1[0], c1[1], c1[2], c1[3]};
#pragma unroll
          for (int i = 0; i < 8; ++i) o[i] = (h[i] + P[i] * cr[i]) * gelu_tanh(gt[i]);
          *(v4u*)(y + (size_t)row * 1024 + c8) = pack8(o); }
        if (!more) break; it = nx; rh = nh; rp = np; rg = ng; c0 = n0; c1 = n1; }
}

template <bool RET> struct LA {
    static constexpr int DK = RET ? 128 : 64, C = RET ? 128 : 64, NCH = SEQ / C, TPT = NTHREADS / C, KPT = DK / TPT, VPT = 128 / TPT, LQ = DK + 8, LT = C + 8;
    static constexpr int O_QS = 0, O_KS = O_QS + C * LQ * 2, O_VT = O_KS + C * LQ * 2, O_SC = O_VT + 128 * LT * 2, O_F = O_SC + C * LT * 2, O_OF = RET ? 0 : O_F + 16640;
    static constexpr int O_KT = O_QS;
    static_assert(DK * LT * 2 <= 2 * C * LQ * 2, "Kt fits");
    static_assert(RET ? (O_SC + C * LT * 2 <= LDS_BYTES - 256 && 128 * 133 * 4 <= 2 * 128 * 136 * 2) : (O_OF + 64 * 133 * 4 <= 98304 && 98304 + 2048 <= LDS_BYTES - 256), "LA LDS");
};
__device__ __forceinline__ void gla_cum(PRef p, LAS unsigned char* lds, const bf16* proj, int t0, int h, int tid) {
    LAS float* F = (LAS float*)(lds + LA<false>::O_F); const int tl = tid >> 3, c8 = (tid & 7) * 8;
    float z[8], bg[8]; ld8(proj + (size_t)(t0 + tl) * NP0 + 2560 + 64 * h + c8, z); ldf8(p.in[12] + 64 * h + c8, bg);
#pragma unroll
    for (int i = 0; i < 8; ++i) F[tl * 65 + c8 + i] = logsigf(z[i] + bg[i]) * (1.0f / 16.0f);
    __syncthreads();
    LAS float* SEG = (LAS float*)(lds + 98304);
    { const int ch = tid & 63, seg = tid >> 6; float run = 0.f;
#pragma unroll
      for (int t = 8 * seg; t < 8 * seg + 8; ++t) { run += F[t * 65 + ch]; F[t * 65 + ch] = run; }
      SEG[seg * 64 + ch] = run; }
    __syncthreads();
    { const int ch = tid & 63, seg = tid >> 6; float off = 0.f;
#pragma unroll
      for (int s2 = 0; s2 < 7; ++s2) { const float v = SEG[s2 * 64 + ch]; if (s2 < seg) off += v; }
#pragma unroll
      for (int t = 8 * seg; t < 8 * seg + 8; ++t) F[t * 65 + ch] += off; }
    __syncthreads();
}
template <bool RET> __device__ __forceinline__ void la_load_vt(LAS unsigned char* lds, const bf16* vsrc  , int ld, int tid) {
    typedef LA<RET> L; LAS bf16* Vt = (LAS bf16*)(lds + L::O_VT); const int tl = tid / L::TPT, v0 = (tid % L::TPT) * L::VPT;
#pragma unroll
    for (int s = 0; s < L::VPT / 8; ++s) { float v[8]; ld8(vsrc + (size_t)tl * ld + v0 + 8 * s, v);
#pragma unroll
        for (int i = 0; i < 8; ++i) Vt[(v0 + 8 * s + i) * L::LT + tl] = (bf16)f2bf(v[i]); }
}
__device__ __forceinline__ void rot_cs(int pos_i, int part, float* cs, float* sn) {
    const float pos = (float)pos_i;
#pragma unroll
    for (int i = 0; i < 16; ++i) { const float invr = __builtin_amdgcn_exp2f(-(float)(16 * part + i) * (13.287712379549449f / 64.0f)) * 0.15915494309189535f;
        const float hi = __uint_as_float(__float_as_uint(invr) & 0xfffff000u), lo = invr - hi;
        const float rev = __builtin_amdgcn_fractf(pos * hi) + pos * lo;
        sn[i] = __builtin_amdgcn_sinf(rev); cs[i] = __builtin_amdgcn_cosf(rev); }
}
__device__ __forceinline__ void ret_rot16(const bf16* src, const float* cs, const float* sn, int part, float* o1, float* o2) {
    float x1[16], x2[16]; ld8(src + 16 * part, x1); ld8(src + 16 * part + 8, x1 + 8); ld8(src + 64 + 16 * part, x2); ld8(src + 64 + 16 * part + 8, x2 + 8);
#pragma unroll
    for (int i = 0; i < 16; ++i) { o1[i] = x1[i] * cs[i] - x2[i] * sn[i]; o2[i] = x2[i] * cs[i] + x1[i] * sn[i]; }
}

template <bool RET> __device__ __forceinline__ void la_local_item(PRef p, LAS unsigned char* lds, int item, int tid, int wave, int lane) {
    typedef LA<RET> L; const int c = item % L::NCH, h = (item / L::NCH) & 3, b = item / (L::NCH * 4), t0 = b * SEQ + L::C * c;
    const bf16* proj = (const bf16*)(p.ws + WS_PROJ); LAS bf16* Kt = (LAS bf16*)(lds + L::O_KT); LAS bf16* Vt = (LAS bf16*)(lds + L::O_VT);
    bf16* state = RET ? (bf16*)(p.ws + WS_HB) : (bf16*)(p.ws + WS_GST);
    if (!RET) {
        la_load_vt<false>(lds, proj + (size_t)t0 * NP0 + 1536 + 128 * h, NP0, tid);
        const int tl = tid >> 3, c8 = (tid & 7) * 8; const v4u kraw = *(const v4u*)(proj + (size_t)(t0 + tl) * NP0 + 1280 + 64 * h + c8);
        gla_cum(p, lds, proj, t0, h, tid);
        LAS float* F = (LAS float*)(lds + L::O_F); float kv[8]; unpack8(kraw, kv);
#pragma unroll
        for (int i = 0; i < 8; ++i) { const float ge = F[63 * 65 + c8 + i], gt = F[tl * 65 + c8 + i]; Kt[(c8 + i) * L::LT + tl] = (bf16)f2bf(kv[i] * __expf(ge - gt));
            if (tl == 63) ((float*)(p.ws + WS_GDEC))[item * 64 + c8 + i] = __expf(ge); }
    } else {
        la_load_vt<true>(lds, proj + (size_t)t0 * NP1 + 1024 + 128 * h, NP1, tid);
        const int tl = tid >> 2, part = tid & 3; float cs[16], sn[16]; rot_cs(((const int*)p.in[2])[t0 + tl], part, cs, sn); const float lg = log1pf(-exp2f(-5.0f - (float)h));
        float k1[16], k2[16]; ret_rot16(proj + (size_t)(t0 + tl) * NP1 + 512 + 128 * h, cs, sn, part, k1, k2); const float f = __expf((float)(127 - tl) * lg);
#pragma unroll
        for (int i = 0; i < 16; ++i) { Kt[(16 * part + i) * L::LT + tl] = (bf16)f2bf(k1[i] * f); Kt[(64 + 16 * part + i) * L::LT + tl] = (bf16)f2bf(k2[i] * f); }
    }
    __syncthreads();
    { const int q = lane >> 4; bf16* dst = state + (size_t)item * 128 * L::DK;
      for (int kt = 0; kt < L::DK / 16; ++kt) { f32x4 acc = {0.f, 0.f, 0.f, 0.f}; acc = mma_ll(Vt + 16 * wave * L::LT, L::LT, Kt + 16 * kt * L::LT, L::LT, L::C, acc, lane);
#pragma unroll
          for (int j = 0; j < 4; ++j) dst[(16 * wave + 4 * q + j) * L::DK + 16 * kt + (lane & 15)] = (bf16)f2bf(acc[j]); } }
    __syncthreads();
}
template <bool RET> __device__ __forceinline__ void la_prefix(PRef p, int gtid, int NGT) {
    typedef LA<RET> L; constexpr int NP = 128 * L::DK / 2; unsigned* state = RET ? (unsigned*)(p.ws + WS_HB) : (unsigned*)(p.ws + WS_GST); const float* dec = (const float*)(p.ws + WS_GDEC);
    for (int it = gtid; it < 32 * NP; it += NGT) { const int bh = it / NP, pe = it % NP, k = (2 * pe) % L::DK; float s0 = 0.f, s1 = 0.f;
        unsigned w[L::NCH]; float d0[L::NCH], d1[L::NCH];
        float dr = 0.f; if (RET) { const float lg = log1pf(-exp2f(-5.0f - (float)(bh & 3))); dr = __expf(128.0f * lg); }
#pragma unroll
        for (int c = 0; c < L::NCH; ++c) { w[c] = state[(size_t)(bh * L::NCH + c) * NP + pe];
            if (RET) { d0[c] = dr; d1[c] = dr; } else { d0[c] = dec[(bh * L::NCH + c) * 64 + k]; d1[c] = dec[(bh * L::NCH + c) * 64 + k + 1]; } }
#pragma unroll
        for (int c = 0; c < L::NCH; ++c) { state[(size_t)(bh * L::NCH + c) * NP + pe] = pk2(s0, s1);
            s0 = s0 * d0[c] + __uint_as_float(w[c] << 16); s1 = s1 * d1[c] + __uint_as_float(w[c] & 0xffff0000u); } }
}
template <bool RET> __device__ __forceinline__ void la_out_item(PRef p, LAS unsigned char* lds, int item, int tid, int wave, int lane) {
    typedef LA<RET> L; const int c = item % L::NCH, h = (item / L::NCH) & 3, b = item / (L::NCH * 4), t0 = b * SEQ + L::C * c;
    bf16* proj = (bf16*)(p.ws + WS_PROJ); LAS bf16* Qs = (LAS bf16*)(lds + L::O_QS); LAS bf16* Ks = (LAS bf16*)(lds + L::O_KS); LAS bf16* Vt = (LAS bf16*)(lds + L::O_VT); LAS bf16* Sc = (LAS bf16*)(lds + L::O_SC);
    LAS float* Of = (LAS float*)(lds + L::O_OF);
    const bf16* state = (RET ? (const bf16*)(p.ws + WS_HB) : (const bf16*)(p.ws + WS_GST)) + (size_t)item * 128 * L::DK;
    float inter_scale = 1.0f;
    const int ptl = tid / L::TPT, pv0 = (tid % L::TPT) * L::VPT;
    const bf16* gsrc0 = RET ? proj + (size_t)(t0 + ptl) * NP1 + 1536 + 128 * h + pv0 : proj + (size_t)(t0 + ptl) * NP0 + 2048 + 128 * h + pv0;
    const float* gn0 = (RET ? p.in[16] : p.in[13]) + 128 * h + pv0;
    v4u graw[L::VPT / 8]; f32x4 gnr[L::VPT / 4];
#pragma unroll
    for (int s8 = 0; s8 < L::VPT / 8; ++s8) graw[s8] = *(const v4u*)(gsrc0 + 8 * s8);
#pragma unroll
    for (int s4 = 0; s4 < L::VPT / 4; ++s4) gnr[s4] = *(const f32x4*)(gn0 + 4 * s4);
    if (!RET) {
        la_load_vt<false>(lds, proj + (size_t)t0 * NP0 + 1536 + 128 * h, NP0, tid);
        const int tl = tid >> 3, c8 = (tid & 7) * 8; const v4u qraw = *(const v4u*)(proj + (size_t)(t0 + tl) * NP0 + 1024 + 64 * h + c8), kraw = *(const v4u*)(proj + (size_t)(t0 + tl) * NP0 + 1280 + 64 * h + c8);
        gla_cum(p, lds, proj, t0, h, tid);
        LAS float* F = (LAS float*)(lds + L::O_F); float qv[8], kv[8], qo[8], ko[8]; unpack8(qraw, qv); unpack8(kraw, kv);
#pragma unroll
        for (int i = 0; i < 8; ++i) { const float gt = F[tl * 65 + c8 + i]; qo[i] = qv[i] * 0.125f * __expf(gt); ko[i] = kv[i] * __expf(-gt); }
        *(LAS v4u*)(Qs + tl * L::LQ + c8) = pack8(qo); *(LAS v4u*)(Ks + tl * L::LQ + c8) = pack8(ko);
    } else {
        la_load_vt<true>(lds, proj + (size_t)t0 * NP1 + 1024 + 128 * h, NP1, tid);
        const int tl = tid >> 2, part = tid & 3; float cs[16], sn[16]; rot_cs(((const int*)p.in[2])[t0 + tl], part, cs, sn); const float lg = log1pf(-exp2f(-5.0f - (float)h)); inter_scale = __expf(lg);
        float a1[16], a2[16];
        ret_rot16(proj + (size_t)(t0 + tl) * NP1 + 128 * h, cs, sn, part, a1, a2); const float fq_ = 0.08838834764831845f * __expf((float)tl * lg);
#pragma unroll
        for (int i = 0; i < 16; ++i) { a1[i] *= fq_; a2[i] *= fq_; }
        *(LAS v4u*)(Qs + tl * L::LQ + 16 * part) = pack8(a1); *(LAS v4u*)(Qs + tl * L::LQ + 16 * part + 8) = pack8(a1 + 8);
        *(LAS v4u*)(Qs + tl * L::LQ + 64 + 16 * part) = pack8(a2); *(LAS v4u*)(Qs + tl * L::LQ + 64 + 16 * part + 8) = pack8(a2 + 8);
        ret_rot16(proj + (size_t)(t0 + tl) * NP1 + 512 + 128 * h, cs, sn, part, a1, a2); const float fk_ = __expf(-(float)tl * lg);
#pragma unroll
        for (int i = 0; i < 16; ++i) { a1[i] *= fk_; a2[i] *= fk_; }
        *(LAS v4u*)(Ks + tl * L::LQ + 16 * part) = pack8(a1); *(LAS v4u*)(Ks + tl * L::LQ + 16 * part + 8) = pack8(a1 + 8);
        *(LAS v4u*)(Ks + tl * L::LQ + 64 + 16 * part) = pack8(a2); *(LAS v4u*)(Ks + tl * L::LQ + 64 + 16 * part + 8) = pack8(a2 + 8);
    }
    bf16x8 sf[4][2];
    if (!RET) {
#pragma unroll
        for (int vi = 0; vi < 4; ++vi)
#pragma unroll
            for (int ks = 0; ks < 2; ++ks) sf[vi][ks] = *(const bf16x8*)(state + (size_t)(16 * (4 * (wave >> 2) + vi) + (lane & 15)) * 64 + 8 * (lane >> 4) + 32 * ks);
    }
    __syncthreads();
    const int q = lane >> 4; constexpr int RT = L::C / 16;
    if (!RET) { const int rt = wave & 3;
#pragma unroll
        for (int cc = 0; cc < 2; ++cc) { const int ct = 2 * (wave >> 2) + cc; f32x4 acc = {0.f, 0.f, 0.f, 0.f};
            if (ct <= rt) acc = mma_ll(Qs + 16 * rt * L::LQ, L::LQ, Ks + 16 * ct * L::LQ, L::LQ, L::DK, acc, lane);
#pragma unroll
            for (int j = 0; j < 4; ++j) { const int it_ = 16 * rt + 4 * q + j, jt = 16 * ct + (lane & 15); Sc[it_ * L::LT + jt] = (bf16)f2bf(jt <= it_ ? acc[j] : 0.f); } }
    } else { const int rt = wave;
        for (int ct = 0; ct < RT; ++ct) { f32x4 acc = {0.f, 0.f, 0.f, 0.f};
            if (ct <= rt) acc = mma_ll(Qs + 16 * rt * L::LQ, L::LQ, Ks + 16 * ct * L::LQ, L::LQ, L::DK, acc, lane);
#pragma unroll
            for (int j = 0; j < 4; ++j) { const int it_ = 16 * rt + 4 * q + j, jt = 16 * ct + (lane & 15); Sc[it_ * L::LT + jt] = (bf16)f2bf(jt <= it_ ? acc[j] : 0.f); } }
    }
    __syncthreads();
    f32x4 oacc[RET ? 8 : 4];
    { const int rt = RET ? wave : (wave & 3), vt0 = RET ? 0 : 4 * (wave >> 2); constexpr int NV = RET ? 8 : 4;
#pragma unroll
      for (int vi = 0; vi < NV; ++vi) { const int vt = vt0 + vi; f32x4 a1 = {0.f, 0.f, 0.f, 0.f}, a2 = {0.f, 0.f, 0.f, 0.f};
          a1 = mma_ll(Sc + 16 * rt * L::LT, L::LT, Vt + 16 * vt * L::LT, L::LT, L::C, a1, lane);
          if (RET) a2 = mma_lg(Qs + 16 * rt * L::LQ, L::LQ, state + (size_t)16 * vt * L::DK, L::DK, L::DK, a2, lane);
          else { const LAS bf16* xp = Qs + (16 * rt + (lane & 15)) * L::LQ + 8 * (lane >> 4);
              a2 = __builtin_amdgcn_mfma_f32_16x16x32_bf16(*(const LAS bf16x8*)xp, sf[vi & 3][0], a2, 0, 0, 0); a2 = __builtin_amdgcn_mfma_f32_16x16x32_bf16(*(const LAS bf16x8*)(xp + 32), sf[vi & 3][1], a2, 0, 0, 0); }
          oacc[vi] = a1 + a2 * inter_scale; }
      if (RET) __syncthreads();
#pragma unroll
      for (int vi = 0; vi < NV; ++vi) { const int vt = vt0 + vi;
#pragma unroll
          for (int j = 0; j < 4; ++j) Of[(16 * rt + 4 * q + j) * 133 + 16 * vt + (lane & 15)] = oacc[vi][j]; } }
    __syncthreads();
    { const int tl = tid / L::TPT, v0 = (tid % L::TPT) * L::VPT; float s = 0.f, s2 = 0.f;
#pragma unroll
      for (int i = 0; i < L::VPT; ++i) { const float o = Of[tl * 133 + v0 + i]; s += o; s2 += o * o; }
#pragma unroll
      for (int m = 1; m < L::TPT; m <<= 1) { s += __shfl_xor(s, m); s2 += __shfl_xor(s2, m); }
      float mean = 0.f, var = s2 * (1.0f / 128.0f);
      if (RET) { mean = s * (1.0f / 128.0f); var = fmaxf(var - mean * mean, 0.f); }
      const float rstd = __builtin_amdgcn_rsqf(var + 1e-5f);
      const bf16* gsrc = RET ? proj + (size_t)(t0 + tl) * NP1 + 1536 + 128 * h + v0 : proj + (size_t)(t0 + tl) * NP0 + 2048 + 128 * h + v0;
      const float* gn = (RET ? p.in[16] : p.in[13]) + 128 * h + v0;
      bf16* dst = RET ? proj + (size_t)(t0 + tl) * NP1 + 128 * h + v0 : (bf16*)(p.ws + WS_Y) + (size_t)(t0 + tl) * 1024 + 512 + 128 * h + v0;
#pragma unroll
      for (int s8 = 0; s8 < L::VPT / 8; ++s8) { float gv[8], o[8]; unpack8(graw[s8], gv); const float gg[8] = {gnr[2 * s8][0], gnr[2 * s8][1], gnr[2 * s8][2], gnr[2 * s8][3], gnr[2 * s8 + 1][0], gnr[2 * s8 + 1][1], gnr[2 * s8 + 1][2], gnr[2 * s8 + 1][3]};
#pragma unroll
          for (int i = 0; i < 8; ++i) { const float x = (Of[tl * 133 + v0 + 8 * s8 + i] - mean) * rstd * gg[i]; o[i] = x * (gv[i] * sigmf(gv[i])); }
          *(v4u*)(dst + 8 * s8) = pack8(o); } }
    __syncthreads();
}

__device__ __forceinline__ void rwkv_prep(PRef p, int gtid, int NGT) {
    const bf16* proj = (const bf16*)(p.ws + WS_PROJ); bf16* alr = (bf16*)(p.ws + WS_ALR); const float* mu = p.in[17];
    for (int it = gtid; it < T * 32; it += NGT) { const int row = it >> 5, c8 = (it & 31) * 8, col = 1536 + c8; float cur[8], prv[8], o[8];
        ld8(proj + (size_t)row * NP1 + 2048 + col, cur);
        if ((row & 2047) != 0) ld8(proj + (size_t)(row - 1) * NP1 + 2048 + col, prv); else {
#pragma unroll
            for (int i = 0; i < 8; ++i) prv[i] = 0.f; }
        float mv[8]; ldf8(mu + col, mv);
#pragma unroll
        for (int i = 0; i < 8; ++i) { const float d = cur[i] + mv[i] * (prv[i] - cur[i]); o[i] = c8 < 64 ? tanh_fast(d) : (c8 < 128 ? d : sigmf(d)); }
        *(v4u*)(alr + (size_t)row * 256 + c8) = pack8(o); }
}
__device__ __forceinline__ float row_sum16(float x) {
    x += __int_as_float(__builtin_amdgcn_update_dpp(0, __float_as_int(x), 0x128, 0xf, 0xf, false));
    x += __int_as_float(__builtin_amdgcn_update_dpp(0, __float_as_int(x), 0x124, 0xf, 0xf, false));
    x += __int_as_float(__builtin_amdgcn_update_dpp(0, __float_as_int(x), 0x122, 0xf, 0xf, false));
    x += __int_as_float(__builtin_amdgcn_update_dpp(0, __float_as_int(x), 0x121, 0xf, 0xf, false));
    return x;
}
constexpr int SC_STR = 344, SC_STEPS = 32;
__device__ __forceinline__ void rwkv_stage(PRef p, LAS float* buf, int b, int h, int part, int ch, int pt,
                                           const float* mur, const float* muk, const float* muv, const float* kkp, const float* kap, const float* rkp, const float* w0p, const float* a0p) {
    const bf16* proj = (const bf16*)(p.ws + WS_PROJ); const bf16* wag = (const bf16*)(p.ws + WS_Y);
    const int tl = pt >> 3, kc = pt & 7, t = SC_STEPS * ch + tl, row = b * SEQ + t, c0 = 64 * h + 8 * kc;
    float r[8], k[8], v[8], pr[8], pk[8], pv[8], e[8], a[8];
    ld8(proj + (size_t)row * NP1 + 2048 + c0, r); ld8(proj + (size_t)row * NP1 + 2560 + c0, k); ld8(proj + (size_t)row * NP1 + 3072 + c0, v);
    if (t > 0) { ld8(proj + (size_t)(row - 1) * NP1 + 2048 + c0, pr); ld8(proj + (size_t)(row - 1) * NP1 + 2560 + c0, pk); ld8(proj + (size_t)(row - 1) * NP1 + 3072 + c0, pv); }
    else {
#pragma unroll
        for (int i = 0; i < 8; ++i) { pr[i] = 0.f; pk[i] = 0.f; pv[i] = 0.f; } }
    ld8(wag + (size_t)row * 1536 + c0, e); ld8(wag + (size_t)row * 1536 + 512 + c0, a);
    float kkr[8], ss = 0.f;
#pragma unroll
    for (int i = 0; i < 8; ++i) { r[i] += mur[i] * (pr[i] - r[i]); k[i] += muk[i] * (pk[i] - k[i]); v[i] += muv[i] * (pv[i] - v[i]); kkr[i] = k[i] * kkp[i]; ss += kkr[i] * kkr[i]; }
    ss += __shfl_xor(ss, 1); ss += __shfl_xor(ss, 2); ss += __shfl_xor(ss, 4);
    const float rn = __builtin_amdgcn_rsqf(ss + 1e-12f);
    LAS float* base = buf + tl * SC_STR; float br = 0.f, kr = 0.f, rkr = 0.f;
    f32x4 o0[2], o1[2], o2[2], o3[2], o4[2];
#pragma unroll
    for (int i = 0; i < 8; ++i) { const float kk = kkr[i] * rn, w = __expf(-e[i]), km = k[i] * (1.0f + (a[i] - 1.0f) * kap[i]), bb = kk * a[i];
        o0[i >> 2][i & 3] = -kk; o1[i >> 2][i & 3] = w * r[i]; o2[i >> 2][i & 3] = w; o3[i >> 2][i & 3] = bb; o4[i >> 2][i & 3] = km;
        br += bb * r[i]; kr += km * r[i]; rkr += r[i] * km * rkp[i]; }
#pragma unroll
    for (int s = 0; s < 2; ++s) { *(LAS f32x4*)(base + 16 * kc + 8 * s) = (f32x4){o0[s][0], o1[s][0], o0[s][1], o1[s][1]}; *(LAS f32x4*)(base + 16 * kc + 8 * s + 4) = (f32x4){o0[s][2], o1[s][2], o0[s][3], o1[s][3]}; *(LAS f32x4*)(base + 128 + 8 * kc + 4 * s) = o2[s];
        *(LAS f32x4*)(base + 192 + 8 * kc + 4 * s) = o3[s]; *(LAS f32x4*)(base + 256 + 8 * kc + 4 * s) = o4[s]; }
    if ((kc >> 1) == part) {
#pragma unroll
        for (int i = 0; i < 8; ++i) base[320 + (kc & 1) * 8 + i] = v[i]; }
#pragma unroll
    for (int m = 1; m < 8; m <<= 1) { br += __shfl_xor(br, m); kr += __shfl_xor(kr, m); rkr += __shfl_xor(rkr, m); }
    if (kc == 0) { base[336] = br; base[337] = kr; if (part == 0) ((float*)(p.ws + WS_RKR))[(size_t)(b * 8 + h) * SEQ + t] = rkr; }
}
__device__ __forceinline__ void rwkv_scan_item(PRef p, LAS unsigned char* lds, int item, int tid, int wave, int lane, bool do_cvt) {
    const int part = item & 3, h = (item >> 2) & 7, b = item >> 5;
    LAS float* buf = (LAS float*)lds; LAS float* ybuf = (LAS float*)(lds + 2 * SC_STEPS * SC_STR * 4);
    bf16* yraw = (bf16*)(p.ws + WS_HB) + (size_t)T * 512;
    constexpr int NCHK = SEQ / SC_STEPS;
    if (wave >= 4) {
        const int pt = tid - 256, kc = pt & 7, c0 = 64 * h + 8 * kc; float mur[8], muk[8], muv[8], kkp[8], kap[8], rkp[8], w0p[8], a0p[8];
#pragma unroll
        for (int i = 0; i < 8; ++i) { mur[i] = p.in[17][c0 + i]; muk[i] = p.in[17][512 + c0 + i]; muv[i] = p.in[17][1024 + c0 + i]; kkp[i] = p.in[23][c0 + i]; kap[i] = p.in[24][c0 + i]; rkp[i] = p.in[25][c0 + i]; w0p[i] = p.in[18][c0 + i]; a0p[i] = p.in[20][c0 + i]; }
        rwkv_stage(p, buf, b, h, part, 0, pt, mur, muk, muv, kkp, kap, rkp, w0p, a0p);
        LAS float* scr = (LAS float*)(lds + 2 * SC_STEPS * SC_STR * 4 + 8192 + (wave - 4) * 8704);
        f32x4 creg[8];
#pragma unroll
        for (int i = 0; i < 8; ++i) creg[i] = (f32x4){0.f, 0.f, 0.f, 0.f};
        for (int ch = 0; ch < NCHK; ++ch) { __syncthreads(); if (ch + 1 < NCHK) rwkv_stage(p, buf + ((ch + 1) & 1) * SC_STEPS * SC_STR, b, h, part, ch + 1, pt, mur, muk, muv, kkp, kap, rkp, w0p, a0p);
#ifndef NO_SCAN_CVT
            if (do_cvt) { const int idx = (int)blockIdx.x * 4 + (wave - 4) + (ch >> 3) * ((int)gridDim.x * 4);
                if ((ch & 7) == 0) { if (idx < CVT1_ITEMS) cvt1_load(p, idx, lane, creg); } else if ((ch & 7) == 1) { if (idx < CVT1_ITEMS) cvt1_store(p, idx, scr, lane, creg); } }
#endif
        }
    } else {
        const int vl = lane >> 4, kg = lane & 15; f32x4 S = {0.f, 0.f, 0.f, 0.f}; LAS float* yb = ybuf + wave * 512;
        bf16* yp = yraw + (size_t)(item * SEQ) * 16;
        for (int ch = 0; ch < NCHK; ++ch) { __syncthreads(); const LAS float* cb = buf + (ch & 1) * SC_STEPS * SC_STR;
            typedef float f32x2 __attribute__((ext_vector_type(2)));
            const LAS float* b0 = cb;
            f32x4 c_nw0 = *(const LAS f32x4*)(b0 + 8 * kg), c_nw1 = *(const LAS f32x4*)(b0 + 8 * kg + 4), c_w = *(const LAS f32x4*)(b0 + 128 + 4 * kg),
                  c_bb = *(const LAS f32x4*)(b0 + 192 + 4 * kg), c_kk = *(const LAS f32x4*)(b0 + 256 + 4 * kg);
            float c_vv = b0[320 + 4 * wave + vl], c_br = b0[336], c_kr = b0[337];
#pragma unroll
            for (int s = 0; s < SC_STEPS; ++s) { const LAS float* base = cb + (s + 1 < SC_STEPS ? s + 1 : s) * SC_STR;
                const f32x4 n_nw0 = *(const LAS f32x4*)(base + 8 * kg), n_nw1 = *(const LAS f32x4*)(base + 8 * kg + 4), n_w = *(const LAS f32x4*)(base + 128 + 4 * kg),
                            n_bb = *(const LAS f32x4*)(base + 192 + 4 * kg), n_kk = *(const LAS f32x4*)(base + 256 + 4 * kg);
                const float n_vv = base[320 + 4 * wave + vl], n_br = base[336], n_kr = base[337];
                const f32x4 tS = S * c_w + c_kk * c_vv;
                f32x2 dd = (f32x2){S[0], S[0]} * (f32x2){c_nw0[0], c_nw0[1]};
                dd = (f32x2){S[1], S[1]} * (f32x2){c_nw0[2], c_nw0[3]} + dd;
                dd = (f32x2){S[2], S[2]} * (f32x2){c_nw1[0], c_nw1[1]} + dd;
                dd = (f32x2){S[3], S[3]} * (f32x2){c_nw1[2], c_nw1[3]} + dd;
                const float d1 = row_sum16(dd.x);
                S = tS + c_bb * d1;
                float d2 = dd.y;
                d2 += __int_as_float(__builtin_amdgcn_update_dpp(0, __float_as_int(d2), 0x128, 0xf, 0xf, false));
                d2 += __int_as_float(__builtin_amdgcn_update_dpp(0, __float_as_int(d2), 0x124, 0xf, 0xf, false));
                yb[(s * 4 + vl) * 4 + (kg & 3)] = d2 + 0.25f * (d1 * c_br + c_vv * c_kr);
                c_nw0 = n_nw0; c_nw1 = n_nw1; c_w = n_w; c_bb = n_bb; c_kk = n_kk; c_vv = n_vv; c_br = n_br; c_kr = n_kr; }
            { const int s = lane >> 1, pr = lane & 1; const f32x4 q0 = *(const LAS f32x4*)(yb + (s * 4 + 2 * pr) * 4), q1 = *(const LAS f32x4*)(yb + (s * 4 + 2 * pr + 1) * 4); const float y0 = (q0[0] + q0[1]) + (q0[2] + q0[3]), y1 = (q1[0] + q1[1]) + (q1[2] + q1[3]);
              *(unsigned*)(yp + (size_t)(SC_STEPS * ch + s) * 16 + 4 * wave + 2 * pr) = pk2(y0, y1); } }
    }
    __syncthreads();
}
__device__ __forceinline__ void rwkv_post(PRef p, int gtid, int NGT) {
    bf16* proj = (bf16*)(p.ws + WS_PROJ); const bf16* wag = (const bf16*)(p.ws + WS_Y); const bf16* yraw = (const bf16*)(p.ws + WS_HB) + (size_t)T * 512; const float* rkr = (const float*)(p.ws + WS_RKR);
    for (int it = gtid; it < T * 64; it += NGT) { const int row = it >> 6, h = (it >> 3) & 7, c0 = 64 * h + 8 * (it & 7); float y[8], v[8], pv[8], g[8], o[8];
        { const int b_ = row >> 11, t_ = row & 2047, j_ = it & 7; ld8(yraw + ((size_t)(((b_ * 8 + h) * 4 + (j_ >> 1)) * SEQ + t_)) * 16 + (j_ & 1) * 8, y); } float s = 0.f;
#pragma unroll
        for (int i = 0; i < 8; ++i) s += y[i];
        s += __shfl_xor(s, 1); s += __shfl_xor(s, 2); s += __shfl_xor(s, 4); const float mean = s * (1.0f / 64.0f); float s2 = 0.f;
#pragma unroll
        for (int i = 0; i < 8; ++i) { y[i] -= mean; s2 += y[i] * y[i]; }
        s2 += __shfl_xor(s2, 1); s2 += __shfl_xor(s2, 2); s2 += __shfl_xor(s2, 4); const float rstd = __builtin_amdgcn_rsqf(s2 * (1.0f / 64.0f) + 64e-5f);
        ld8(proj + (size_t)row * NP1 + 3072 + c0, v);
        if ((row & 2047) != 0) ld8(proj + (size_t)(row - 1) * NP1 + 3072 + c0, pv); else {
#pragma unroll
            for (int i = 0; i < 8; ++i) pv[i] = 0.f; }
        ld8(wag + (size_t)row * 1536 + 1024 + c0, g); const float rk = rkr[(size_t)((row >> 11) * 8 + h) * SEQ + (row & 2047)];
        float mv[8], ng[8]; ldf8(p.in[17] + 1024 + c0, mv); ldf8(p.in[26] + c0, ng);
#pragma unroll
        for (int i = 0; i < 8; ++i) { const float vs = v[i] + mv[i] * (pv[i] - v[i]); o[i] = (y[i] * rstd * ng[i] + rk * vs) * g[i]; }
#ifdef SANITIZE
#pragma unroll
        for (int i = 0; i < 8; ++i) if (!(fabsf(o[i]) < 1e30f)) o[i] = 0.f;
#endif
        *(v4u*)(proj + (size_t)row * NP1 + 512 + c0) = pack8(o); }
}
__device__ __forceinline__ void final_norm(PRef p, int gw, int NGW, int lane) {
    const float* part = pg8::rpart(p.ws, 6); const float* g = p.in[37]; const bf16* hf = (const bf16*)(p.ws + 107 * MiB);
    f32x4 gv[4];
#pragma unroll
    for (int j = 0; j < 4; ++j) gv[j] = *((const f32x4*)g + lane + 64 * j);
    int m = gw; if (m >= T) return;
    v2u cur[4]; float rs = pg8::rs16(part, m);
#pragma unroll
    for (int j = 0; j < 4; ++j) cur[j] = *((const v2u*)(hf + (size_t)m * 1024) + lane + 64 * j);
    for (;;) { const int nx = m + NGW; const bool more = nx < T; v2u nxt[4]; float nrs = rs;
#pragma unroll
        for (int j = 0; j < 4; ++j) nxt[j] = cur[j];
        if (more) { nrs = pg8::rs16(part, nx);
#pragma unroll
            for (int j = 0; j < 4; ++j) nxt[j] = *((const v2u*)(hf + (size_t)nx * 1024) + lane + 64 * j); }
        f32x4* xr = (f32x4*)(p.out + (size_t)m * 1024) + lane;
#pragma unroll
        for (int j = 0; j < 4; ++j) { const v2u hw = cur[j]; f32x4 v = {__uint_as_float(hw.x << 16), __uint_as_float(hw.x & 0xffff0000u), __uint_as_float(hw.y << 16), __uint_as_float(hw.y & 0xffff0000u)}; v = v * rs * gv[j]; xr[64 * j] = v; }
        if (!more) break; m = nx; rs = nrs;
#pragma unroll
        for (int j = 0; j < 4; ++j) cur[j] = nxt[j]; }
}

#define TID (fresh_tid())
#define LANE (TID & 63)
#define WAVE (__builtin_amdgcn_readfirstlane(TID >> 6))
#define GRD (fresh_s((int)gridDim.x))
#define BID (fresh_s((int)blockIdx.x))
#define GW (BID * NWAVES + WAVE)
#define NGW_ (GRD * NWAVES)
#define GTID (BID * NTHREADS + TID)
#define NGT_ (GRD * NTHREADS)
#define GSYNC_CG() cg::this_grid().sync()
#define GSYNC() do { XcdBarrier xb_; xb_.bar = (unsigned*)(FP.ws + WS_XBAR); xb_.x = xb_xcc_id(); xb_.st = (volatile LAS unsigned*)(lds + LDS_XST); xcd_barrier(xb_); } while (0)
#define WSP(off) (FP.ws + (off))
#define ROWSS(i) ((float*)WSP(WS_ROWSS) + (size_t)(i) * T)

template <int li> __device__ __forceinline__ void layer_body(LAS unsigned char* lds) {
        { const int N = li == 0 ? NP0 : NP1; pg8::Gemm g{li == 0 ? (const bf16*)WSP(WS_HB) : (const bf16*)FP.out + (size_t)T * 1024, (const bf16*)WSP(W_IN), T, N, 1024, 1024}; pg8::StaticOrder S; S.init(T, N, GRD, BID);
          pg8::EpiScaleBf16 E{0, li};
          pg8::gemm_phase<pg8::EpiScaleBf16, pg8::StaticOrder, true, true>(lds, g, S, E);
#ifdef PROBE_INPROJ2
          pg8::gemm_phase<pg8::EpiScaleBf16, pg8::StaticOrder, true, true>(lds, g, S, E);
#endif
        }
        GSYNC();
#ifndef NO_MIX
        if (li == 0) {
#ifdef NO_MIX0
            { PRef p = FP; tr_job(p.in[15], NP1, 1024, p.in[28] + 1024, (bf16*)(p.ws + W_IN), NP1, 0, lds, GW, NGW_, WAVE, LANE); }
            GSYNC();
#else
            for (int it = BID; it < 256; it += GRD) lru_local_item(FP, lds, it, TID, WAVE, LANE);
#ifdef PROBE_LRU2
            for (int it = BID; it < 256; it += GRD) lru_local_item(FP, lds, it, TID, WAVE, LANE);
#endif
#ifdef PROBE_GLA2
            for (int it = BID; it < 1024; it += GRD) la_local_item<false>(FP, lds, it, TID, WAVE, LANE);
#endif
            for (int it = BID; it < 1024; it += GRD) la_local_item<false>(FP, lds, it, TID, WAVE, LANE);
            { PRef p = FP; tr_job(p.in[15], NP1, 1024, p.in[28] + 1024, (bf16*)(p.ws + W_IN), NP1, 0, lds, GW, NGW_, WAVE, LANE); }
            GSYNC();
            lru_prefix(FP, GTID, NGT_); la_prefix<false>(FP, GTID, NGT_);
            GSYNC();
            for (int it = BID; it < 1024; it += GRD) la_out_item<false>(FP, lds, it, TID, WAVE, LANE);
#ifdef PROBE_GLAOUT2
            for (int it = BID; it < 1024; it += GRD) la_out_item<false>(FP, lds, it, TID, WAVE, LANE);
#endif
#ifdef PROBE_LRUOUT2
            lru_out(FP, GTID, NGT_);
#endif
            lru_out(FP, GTID, NGT_);
            GSYNC();
#endif
        } else {
#ifdef NO_MIX1
            cvt_layer_weights(FP, 1, lds, GW, NGW_, WAVE, LANE);
            cvt_p(FP, 1, GW, NGW_, LANE);
            GSYNC();
#else
#ifndef NO_RET
            for (int it = BID; it < 512; it += GRD) la_local_item<true>(FP, lds, it, TID, WAVE, LANE);
#endif
#ifdef PROBE_RETLOC2
            for (int it = BID; it < 512; it += GRD) la_local_item<true>(FP, lds, it, TID, WAVE, LANE);
#endif
#ifdef PROBE_CVT2
            cvt_layer_weights(FP, 1, lds, GW, NGW_, WAVE, LANE);
#endif
#ifndef NO_RWKV
            rwkv_prep(FP, GTID, NGT_);
#endif
#ifdef NO_SCAN_CVT
            cvt_layer_weights(FP, 1, lds, GW, NGW_, WAVE, LANE);
            cvt_p(FP, 1, GW, NGW_, LANE);
#endif
            GSYNC();
#ifndef NO_RET
            la_prefix<true>(FP, GTID, NGT_);
#endif
#ifndef NO_RWKV
            { PRef p = FP; pg8::Gemm g{(const bf16*)(p.ws + WS_ALR), (const bf16*)(p.ws + W_LR), T, 1024, 128, 256}; pg8::StaticOrder S; S.init(T, 1024, GRD, BID);
              pg8::EpiLowRank E{0};
              pg8::gemm_phase<pg8::EpiLowRank, pg8::StaticOrder, true, true>(lds, g, S, E); }
            { PRef p = FP; pg8::Gemm g{(const bf16*)(p.ws + WS_ALR) + 128, (const bf16*)(p.ws + W_LR) + 1024 * 128, T, 512, 128, 256}; pg8::StaticOrder S; S.init(T, 512, GRD, BID);
              pg8::EpiLowRank E{1024};
              pg8::gemm_phase<pg8::EpiLowRank, pg8::StaticOrder, true, true>(lds, g, S, E); }
#endif
            GSYNC();
#ifndef NO_RET
            for (int it = BID; it < 512; it += GRD) la_out_item<true>(FP, lds, it, TID, WAVE, LANE);
#endif
#if !defined(NO_RWKV) && !defined(NO_SCAN)
            for (int it = BID; it < 256; it += GRD) rwkv_scan_item(FP, lds, it, TID, WAVE, LANE, it < GRD);
#endif
#ifndef NO_SCAN_CVT
            { const int first = 8 * GRD * 4; for (int idx = first + GW; idx < CVT1_ITEMS; idx += NGW_) cvt1_flat(FP, idx, (LAS float*)(lds + WAVE * 8704), LANE); }
#endif
#ifdef PROBE_SCAN2
            for (int it = BID; it < 256; it += GRD) rwkv_scan_item(FP, lds, it, TID, WAVE, LANE, it < GRD);
#endif
            GSYNC();
#ifndef NO_RWKV
            rwkv_post(FP, GTID, NGT_);
#endif
            GSYNC();
#endif
        }
#endif
        { PRef p = FP;
#if defined(NO_MIX) || defined(NO_MIX0)
          pg8::Gemm g{(const bf16*)(p.ws + WS_PROJ), (const bf16*)(p.ws + W_OUT), T, 1024, 1024, li == 0 ? NP0 : NP1};
#elif defined(NO_MIX1)
          pg8::Gemm g{li == 0 ? (const bf16*)(p.ws + WS_Y) : (const bf16*)(p.ws + WS_PROJ) + 2048, (const bf16*)(p.ws + W_OUT), T, 1024, 1024, li == 0 ? 1024 : NP1};
#else
          pg8::Gemm g{li == 0 ? (const bf16*)(p.ws + WS_Y) : (const bf16*)(p.ws + WS_PROJ), (const bf16*)(p.ws + W_OUT), T, 1024, 1024, li == 0 ? 1024 : NP1};
#endif

          pg8::StaticOrder S; S.init(T, 1024, GRD, BID);
          pg8::EpiResid E{0, li};
          pg8::gemm_phase<pg8::EpiResid, pg8::StaticOrder, true, true>(lds, g, S, E); }
        GSYNC();
        { pg8::Gemm g{(const bf16*)FP.out + (size_t)li * T * 1024, (const bf16*)WSP(W_GU), T, 2 * FF, 1024, 1024}; pg8::StaticOrder S; S.init(T, 2 * FF, GRD, BID);
          pg8::EpiSwiGLU E{li};
          pg8::gemm_phase<pg8::EpiSwiGLU, pg8::StaticOrder, true, true>(lds, g, S, E);
#ifdef PROBE_GU2
          pg8::gemm_phase<pg8::EpiSwiGLU, pg8::StaticOrder, true, true>(lds, g, S, E);
#endif
          { const int G_ = GRD, b_ = BID, half = G_ / 2; pg8::Gemm g2{(const bf16*)WSP(WS_PB), (const bf16*)WSP(W_PP), T, 1024, 256, 256}; pg8::StaticOrder S2;
            if (G_ == 256) S2.init(T, 1024, half, b_ >= half ? b_ - half : (1 << 28)); else S2.init(T, 1024, G_, b_);
            pg8::EpiScaleBf16 E2{1, li};
            pg8::gemm_phase<pg8::EpiScaleBf16, pg8::StaticOrder, true, true>(lds, g2, S2, E2); }
        }
        GSYNC();
        { PRef p = FP; pg8::Gemm g{(const bf16*)(p.ws + WS_PROJ), (const bf16*)(p.ws + W_DN), T, 1024, FF, FF}; pg8::StaticOrder S; S.init(T, 1024, GRD, BID);
          pg8::EpiResid E{1, li};
          pg8::gemm_phase<pg8::EpiResid, pg8::StaticOrder, true, true>(lds, g, S, E); }
        GSYNC();
        { PRef p = FP; pg8::Gemm g{(const bf16*)p.out + (size_t)li * T * 1024, (const bf16*)(p.ws + W_PG), T, 1024, 1024, 1024}; pg8::StaticOrder S; S.init(T, 1024, GRD, BID);
          pg8::EpiPLE E{li};
          pg8::gemm_phase<pg8::EpiPLE, pg8::StaticOrder, true, true>(lds, g, S, E);
#ifdef PROBE_PLE2
          pg8::gemm_phase<pg8::EpiPLE, pg8::StaticOrder, true, true>(lds, g, S, E);
#endif
        }
        GSYNC();
    }

__global__ void __launch_bounds__(NTHREADS, 2) trunk_fwd(Params p_unused) {
    extern __shared__ __attribute__((aligned(16))) unsigned char lds_raw[];
    LAS unsigned char* lds = (LAS unsigned char*)lds_raw;
    if (threadIdx.x < 16) ((volatile LAS unsigned*)(lds + LDS_XST))[threadIdx.x] = 0u;
    __syncthreads();
    (void)xcd_barrier_post((unsigned*)(FP.ws + WS_XBAR), (volatile LAS unsigned*)(lds + LDS_XST));
#ifndef NO_PRO
    phase_prologue(FP, lds, GW, NGW_, WAVE, LANE);
#endif
    GSYNC_CG();
#ifdef PROBE_SYNC10
    for (int i_ = 0; i_ < 10; ++i_) GSYNC();
#endif
#ifdef PROBE_PRO2
    phase_prologue(FP, lds, GW, NGW_, WAVE, LANE);
    GSYNC();
#endif
    layer_body<0>(lds);
    layer_body<1>(lds);
    final_norm(FP, GW, NGW_, LANE);
}

extern "C" void kernel_launch(void* const* d_in, const int* in_sizes, int n_in, void* d_out, int out_size, void* d_ws, size_t ws_size, hipStream_t stream) {
    static int grid = 0;
    if (grid == 0) {
        if (n_in != 38 || ws_size < WS_END) { fprintf(stderr, "kernel_launch: unexpected n_in %d / ws %zu\n", n_in, ws_size); grid = -1; return; }
        int dev = 0, cus = 0, per_cu = 0;
        hipGetDevice(&dev); hipDeviceGetAttribute(&cus, hipDeviceAttributeMultiprocessorCount, dev);
        hipFuncSetAttribute((const void*)trunk_fwd, hipFuncAttributeMaxDynamicSharedMemorySize, LDS_BYTES);
        hipOccupancyMaxActiveBlocksPerMultiprocessor(&per_cu, (const void*)trunk_fwd, NTHREADS, LDS_BYTES);
        (void)hipGetLastError();
        if (per_cu < 1) { fprintf(stderr, "kernel_launch: occupancy query reports %d blocks per CU\n", per_cu); per_cu = 1; }
        grid = cus;
    }
    if (grid < 0) return;
    hipMemsetAsync((char*)d_ws + WS_CTL, 0, CTL_ZERO_BYTES, stream);
    Params prm{};
    for (int i = 0; i < 38; ++i) prm.in[i] = (const float*)d_in[i];
    prm.out = (float*)d_out; prm.ws = (unsigned char*)d_ws;
    void* args[] = {&prm};
    hipError_t e = hipLaunchCooperativeKernel((const void*)trunk_fwd, dim3(grid), dim3(NTHREADS), args, LDS_BYTES, stream);
    if (e != hipSuccess) fprintf(stderr, "cooperative launch failed: %s (grid %d)\n", hipGetErrorString(e), grid);
}
```
